# Optimizing an MI355X kernel written in HIP

```python
import math
import jax, jax.numpy as jnp
from jax import lax
import numpy as np

D_MODEL = 1024
BATCH = 16
SEQ = 2048
DEPTH = 1

MLA_HEADS = 8
MLA_Q_RANK = 256
MLA_KV_RANK = 128
MLA_NOPE = 64
MLA_ROPE = 32
MLA_V = 64
MLA_SCALE = 1.0 / math.sqrt(MLA_NOPE + MLA_ROPE)
DIFF_HEADS = 4
DIFF_QK = 64
DIFF_V = 2 * DIFF_QK
DIFF_SCALE = 1.0 / math.sqrt(DIFF_QK)
MIX_WIDTH = MLA_HEADS * MLA_V + DIFF_HEADS * DIFF_V
DIFF_QK_COLS = DIFF_HEADS * 2 * DIFF_QK
DIFF_V_COLS = DIFF_HEADS * DIFF_V
IN_COLS = MLA_Q_RANK + MLA_KV_RANK + MLA_ROPE + 2 * DIFF_QK_COLS + DIFF_V_COLS
IN_SPLITS = tuple(int(s) for s in np.cumsum([MLA_Q_RANK, MLA_KV_RANK, MLA_ROPE, DIFF_QK_COLS, DIFF_QK_COLS]))
N_BUCKETS = 32
MAX_DISTANCE = 128
N_EXPERTS = 16
EXPERT_FF = 2048
CAPACITY_FACTOR = 2
Q_BLOCK = 128
ROPE_THETA = 10000.0
LN_EPS = 1e-5
RMS_EPS = 1e-6
DEEPNORM_ALPHA = (2.0 * DEPTH) ** 0.25
DEEPNORM_BETA = (8.0 * DEPTH) ** -0.25

kernel_name = "hybrid_mla_diffattn_ec_moe_encoder"


def layer_norm(x, g, b):
    xf = x.astype(jnp.float32)
    mu = jnp.mean(xf, axis=-1, keepdims=True)
    var = jnp.mean(jnp.square(xf - mu), axis=-1, keepdims=True)
    y = (xf - mu) * lax.rsqrt(var + LN_EPS)
    return (y * g.astype(jnp.float32) + b.astype(jnp.float32)).astype(x.dtype)


def rms_norm(x, g):
    xf = x.astype(jnp.float32)
    y = xf * lax.rsqrt(jnp.mean(jnp.square(xf), axis=-1, keepdims=True) + RMS_EPS)
    return (y * g.astype(jnp.float32)).astype(x.dtype)


def rope(t, pos):
    half = t.shape[-1] // 2
    freqs = ROPE_THETA ** (-jnp.arange(half, dtype=jnp.float32) / half)
    ang = pos.astype(jnp.float32)[..., None] * freqs
    cos = jnp.cos(ang)[:, :, None, :].astype(t.dtype)
    sin = jnp.sin(ang)[:, :, None, :].astype(t.dtype)
    t1, t2 = t[..., :half], t[..., half:]
    return jnp.concatenate([t1 * cos - t2 * sin, t1 * sin + t2 * cos], axis=-1)


def t5_bucket(rel):
    nb = N_BUCKETS // 2
    max_exact = nb // 2
    ret = jnp.where(rel > 0, nb, 0)
    n = jnp.abs(rel)
    nf = jnp.maximum(n, 1).astype(jnp.float32)
    large = max_exact + (jnp.log(nf / max_exact) / math.log(MAX_DISTANCE / max_exact)
                         * (nb - max_exact)).astype(jnp.int32)
    large = jnp.minimum(large, nb - 1)
    return ret + jnp.where(n < max_exact, n, large)


def attention_mixer(u, positions, rel_bias, w_in, mla_q_norm, w_uq, mla_kv_norm, w_ukv,
                    diff_lq1, diff_lk1, diff_lq2, diff_lk2, diff_subln, w_out, layer_idx):
    B, S, _ = u.shape
    nblk = S // Q_BLOCK
    proj = jnp.einsum('bsd,dn->bsn', u, w_in)
    cq, ckv, k_rope, dq, dk, dv = jnp.split(proj, IN_SPLITS, axis=-1)

    q = jnp.einsum('bsr,rn->bsn', rms_norm(cq, mla_q_norm), w_uq).reshape(B, S, MLA_HEADS, MLA_NOPE + MLA_ROPE)
    q_nope = q[..., :MLA_NOPE]
    q_rope = rope(q[..., MLA_NOPE:], positions)
    kv = jnp.einsum('bsr,rn->bsn', rms_norm(ckv, mla_kv_norm), w_ukv).reshape(B, S, MLA_HEADS, MLA_NOPE + MLA_V)
    k_nope, v_mla = kv[..., :MLA_NOPE], kv[..., MLA_NOPE:]
    k_rope = rope(k_rope[:, :, None, :], positions)[:, :, 0, :]

    dq = dq.reshape(B, S, DIFF_HEADS, 2, DIFF_QK)
    dk = dk.reshape(B, S, DIFF_HEADS, 2, DIFF_QK)
    dv = dv.reshape(B, S, DIFF_HEADS, DIFF_V)
    lambda_init = 0.8 - 0.6 * math.exp(-0.3 * layer_idx)
    lam = (jnp.exp(jnp.sum(diff_lq1.astype(jnp.float32) * diff_lk1.astype(jnp.float32)))
           - jnp.exp(jnp.sum(diff_lq2.astype(jnp.float32) * diff_lk2.astype(jnp.float32)))
           + lambda_init)

    def to_blocks(t):
        return jnp.moveaxis(t.reshape((B, nblk, Q_BLOCK) + t.shape[2:]), 1, 0)

    def one_block(args):
        qn, qr, dqb, qp = args
        s = (jnp.einsum('bqhd,bkhd->bhqk', qn, k_nope)
             + jnp.einsum('bqhr,bkr->bhqk', qr, k_rope)) * MLA_SCALE
        p = jax.nn.softmax(s.astype(jnp.float32), axis=-1).astype(v_mla.dtype)
        o_mla = jnp.einsum('bhqk,bkhd->bqhd', p, v_mla).reshape(B, Q_BLOCK, MLA_HEADS * MLA_V)
        rel = positions[:, None, :] - qp[:, :, None]
        bias = jnp.transpose(rel_bias[t5_bucket(rel)], (0, 3, 1, 2))
        s12 = (jnp.einsum('bqhmd,bkhmd->bmhqk', dqb, dk) * DIFF_SCALE
               + bias[:, None].astype(dqb.dtype))
        p12 = jax.nn.softmax(s12.astype(jnp.float32), axis=-1)
        a = (p12[:, 0] - lam * p12[:, 1]).astype(dv.dtype)
        o_d = jnp.einsum('bhqk,bkhd->bqhd', a, dv)
        o_d = rms_norm(o_d, diff_subln) * (1.0 - lambda_init)
        return jnp.concatenate([o_mla, o_d.reshape(B, Q_BLOCK, DIFF_HEADS * DIFF_V)], axis=-1)

    out = lax.map(one_block, (to_blocks(q_nope), to_blocks(q_rope), to_blocks(dq), to_blocks(positions)))
    out = jnp.moveaxis(out, 0, 1).reshape(B, S, MIX_WIDTH)
    return jnp.einsum('bsm,md->bsd', out, w_out)


def expert_choice_ffn(u, w_router, w_gate, w_up, w_down):
    B, S, D = u.shape
    cap = CAPACITY_FACTOR * S // N_EXPERTS
    logits = jnp.einsum('bsd,de->bse', u, w_router).astype(jnp.float32)
    aff = jax.nn.softmax(logits, axis=-1)
    g, idx = lax.top_k(jnp.swapaxes(aff, 1, 2), cap)
    xs = jax.vmap(lambda ub, ib: ub[ib])(u, idx)
    h = jax.nn.silu(jnp.einsum('becd,edf->becf', xs, w_gate)) * jnp.einsum('becd,edf->becf', xs, w_up)
    y = jnp.einsum('becf,efd->becd', h, w_down) * g[..., None].astype(u.dtype)
    flat_idx = (jnp.arange(B, dtype=jnp.int32)[:, None, None] * S + idx).reshape(-1)
    out = jnp.zeros((B * S, D), y.dtype).at[flat_idx].add(y.reshape(-1, D))
    return out.reshape(B, S, D)


def setup_inputs(seed: int = 0) -> dict:
    key = jax.random.key(seed)
    ks = jax.random.split(key, 32)
    f32 = jnp.float32
    nrm = lambda k, shape, s: jax.random.normal(k, shape, f32) * s
    L, D = DEPTH, D_MODEL
    pos_off = jax.random.randint(ks[2], (BATCH, 1), 0, 4096, dtype=jnp.int32)
    return {
        "x": nrm(ks[0], (BATCH, SEQ, D), 1.0),
        "c": nrm(ks[1], (BATCH, D), 1.0),
        "positions": pos_off + jnp.arange(SEQ, dtype=jnp.int32)[None, :],
        "rel_bias": nrm(ks[3], (N_BUCKETS, DIFF_HEADS), 0.5),
        "w_ada": nrm(ks[4], (L, D, 6 * D), 0.5 * D ** -0.5),
        "b_ada": nrm(ks[5], (L, 6 * D), 0.02),
        "w_in": nrm(ks[6], (L, D, IN_COLS), D ** -0.5),
        "mla_q_norm": 1.0 + nrm(ks[7], (L, MLA_Q_RANK), 0.02),
        "w_uq": nrm(ks[8], (L, MLA_Q_RANK, MLA_HEADS * (MLA_NOPE + MLA_ROPE)), MLA_Q_RANK ** -0.5),
        "mla_kv_norm": 1.0 + nrm(ks[9], (L, MLA_KV_RANK), 0.02),
        "w_ukv": nrm(ks[10], (L, MLA_KV_RANK, MLA_HEADS * (MLA_NOPE + MLA_V)), MLA_KV_RANK ** -0.5),
        "diff_lq1": nrm(ks[11], (L, DIFF_QK), 0.1),
        "diff_lk1": nrm(ks[12], (L, DIFF_QK), 0.1),
        "diff_lq2": nrm(ks[13], (L, DIFF_QK), 0.1),
        "diff_lk2": nrm(ks[14], (L, DIFF_QK), 0.1),
        "diff_subln": 1.0 + nrm(ks[15], (L, DIFF_V), 0.02),
        "w_out": nrm(ks[16], (L, MIX_WIDTH, D), DEEPNORM_BETA * MIX_WIDTH ** -0.5),
        "ln1_g": 1.0 + nrm(ks[17], (L, D), 0.02),
        "ln1_b": nrm(ks[18], (L, D), 0.02),
        "w_router": nrm(ks[19], (L, D, N_EXPERTS), D ** -0.5),
        "w_gate": nrm(ks[20], (L, N_EXPERTS, D, EXPERT_FF), D ** -0.5),
        "w_up": nrm(ks[21], (L, N_EXPERTS, D, EXPERT_FF), D ** -0.5),
        "w_down": nrm(ks[22], (L, N_EXPERTS, EXPERT_FF, D), DEEPNORM_BETA * EXPERT_FF ** -0.5),
        "ln2_g": 1.0 + nrm(ks[23], (L, D), 0.02),
        "ln2_b": nrm(ks[24], (L, D), 0.02),
    }


def reference(x, c, positions, rel_bias, w_ada, b_ada, w_in, mla_q_norm, w_uq, mla_kv_norm, w_ukv,
              diff_lq1, diff_lk1, diff_lq2, diff_lk2, diff_subln, w_out, ln1_g, ln1_b,
              w_router, w_gate, w_up, w_down, ln2_g, ln2_b):
    c_act = jax.nn.silu(c)
    for l in range(DEPTH):
        mod = jnp.einsum('bd,dn->bn', c_act, w_ada[l]) + b_ada[l]
        sh_a, sc_a, g_a, sh_f, sc_f, g_f = jnp.split(mod[:, None, :], 6, axis=-1)
        u = x * (1.0 + sc_a) + sh_a
        mix = attention_mixer(u, positions, rel_bias, w_in[l], mla_q_norm[l], w_uq[l], mla_kv_norm[l], w_ukv[l],
                              diff_lq1[l], diff_lk1[l], diff_lq2[l], diff_lk2[l], diff_subln[l], w_out[l], l)
        x = layer_norm(DEEPNORM_ALPHA * x + g_a * mix, ln1_g[l], ln1_b[l])
        u = x * (1.0 + sc_f) + sh_f
        ffn = expert_choice_ffn(u, w_router[l], w_gate[l], w_up[l], w_down[l])
        x = layer_norm(DEEPNORM_ALPHA * x + g_f * ffn, ln2_g[l], ln2_b[l])
    return x
```

```cpp
#include <hip/hip_runtime.h>
#include <cstdio>
#include <cstdint>

#ifndef CFG_OPT_MASK
#define CFG_OPT_MASK 0
#endif
#ifndef CFG_ONE_LAUNCH
#define CFG_ONE_LAUNCH 0
#endif

constexpr int BATCH = 16, SEQ = 2048, DM = 1024, T = BATCH * SEQ;
constexpr int NE = 16, FF = 2048, CAP = 256, NSEL = BATCH * NE * CAP;
constexpr int NPROJ = 2048;
constexpr float LOG2E = 1.4426950408889634f;
constexpr float MLA_SCALE = 0.10206207261596575f;
constexpr float DIFF_SCALE = 0.125f;
constexpr float ALPHA = 1.189207115002721f;
constexpr float LN_EPS = 1e-5f, RMS_EPS = 1e-6f;
constexpr float LAMBDA_INIT = 0.2f;

constexpr size_t MiB = 1u << 20;
constexpr size_t WS_CTL = 0, CTL_BYTES = 1 * MiB;
constexpr size_t WS_MOD = 1 * MiB;
constexpr size_t WS_MISC = 1 * MiB + 512 * 1024;
constexpr size_t WS_PMM = 1 * MiB + 768 * 1024;
constexpr size_t WS_CS = 2 * MiB, WS_SN = 4 * MiB;
constexpr size_t WS_AFF = 6 * MiB;
constexpr size_t WS_IDX = 8 * MiB, WS_GATE = 8 * MiB + 512 * 1024;
constexpr size_t WS_SLOT = 9 * MiB;
constexpr size_t WS_RINVQ = 11 * MiB, WS_RINVKV = 11 * MiB + 256 * 1024;
constexpr size_t WS_KR = 12 * MiB;
constexpr size_t WS_WIN = 14 * MiB, WS_WUQ = 18 * MiB, WS_WUKV = 18 * MiB + 512 * 1024, WS_WOUT = 19 * MiB;
constexpr size_t WS_WD = 22 * MiB;
constexpr size_t WS_WGU = 86 * MiB;
constexpr size_t WS_YE = WS_WGU;
constexpr size_t WS_PROJ = 214 * MiB;
constexpr size_t WS_Y = WS_PROJ, WS_HLO = WS_PROJ;
constexpr size_t WS_Q = 342 * MiB;
constexpr size_t WS_KV = 390 * MiB;
constexpr size_t WS_U2 = 342 * MiB;
constexpr size_t WS_U = 454 * MiB, WS_AO = 454 * MiB;
constexpr size_t WS_HHI = 406 * MiB;
constexpr size_t WS_END = 534 * MiB;
constexpr size_t WS_ODIFF = WS_WGU;

#define GAS __attribute__((address_space(1)))
#define LAS __attribute__((address_space(3)))
typedef unsigned short bf16;
typedef short bf16x8 __attribute__((ext_vector_type(8)));
typedef float f32x4 __attribute__((ext_vector_type(4)));
typedef float f32x2 __attribute__((ext_vector_type(2)));
typedef unsigned u32x4 __attribute__((ext_vector_type(4)));
typedef unsigned u32x2 __attribute__((ext_vector_type(2)));
typedef GAS unsigned gu32;
#define RLX_AGENT __ATOMIC_RELAXED, __HIP_MEMORY_SCOPE_AGENT
#define LDS_WAIT() asm volatile("s_waitcnt lgkmcnt(0)" ::: "memory")
#define VM_WAIT() asm volatile("s_waitcnt vmcnt(0)" ::: "memory")
__device__ __forceinline__ unsigned f2bf(float f) { unsigned u = __builtin_bit_cast(unsigned, f); return (u + 0x7fffu + ((u >> 16) & 1u)) >> 16; }
__device__ __forceinline__ unsigned pk2(float lo, float hi) { return f2bf(lo) | (f2bf(hi) << 16); }
__device__ __forceinline__ float bflo(unsigned w) { return __uint_as_float(w << 16); }
__device__ __forceinline__ float bfhi(unsigned w) { return __uint_as_float(w & 0xffff0000u); }
__device__ __forceinline__ float bf2f(bf16 h) { return __uint_as_float((unsigned)h << 16); }
__device__ __forceinline__ float wave_sum(float v) {
#pragma unroll
    for (int o = 1; o < 64; o <<= 1) v += __shfl_xor(v, o);
    return v;
}
__device__ __forceinline__ float wave_max(float v) {
#pragma unroll
    for (int o = 1; o < 64; o <<= 1) v = fmaxf(v, __shfl_xor(v, o));
    return v;
}
__device__ __forceinline__ float silu_f(float g) { return g * __builtin_amdgcn_rcpf(1.0f + __builtin_amdgcn_exp2f(-g * LOG2E)); }

#define XB_TMO      128
#define XB_XCNT(j)  (256  + 64 * (j))
#define XB_XSUB(j)  (1280 + 64 * (j))
#define XB_XGEN(j)  (2304 + 64 * (j))
#define XB_TOP      3328
#define XB_TOPGEN   3392
#define XCD_BAR_WORDS 3456
#define XB_SPIN_CAP (1u << 18)
__device__ __forceinline__ unsigned xb_ld(unsigned* p)              { return __hip_atomic_load(p, __ATOMIC_RELAXED, __HIP_MEMORY_SCOPE_AGENT); }
__device__ __forceinline__ unsigned xb_add(unsigned* p, unsigned v) { return __hip_atomic_fetch_add(p, v, __ATOMIC_RELAXED, __HIP_MEMORY_SCOPE_AGENT); }
__device__ __forceinline__ unsigned xb_xcc_id() { return (unsigned)__builtin_amdgcn_s_getreg((3 << 11) | 20) & 0xFu; }
#define XB_SPIN(cond, bar) do { unsigned _sp = 0; while (cond) { __builtin_amdgcn_s_sleep(1); \
    if ((++_sp & 255u) == 0u) { if (xb_ld(&(bar)[XB_TMO])) break; if (_sp > XB_SPIN_CAP) { atomicAdd(&(bar)[XB_TMO], 1u); break; } } } } while (0)
struct XcdBarrier { unsigned* bar; unsigned x; volatile LAS unsigned* st; };
__device__ __forceinline__ XcdBarrier xcd_barrier_post(unsigned* bar, volatile LAS unsigned* st) {
    XcdBarrier b; b.bar = bar; b.x = xb_xcc_id(); b.st = st;
    if (threadIdx.x == 0) (void)xb_add(&bar[XB_XCNT(b.x)], 1u);
    return b;
}
__device__ __forceinline__ void xcd_barrier_complete(unsigned* bar, unsigned x, unsigned& nloc, unsigned& nx) {
    const unsigned G = gridDim.x * gridDim.y * gridDim.z;
    unsigned sum, cnt, mine, sp = 0u;
    for (;;) {
        sum = 0u; cnt = 0u; mine = 0u;
#pragma unroll
        for (unsigned j = 0; j < 16; ++j) { const unsigned c = xb_ld(&bar[XB_XCNT(j)]); sum += c; cnt += (c > 0u) ? 1u : 0u; mine = (j == x) ? c : mine; }
        if (sum == G) break;
        __builtin_amdgcn_s_sleep(1);
        if ((++sp & 255u) == 0u) { if (xb_ld(&bar[XB_TMO])) break; if (sp > XB_SPIN_CAP) { atomicAdd(&bar[XB_TMO], 1u); break; } }
    }
    nloc = mine > 0u ? mine : 1u; nx = cnt > 0u ? cnt : 1u;
}
__device__ __forceinline__ void xcd_barrier(const XcdBarrier& b) {
    asm volatile("s_waitcnt vmcnt(0)" ::: "memory");
    __syncthreads();
    if (threadIdx.x == 0) {
        unsigned* bar = b.bar;
        __builtin_amdgcn_s_waitcnt(0);
        unsigned nloc = b.st[0], nx = b.st[1];
        if (nloc == 0u) { xcd_barrier_complete(bar, b.x, nloc, nx); b.st[0] = nloc; b.st[1] = nx; }
        const unsigned old = xb_add(&bar[XB_XSUB(b.x)], 1u);
        const unsigned gen = old / nloc;
        if (old + 1u == (gen + 1u) * nloc) {
            __builtin_amdgcn_fence(__ATOMIC_RELEASE, "agent");
            asm volatile("s_waitcnt vmcnt(0)" ::: "memory");
            const unsigned og = xb_add(&bar[XB_TOP], 1u);
            const unsigned tg = og / nx;
            if (og + 1u == (tg + 1u) * nx) xb_add(&bar[XB_TOPGEN], 1u);
            else XB_SPIN(xb_ld(&bar[XB_TOPGEN]) == tg, bar);
            __builtin_amdgcn_fence(__ATOMIC_ACQUIRE, "agent");
            xb_add(&bar[XB_XGEN(b.x)], 1u);
            asm volatile("s_waitcnt vmcnt(0)" ::: "memory");
        } else {
            XB_SPIN(xb_ld(&bar[XB_XGEN(b.x)]) == gen, bar);
            __builtin_amdgcn_fence(__ATOMIC_ACQUIRE, "agent");
            asm volatile("s_waitcnt vmcnt(0)" ::: "memory");
        }
    }
    __syncthreads();
}

constexpr int NWAVES = 8, NTHREADS = 512;
constexpr int RING_BYTES = 131072, LDSCTL_OFF = RING_BYTES, MISC_OFF = LDSCTL_OFF + 320, LDS_BYTES = 147456;
constexpr int CW_BAR = 4096;

struct Args { const void* in[25]; float* out; unsigned char* ws; int ph_lo, ph_hi, li, pad; };

struct Ctx {
    LAS unsigned char* lds; unsigned char* lds_g;
    int tid, lane, wave, vcu, G;
    const float *x, *c, *rel_bias, *w_ada, *b_ada, *w_in, *qnorm, *w_uq, *kvnorm, *w_ukv, *lq1, *lk1, *lq2, *lk2, *subln, *w_out, *ln1g, *ln1b, *w_router, *w_gate, *w_up, *w_down, *ln2g, *ln2b;
    const int* pos;
    float* out; unsigned char* ws;
    float *MOD, *MISC, *CS, *SN, *AFF, *GATE, *RINVQ, *RINVKV, *Y;
    int *PMM, *IDX, *SLOT;
    bf16 *KR, *WIN, *WUQ, *WUKV, *WOUT, *WD, *WGU, *YE, *PROJ, *Q, *KV, *U2, *U, *AO, *HLO, *HHI;
};
__device__ __forceinline__ void ctx_init(Ctx& C, const Args& a) {
    C.x = (const float*)a.in[0]; C.c = (const float*)a.in[1]; C.pos = (const int*)a.in[2]; C.rel_bias = (const float*)a.in[3];
    C.w_ada = (const float*)a.in[4]; C.b_ada = (const float*)a.in[5]; C.w_in = (const float*)a.in[6]; C.qnorm = (const float*)a.in[7];
    C.w_uq = (const float*)a.in[8]; C.kvnorm = (const float*)a.in[9]; C.w_ukv = (const float*)a.in[10];
    C.lq1 = (const float*)a.in[11]; C.lk1 = (const float*)a.in[12]; C.lq2 = (const float*)a.in[13]; C.lk2 = (const float*)a.in[14];
    C.subln = (const float*)a.in[15]; C.w_out = (const float*)a.in[16]; C.ln1g = (const float*)a.in[17]; C.ln1b = (const float*)a.in[18];
    C.w_router = (const float*)a.in[19]; C.w_gate = (const float*)a.in[20]; C.w_up = (const float*)a.in[21]; C.w_down = (const float*)a.in[22];
    C.ln2g = (const float*)a.in[23]; C.ln2b = (const float*)a.in[24];
    C.out = a.out; unsigned char* ws = a.ws; C.ws = ws;
    C.MOD = (float*)(ws + WS_MOD); C.MISC = (float*)(ws + WS_MISC); C.PMM = (int*)(ws + WS_PMM); C.CS = (float*)(ws + WS_CS); C.SN = (float*)(ws + WS_SN);
    C.AFF = (float*)(ws + WS_AFF); C.IDX = (int*)(ws + WS_IDX); C.GATE = (float*)(ws + WS_GATE); C.SLOT = (int*)(ws + WS_SLOT);
    C.RINVQ = (float*)(ws + WS_RINVQ); C.RINVKV = (float*)(ws + WS_RINVKV); C.KR = (bf16*)(ws + WS_KR);
    C.WIN = (bf16*)(ws + WS_WIN); C.WUQ = (bf16*)(ws + WS_WUQ); C.WUKV = (bf16*)(ws + WS_WUKV); C.WOUT = (bf16*)(ws + WS_WOUT);
    C.WD = (bf16*)(ws + WS_WD); C.WGU = (bf16*)(ws + WS_WGU); C.YE = (bf16*)(ws + WS_YE);
    C.PROJ = (bf16*)(ws + WS_PROJ); C.Y = (float*)(ws + WS_Y); C.HLO = (bf16*)(ws + WS_HLO); C.HHI = (bf16*)(ws + WS_HHI);
    C.Q = (bf16*)(ws + WS_Q); C.KV = (bf16*)(ws + WS_KV); C.U2 = (bf16*)(ws + WS_U2); C.U = (bf16*)(ws + WS_U); C.AO = (bf16*)(ws + WS_AO);
}

__device__ __forceinline__ void store8_bf16(bf16* p, const float (&v)[8]) {
    u32x4 w; w.x = pk2(v[0], v[1]); w.y = pk2(v[2], v[3]); w.z = pk2(v[4], v[5]); w.w = pk2(v[6], v[7]); *(u32x4*)p = w;
}
struct FPlain { bf16* O; int ldc;
    __device__ __forceinline__ void row8(int kind, int row, int col, const float (&v)[8]) const { store8_bf16(O + (size_t)row * ldc + col, v); } };
struct FQKV { bf16* Q; bf16* KV; const float* rq; const float* rkv; const float* cs; const float* sn;
    __device__ __forceinline__ void row8(int kind, int row, int col, const float (&v)[8]) const {
        float o[8];
        if (kind == 0) {
            const float s = rq[row];
            if (col < 512) {
#pragma unroll
                for (int i = 0; i < 8; ++i) o[i] = v[i] * s;
            } else {
                const int fq = (col >> 3) & 3; const f32x4 c4 = *(const f32x4*)(cs + (size_t)row * 16 + 4 * fq), s4 = *(const f32x4*)(sn + (size_t)row * 16 + 4 * fq);
#pragma unroll
                for (int i = 0; i < 4; ++i) { const float t1 = v[i] * s, t2 = v[4 + i] * s; o[i] = t1 * c4[i] - t2 * s4[i]; o[4 + i] = t1 * s4[i] + t2 * c4[i]; }
            }
            store8_bf16(Q + (size_t)row * 768 + col, o);
        } else {
            const float s = rkv[row];
#pragma unroll
            for (int i = 0; i < 8; ++i) o[i] = v[i] * s;
            store8_bf16(KV + (size_t)row * 1024 + col, o);
        }
    } };
struct FY { float* Y; const float* x; const float* mod;
    __device__ __forceinline__ void row8(int kind, int row, int col, const float (&v)[8]) const {
        const int b = row >> 11; const float* ga = mod + b * 6144 + 2048 + col; const float* xr = x + (size_t)row * DM + col; float* yo = Y + (size_t)row * DM + col;
        const f32x4 g0 = *(const f32x4*)ga, g1 = *(const f32x4*)(ga + 4), x0 = *(const f32x4*)xr, x1 = *(const f32x4*)(xr + 4);
        f32x4 y0, y1;
#pragma unroll
        for (int i = 0; i < 4; ++i) { y0[i] = ALPHA * x0[i] + g0[i] * v[i]; y1[i] = ALPHA * x1[i] + g1[i] * v[4 + i]; }
        *(f32x4*)yo = y0; *(f32x4*)(yo + 4) = y1;
    } };
struct FSwi { bf16* HLO; bf16* HHI;
    __device__ __forceinline__ void pair8(int row, int col, const float (&g)[8], const float (&u)[8]) const {
        float o[8];
#pragma unroll
        for (int i = 0; i < 8; ++i) o[i] = silu_f(g[i]) * u[i];
        bf16* p = (row < NSEL / 2) ? HLO + (size_t)row * FF : HHI + (size_t)(row - NSEL / 2) * FF;
        store8_bf16(p + col, o);
    } };
struct FGate { bf16* YE; const float* gate;
    __device__ __forceinline__ void row8(int kind, int row, int col, const float (&v)[8]) const {
        const float s = gate[row]; float o[8];
#pragma unroll
        for (int i = 0; i < 8; ++i) o[i] = v[i] * s;
        store8_bf16(YE + (size_t)row * DM + col, o);
    } };

template <bool DUAL, class ARow, class BRow, class Epi>
__device__ __forceinline__ void naive_gemm_tile(int m0, int n0, int K, const ARow& arow, const BRow& brow, const Epi& epi, int kind, float* lds) {
    const int tid = threadIdx.x, ty = tid >> 4, tx = tid & 15;
    float* As = lds;
    float* Bs = lds + 16 * 132;
    float* Cs = lds + 32 * 132;
    float acc[4][8], acc2[4][8];
#pragma unroll
    for (int i = 0; i < 4; ++i)
#pragma unroll
        for (int j = 0; j < 8; ++j) { acc[i][j] = 0.f; acc2[i][j] = 0.f; }
    const int lr = tid >> 2, lk = (tid & 3) * 4;
    const bf16* ap = arow(m0 + lr); const bf16* bp = brow(n0 + lr, 0); const bf16* cp = DUAL ? brow(n0 + lr, 1) : bp;
    for (int k0 = 0; k0 < K; k0 += 16) {
        const u32x2 av = *(const u32x2*)(ap + k0 + lk), bv = *(const u32x2*)(bp + k0 + lk);
        u32x2 cv = bv; if (DUAL) cv = *(const u32x2*)(cp + k0 + lk);
        __syncthreads();
        As[(lk + 0) * 132 + lr] = bflo(av.x); As[(lk + 1) * 132 + lr] = bfhi(av.x); As[(lk + 2) * 132 + lr] = bflo(av.y); As[(lk + 3) * 132 + lr] = bfhi(av.y);
        Bs[(lk + 0) * 132 + lr] = bflo(bv.x); Bs[(lk + 1) * 132 + lr] = bfhi(bv.x); Bs[(lk + 2) * 132 + lr] = bflo(bv.y); Bs[(lk + 3) * 132 + lr] = bfhi(bv.y);
        if (DUAL) { Cs[(lk + 0) * 132 + lr] = bflo(cv.x); Cs[(lk + 1) * 132 + lr] = bfhi(cv.x); Cs[(lk + 2) * 132 + lr] = bflo(cv.y); Cs[(lk + 3) * 132 + lr] = bfhi(cv.y); }
        __syncthreads();
#pragma unroll
        for (int kk = 0; kk < 16; ++kk) {
            const f32x4 a = *(const f32x4*)(As + kk * 132 + ty * 4);
            const f32x4 b0 = *(const f32x4*)(Bs + kk * 132 + tx * 8), b1 = *(const f32x4*)(Bs + kk * 132 + tx * 8 + 4);
#pragma unroll
            for (int i = 0; i < 4; ++i)
#pragma unroll
                for (int j = 0; j < 4; ++j) { acc[i][j] += a[i] * b0[j]; acc[i][4 + j] += a[i] * b1[j]; }
            if (DUAL) {
                const f32x4 c0 = *(const f32x4*)(Cs + kk * 132 + tx * 8), c1 = *(const f32x4*)(Cs + kk * 132 + tx * 8 + 4);
#pragma unroll
                for (int i = 0; i < 4; ++i)
#pragma unroll
                    for (int j = 0; j < 4; ++j) { acc2[i][j] += a[i] * c0[j]; acc2[i][4 + j] += a[i] * c1[j]; }
            }
        }
    }
#pragma unroll
    for (int i = 0; i < 4; ++i) {
        if constexpr (DUAL) epi.pair8(m0 + ty * 4 + i, n0 + tx * 8, acc[i], acc2[i]);
        else epi.row8(kind, m0 + ty * 4 + i, n0 + tx * 8, acc[i]);
    }
}

__device__ __forceinline__ void tr_item(const float* W, int ldw, int kb, int srccol0, bool perm, float scale, const float* kgain, int kvalid,
                                        bf16* WT, int ldt, int n0, LAS float* scr, int lane) {
    const int k0 = 64 * kb, cl = lane & 31;
    const int sc = perm ? (16 * ((cl >> 2) & 1) + 4 * (cl >> 3) + (cl & 3)) : cl;
#pragma unroll 8
    for (int i = 0; i < 32; ++i) { const int kk = 2 * i + (lane >> 5), k = k0 + kk; float v = 0.f;
        if (srccol0 >= 0 && k < kvalid) { v = W[(size_t)k * ldw + srccol0 + sc] * scale; if (kgain) v *= kgain[k]; }
        scr[kk * 33 + cl] = v; }
    LDS_WAIT(); asm volatile("" ::: "memory");
    const int c = lane & 7;
#pragma unroll
    for (int j = 0; j < 4; ++j) { const int n = (lane >> 3) + 8 * j; const LAS float* s = scr + (8 * c) * 33 + n;
        u32x4 o; o.x = pk2(s[0 * 33], s[1 * 33]); o.y = pk2(s[2 * 33], s[3 * 33]); o.z = pk2(s[4 * 33], s[5 * 33]); o.w = pk2(s[6 * 33], s[7 * 33]);
        *(GAS u32x4*)(WT + (size_t)(n0 + n) * ldt + k0 + 8 * c) = o; }
    LDS_WAIT(); asm volatile("" ::: "memory");
}
__device__ __forceinline__ int t5_bucket(int rel) {
    const int nb = 16, max_exact = 8; int ret = rel > 0 ? nb : 0; const int n = rel < 0 ? -rel : rel;
    const float nf = (float)(n > 1 ? n : 1);
    int large = max_exact + (int)(logf(nf / 8.0f) / 2.772588722239781f * 8.0f);
    large = large < nb - 1 ? large : nb - 1;
    return ret + (n < max_exact ? n : large);
}

__device__ __forceinline__ void phase_prep(const Ctx& C) {
    LAS float* scr = (LAS float*)(C.lds + C.wave * 8448);
    const int gw = C.vcu * NWAVES + C.wave, NGW = C.G * NWAVES;
    constexpr int I_IN = 16 * 64, I_UQ = 4 * 24, I_UKV = 4 * 32, I_OUT = 16 * 32, NIT = I_IN + I_UQ + I_UKV + I_OUT;
    for (int it = gw; it < NIT; it += NGW) {
        int r = it;
        if (r < I_IN) { const int kb = r / 64, nb = r % 64, n0 = 32 * nb; int src; bool perm = false; float sc = 1.f;
            if (nb < 12) src = n0; else if (nb == 12) { src = 384; perm = true; } else if (nb < 16) src = -1; else { src = 416 + (n0 - 512); if (n0 < 1024) sc = DIFF_SCALE * LOG2E; }
            tr_item(C.w_in, 1952, kb, src, perm, sc, nullptr, 1024, C.WIN, 1024, n0, scr, C.lane); continue; }
        r -= I_IN;
        if (r < I_UQ) { const int kb = r / 24, nb = r % 24, n0 = 32 * nb; int src; bool perm = false;
            if (nb < 16) { src = 96 * (n0 >> 6) + (n0 & 63); } else { src = 96 * (nb - 16) + 64; perm = true; }
            tr_item(C.w_uq, 768, kb, src, perm, MLA_SCALE * LOG2E, C.qnorm, 256, C.WUQ, 256, n0, scr, C.lane); continue; }
        r -= I_UQ;
        if (r < I_UKV) { const int kb = r / 32, nb = r % 32, n0 = 32 * nb; int src;
            if (nb < 16) src = 128 * (n0 >> 6) + (n0 & 63); else { const int n1 = n0 - 512; src = 128 * (n1 >> 6) + 64 + (n1 & 63); }
            tr_item(C.w_ukv, 1024, kb, src, false, 1.f, C.kvnorm, 128, C.WUKV, 256, n0, scr, C.lane); continue; }
        r -= I_UKV;
        { const int kb = r / 32, nb = r % 32; tr_item(C.w_out, 1024, kb, 32 * nb, false, 1.f, nullptr, 1024, C.WOUT, 1024, 32 * nb, scr, C.lane); }
    }
    for (int i = (C.vcu * NTHREADS + C.tid); i < T * 16; i += C.G * NTHREADS) { const int t = i >> 4, j = i & 15;
        const float freq = (float)pow(10000.0, -(double)j / 16.0); const float ang = (float)C.pos[t] * freq; float s, c; sincosf(ang, &s, &c);
        C.CS[i] = c; C.SN[i] = s; }
    for (int i = (C.vcu * NTHREADS + C.tid); i < BATCH * 32; i += C.G * NTHREADS) { int mn = 0x7fffffff, mx = -0x7fffffff - 1;
        for (int k = 0; k < 64; ++k) { const int p = C.pos[i * 64 + k]; mn = p < mn ? p : mn; mx = p > mx ? p : mx; }
        C.PMM[2 * i] = mn; C.PMM[2 * i + 1] = mx; }
    if (C.vcu == 255 % C.G) {
        for (int i = C.tid; i < 4 * 257; i += NTHREADS) { const int h = i / 257, r = i % 257 - 128; C.MISC[64 + h * 260 + (r + 128)] = C.rel_bias[t5_bucket(r) * 4 + h] * LOG2E; }
        if (C.wave == 0) { const float a = wave_sum(C.lq1[C.lane] * C.lk1[C.lane]), b = wave_sum(C.lq2[C.lane] * C.lk2[C.lane]);
            if (C.lane == 0) C.MISC[0] = expf(a) - expf(b) + LAMBDA_INIT; }
    }
    __syncthreads();
    LAS float* cact = (LAS float*)C.lds;
    LAS float* red = (LAS float*)(C.lds + 65536);
    bool have = false;
    for (int u = C.vcu; u < 192; u += C.G) {
        if (!have) { for (int i = C.tid; i < 16 * 1024; i += NTHREADS) { const int b = i >> 10, d = i & 1023; const float v = C.c[i]; cact[d * 16 + b] = v / (1.0f + expf(-v)); } have = true; __syncthreads(); }
        const int nl = C.tid & 31, kc = C.tid >> 5, n = 32 * u + nl;
        float acc[16];
#pragma unroll
        for (int b = 0; b < 16; ++b) acc[b] = 0.f;
#pragma unroll 8
        for (int i = 0; i < 64; ++i) { const int d = kc * 64 + i; const float w = C.w_ada[(size_t)d * 6144 + n];
#pragma unroll
            for (int q = 0; q < 4; ++q) { const f32x4 ca = *(const LAS f32x4*)(cact + d * 16 + 4 * q); acc[4 * q] += w * ca[0]; acc[4 * q + 1] += w * ca[1]; acc[4 * q + 2] += w * ca[2]; acc[4 * q + 3] += w * ca[3]; } }
#pragma unroll
        for (int b = 0; b < 16; ++b) red[(kc * 16 + b) * 32 + nl] = acc[b];
        __syncthreads();
        { const int b = C.tid >> 5; float s = C.b_ada[n];
#pragma unroll
            for (int k = 0; k < 16; ++k) s += red[(k * 16 + b) * 32 + nl];
            C.MOD[b * 6144 + n] = s; }
        __syncthreads();
    }
}
__device__ __forceinline__ void phase_u(const Ctx& C) {
    for (size_t i = (size_t)C.vcu * NTHREADS + C.tid; i < (size_t)T * DM / 8; i += (size_t)C.G * NTHREADS) {
        const size_t e = i * 8; const int row = (int)(e >> 10), col = (int)(e & 1023), b = row >> 11;
        const f32x4 x0 = *(const f32x4*)(C.x + e), x1 = *(const f32x4*)(C.x + e + 4);
        const float* sh = C.MOD + b * 6144 + col; const float* sc = sh + 1024;
        const f32x4 h0 = *(const f32x4*)sh, h1 = *(const f32x4*)(sh + 4), c0 = *(const f32x4*)sc, c1 = *(const f32x4*)(sc + 4);
        u32x4 w; w.x = pk2(x0[0] * (1.f + c0[0]) + h0[0], x0[1] * (1.f + c0[1]) + h0[1]); w.y = pk2(x0[2] * (1.f + c0[2]) + h0[2], x0[3] * (1.f + c0[3]) + h0[3]);
        w.z = pk2(x1[0] * (1.f + c1[0]) + h1[0], x1[1] * (1.f + c1[1]) + h1[1]); w.w = pk2(x1[2] * (1.f + c1[2]) + h1[2], x1[3] * (1.f + c1[3]) + h1[3]);
        *(u32x4*)(C.U + e) = w;
    }
}
__device__ __forceinline__ void phase_fix1(const Ctx& C) {
    const int gw = C.vcu * NWAVES + C.wave, NGW = C.G * NWAVES;
    for (int t = gw; t < T; t += NGW) {
        const bf16* pr = C.PROJ + (size_t)t * NPROJ;
        const u32x2 q = *(const u32x2*)(pr + 4 * C.lane); const unsigned kv = *(const unsigned*)(pr + 256 + 2 * C.lane);
        float sq = bflo(q.x) * bflo(q.x) + bfhi(q.x) * bfhi(q.x) + bflo(q.y) * bflo(q.y) + bfhi(q.y) * bfhi(q.y);
        float sk = bflo(kv) * bflo(kv) + bfhi(kv) * bfhi(kv);
        sq = wave_sum(sq); sk = wave_sum(sk);
        if (C.lane == 0) { C.RINVQ[t] = 1.0f / sqrtf(sq * (1.f / 256.f) + RMS_EPS); C.RINVKV[t] = 1.0f / sqrtf(sk * (1.f / 128.f) + RMS_EPS); }
        if (C.lane < 4) { const int fq = C.lane; const u32x4 w = *(const u32x4*)(pr + 384 + 8 * fq);
            const f32x4 c4 = *(const f32x4*)(C.CS + (size_t)t * 16 + 4 * fq), s4 = *(const f32x4*)(C.SN + (size_t)t * 16 + 4 * fq);
            const float t1[4] = {bflo(w.x), bfhi(w.x), bflo(w.y), bfhi(w.y)}, t2[4] = {bflo(w.z), bfhi(w.z), bflo(w.w), bfhi(w.w)};
            float o[8];
#pragma unroll
            for (int i = 0; i < 4; ++i) { o[i] = t1[i] * c4[i] - t2[i] * s4[i]; o[4 + i] = t1[i] * s4[i] + t2[i] * c4[i]; }
            store8_bf16(C.KR + (size_t)t * 32 + 8 * fq, o); }
    }
}
__device__ __forceinline__ void phase_ln1(const Ctx& C) {
    LAS float* wr = (LAS float*)C.lds;
    LAS float* urow = (LAS float*)(C.lds + 65536) + C.wave * 1024;
    for (int i = C.tid; i < 1024 * 4; i += NTHREADS) { const int d = i >> 2, ch = i & 3; const f32x4 v = *(const f32x4*)(C.w_router + d * 16 + 4 * ch);
        *(LAS f32x4*)(wr + d * 16 + 4 * (ch ^ ((d >> 2) & 3))) = v; }
    __syncthreads();
    const int gw = C.vcu * NWAVES + C.wave, NGW = C.G * NWAVES;
    for (int t = gw; t < T; t += NGW) {
        const int b = t >> 11, s = t & 2047;
        const f32x4* yr = (const f32x4*)(C.Y + (size_t)t * DM) + C.lane;
        f32x4 v[4]; float sum = 0.f;
#pragma unroll
        for (int j = 0; j < 4; ++j) { v[j] = yr[64 * j]; sum += (v[j][0] + v[j][1]) + (v[j][2] + v[j][3]); }
        const float mean = wave_sum(sum) * (1.f / DM); float s2 = 0.f;
#pragma unroll
        for (int j = 0; j < 4; ++j) { v[j] = v[j] - mean; s2 += (v[j][0] * v[j][0] + v[j][1] * v[j][1]) + (v[j][2] * v[j][2] + v[j][3] * v[j][3]); }
        const float rstd = 1.0f / sqrtf(wave_sum(s2) * (1.f / DM) + LN_EPS);
        const float* mod = C.MOD + b * 6144;
#pragma unroll
        for (int j = 0; j < 4; ++j) { const int col = 4 * C.lane + 256 * j;
            const f32x4 g = *(const f32x4*)(C.ln1g + col), be = *(const f32x4*)(C.ln1b + col), sh = *(const f32x4*)(mod + 3072 + col), sc = *(const f32x4*)(mod + 4096 + col);
            f32x4 x1, u2;
#pragma unroll
            for (int i = 0; i < 4; ++i) { x1[i] = v[j][i] * rstd * g[i] + be[i]; u2[i] = x1[i] * (1.f + sc[i]) + sh[i]; }
            *(f32x4*)(C.out + (size_t)t * DM + col) = x1;
            u32x2 w; w.x = pk2(u2[0], u2[1]); w.y = pk2(u2[2], u2[3]); *(u32x2*)(C.U2 + (size_t)t * DM + col) = w;
            *(LAS f32x4*)(urow + col) = u2; }
        LDS_WAIT(); asm volatile("" ::: "memory");
        float lg[16];
#pragma unroll
        for (int e = 0; e < 16; ++e) lg[e] = 0.f;
#pragma unroll 4
        for (int k = 0; k < 16; ++k) { const int d = C.lane + 64 * k; const float uv = urow[d]; const int sw = (d >> 2) & 3;
#pragma unroll
            for (int ch = 0; ch < 4; ++ch) { const f32x4 w = *(const LAS f32x4*)(wr + d * 16 + 4 * (ch ^ sw)); lg[4 * ch] += uv * w[0]; lg[4 * ch + 1] += uv * w[1]; lg[4 * ch + 2] += uv * w[2]; lg[4 * ch + 3] += uv * w[3]; } }
        float mx = -1e30f;
#pragma unroll
        for (int e = 0; e < 16; ++e) { lg[e] = wave_sum(lg[e]); mx = fmaxf(mx, lg[e]); }
        float den = 0.f;
#pragma unroll
        for (int e = 0; e < 16; ++e) { lg[e] = expf(lg[e] - mx); den += lg[e]; }
        const float rden = 1.0f / den; float mine = 0.f;
#pragma unroll
        for (int e = 0; e < 16; ++e) mine = (C.lane == e) ? lg[e] * rden : mine;
        if (C.lane < 16) C.AFF[((size_t)b * 16 + C.lane) * SEQ + s] = mine;
        LDS_WAIT(); asm volatile("" ::: "memory");
    }
}
__device__ __forceinline__ unsigned block_count(LAS unsigned* cnt, int wave, int lane, unsigned c) {
    c += __shfl_xor(c, 1); c += __shfl_xor(c, 2); c += __shfl_xor(c, 4); c += __shfl_xor(c, 8); c += __shfl_xor(c, 16); c += __shfl_xor(c, 32);
    __syncthreads();
    if (lane == 0) cnt[wave] = c;
    __syncthreads();
    unsigned s = 0;
#pragma unroll
    for (int w = 0; w < NWAVES; ++w) s += cnt[w];
    return s;
}
__device__ __forceinline__ unsigned block_excl_scan(LAS unsigned* cnt, int wave, int lane, unsigned c) {
    unsigned inc = c;
#pragma unroll
    for (int o = 1; o < 64; o <<= 1) { const unsigned n = __shfl_up(inc, o); if (lane >= o) inc += n; }
    __syncthreads();
    if (lane == 63) cnt[wave] = inc;
    __syncthreads();
    unsigned base = 0;
#pragma unroll
    for (int w = 0; w < NWAVES; ++w) base += (w < wave) ? cnt[w] : 0u;
    return base + inc - c;
}
__device__ __forceinline__ void phase_topk(const Ctx& C) {
    LAS unsigned* cnt = (LAS unsigned*)(C.lds + 4096);
    for (int be = C.vcu; be < BATCH * NE; be += C.G) {
        const int b = be >> 4, e = be & 15;
        const float* aff = C.AFF + ((size_t)b * 16 + e) * SEQ;
        const u32x4 kv = *(const u32x4*)(aff + 4 * C.tid);
        const unsigned key[4] = {kv.x, kv.y, kv.z, kv.w};
        unsigned prefix = 0;
        for (int bit = 30; bit >= 0; --bit) { const unsigned cand = prefix | (1u << bit);
            unsigned c = 0;
#pragma unroll
            for (int i = 0; i < 4; ++i) c += key[i] >= cand ? 1u : 0u;
            if (block_count(cnt, C.wave, C.lane, c) >= (unsigned)CAP) prefix = cand; }
        unsigned cg = 0, ce = 0;
#pragma unroll
        for (int i = 0; i < 4; ++i) { cg += key[i] > prefix ? 1u : 0u; ce += key[i] == prefix ? 1u : 0u; }
        const unsigned ngt = block_count(cnt, C.wave, C.lane, cg);
        const unsigned need = (unsigned)CAP - ngt;
        unsigned tb = block_excl_scan(cnt, C.wave, C.lane, ce);
        unsigned sel[4], cs = 0;
#pragma unroll
        for (int i = 0; i < 4; ++i) { const bool eq = key[i] == prefix; sel[i] = (key[i] > prefix || (eq && tb < need)) ? 1u : 0u; tb += eq ? 1u : 0u; cs += sel[i]; }
        unsigned p = block_excl_scan(cnt, C.wave, C.lane, cs);
#pragma unroll
        for (int i = 0; i < 4; ++i) { const int s = 4 * C.tid + i; int slot = -1;
            if (sel[i]) { slot = (int)p; C.IDX[be * CAP + p] = s; C.GATE[be * CAP + p] = __uint_as_float(key[i]); ++p; }
            C.SLOT[((size_t)b * 16 + e) * SEQ + s] = slot; }
        __syncthreads();
    }
}
__device__ __forceinline__ void phase_wconv(const Ctx& C) {
    LAS float* scr = (LAS float*)(C.lds + 8192 + C.wave * 8448);
    const int gw = C.vcu * NWAVES + C.wave, NGW = C.G * NWAVES;
    constexpr int I_GU = 16 * 128, I_D = 32 * 32, I_E = I_GU + I_D;
    for (int it = gw; it < NE * I_E; it += NGW) {
        const int e = it / I_E; int r = it % I_E;
        if (r < I_GU) { const int kb = r / 128, nb = r % 128, n0 = 32 * nb, pn = n0 >> 8, j = n0 & 255;
            const float* W = (j < 128 ? C.w_gate : C.w_up) + (size_t)e * DM * FF;
            tr_item(W, FF, kb, 128 * pn + (j & 127), false, 1.f, nullptr, DM, C.WGU + (size_t)e * 4096 * DM, DM, n0, scr, C.lane); }
        else { r -= I_GU; const int kb = r / 32, nb = r % 32;
            tr_item(C.w_down + (size_t)e * FF * DM, DM, kb, 32 * nb, false, 1.f, nullptr, FF, C.WD + (size_t)e * DM * FF, FF, 32 * nb, scr, C.lane); }
    }
}
__device__ __forceinline__ void phase_final(const Ctx& C) {
    const int gw = C.vcu * NWAVES + C.wave, NGW = C.G * NWAVES;
    for (int t = gw; t < T; t += NGW) {
        const int b = t >> 11, s = t & 2047;
        f32x4 a[4];
#pragma unroll
        for (int j = 0; j < 4; ++j) a[j] = (f32x4){0.f, 0.f, 0.f, 0.f};
        const int myslot = C.lane < 16 ? C.SLOT[((size_t)b * 16 + C.lane) * SEQ + s] : -1;
        for (int e = 0; e < 16; ++e) { const int p = __shfl(myslot, e);
            if (p >= 0) { const bf16* yr = C.YE + ((size_t)(b * 16 + e) * CAP + p) * DM;
#pragma unroll
                for (int j = 0; j < 4; ++j) { const u32x2 w = *(const u32x2*)(yr + 4 * C.lane + 256 * j); a[j][0] += bflo(w.x); a[j][1] += bfhi(w.x); a[j][2] += bflo(w.y); a[j][3] += bfhi(w.y); } } }
        const float* mod = C.MOD + b * 6144 + 5120;
        f32x4 v[4]; float sum = 0.f;
#pragma unroll
        for (int j = 0; j < 4; ++j) { const int col = 4 * C.lane + 256 * j; const f32x4 x1 = *(const f32x4*)(C.out + (size_t)t * DM + col), g = *(const f32x4*)(mod + col);
#pragma unroll
            for (int i = 0; i < 4; ++i) v[j][i] = ALPHA * x1[i] + g[i] * a[j][i];
            sum += (v[j][0] + v[j][1]) + (v[j][2] + v[j][3]); }
        const float mean = wave_sum(sum) * (1.f / DM); float s2 = 0.f;
#pragma unroll
        for (int j = 0; j < 4; ++j) { v[j] = v[j] - mean; s2 += (v[j][0] * v[j][0] + v[j][1] * v[j][1]) + (v[j][2] * v[j][2] + v[j][3] * v[j][3]); }
        const float rstd = 1.0f / sqrtf(wave_sum(s2) * (1.f / DM) + LN_EPS);
#pragma unroll
        for (int j = 0; j < 4; ++j) { const int col = 4 * C.lane + 256 * j; const f32x4 g = *(const f32x4*)(C.ln2g + col), be = *(const f32x4*)(C.ln2b + col); f32x4 o;
#pragma unroll
            for (int i = 0; i < 4; ++i) o[i] = v[j][i] * rstd * g[i] + be[i];
            *(f32x4*)(C.out + (size_t)t * DM + col) = o; }
    }
}

struct ARowLd { const bf16* A; int lda; __device__ __forceinline__ const bf16* operator()(int m) const { return A + (size_t)m * lda; } };
struct ARowGather { const bf16* A; const int* idx; __device__ __forceinline__ const bf16* operator()(int m) const { const int be = m >> 8; return A + ((size_t)(be >> 4) * SEQ + idx[m]) * DM; } };
struct BRowLd { const bf16* B; int ldb; __device__ __forceinline__ const bf16* operator()(int n, int) const { return B + (size_t)n * ldb; } };
struct BRowExp { const bf16* B; int rows_per_e, ldb, e; __device__ __forceinline__ const bf16* operator()(int n, int) const { return B + ((size_t)e * rows_per_e + n) * ldb; } };
struct BRowGU { const bf16* B; int e; __device__ __forceinline__ const bf16* operator()(int n, int up) const { return B + ((size_t)e * 4096 + (n >> 7) * 256 + (n & 127) + up * 128) * DM; } };

__global__ void __launch_bounds__(NTHREADS) nk_proj(Args a) {
    __shared__ __attribute__((aligned(16))) float lds[48 * 132]; Ctx C; ctx_init(C, a);
    for (int u = blockIdx.x; u < (T / 128) * (NPROJ / 128); u += gridDim.x) { const int pm = u / (NPROJ / 128), pn = u % (NPROJ / 128);
        naive_gemm_tile<false>(pm * 128, pn * 128, DM, ARowLd{C.U, DM}, BRowLd{C.WIN, DM}, FPlain{C.PROJ, NPROJ}, 0, lds); __syncthreads(); }
}
__global__ void __launch_bounds__(NTHREADS) nk_qkv(Args a) {
    __shared__ __attribute__((aligned(16))) float lds[48 * 132]; Ctx C; ctx_init(C, a);
    const FQKV f{C.Q, C.KV, C.RINVQ, C.RINVKV, C.CS, C.SN};
    for (int u = blockIdx.x; u < (T / 128) * 14; u += gridDim.x) { const int pm = u / 14, j = u % 14;
        if (j < 6) naive_gemm_tile<false>(pm * 128, j * 128, 256, ARowLd{C.PROJ, NPROJ}, BRowLd{C.WUQ, 256}, f, 0, lds);
        else naive_gemm_tile<false>(pm * 128, (j - 6) * 128, 256, ARowLd{C.PROJ + 256, NPROJ}, BRowLd{C.WUKV, 256}, f, 1, lds);
        __syncthreads(); }
}
__global__ void __launch_bounds__(NTHREADS) nk_out(Args a) {
    __shared__ __attribute__((aligned(16))) float lds[48 * 132]; Ctx C; ctx_init(C, a);
    for (int u = blockIdx.x; u < (T / 128) * 8; u += gridDim.x) { const int pm = u / 8, pn = u % 8;
        naive_gemm_tile<false>(pm * 128, pn * 128, DM, ARowLd{C.AO, DM}, BRowLd{C.WOUT, DM}, FY{C.Y, C.x, C.MOD}, 0, lds); __syncthreads(); }
}
__global__ void __launch_bounds__(NTHREADS) nk_up(Args a) {
    __shared__ __attribute__((aligned(16))) float lds[48 * 132]; Ctx C; ctx_init(C, a);
    for (int u = blockIdx.x; u < (NSEL / 128) * (FF / 128); u += gridDim.x) { const int pm = u / (FF / 128), pn = u % (FF / 128); const int e = (pm >> 1) & 15;
        naive_gemm_tile<true>(pm * 128, pn * 128, DM, ARowGather{C.U2, C.IDX}, BRowGU{C.WGU, e}, FSwi{C.HLO, C.HHI}, 0, lds); __syncthreads(); }
}
struct ARowH { const bf16* lo; const bf16* hi; __device__ __forceinline__ const bf16* operator()(int m) const { return m < NSEL / 2 ? lo + (size_t)m * FF : hi + (size_t)(m - NSEL / 2) * FF; } };
__global__ void __launch_bounds__(NTHREADS) nk_down(Args a) {
    __shared__ __attribute__((aligned(16))) float lds[48 * 132]; Ctx C; ctx_init(C, a);
    for (int u = blockIdx.x; u < (NSEL / 128) * 8; u += gridDim.x) { const int pm = u / 8, pn = u % 8; const int e = (pm >> 1) & 15;
        naive_gemm_tile<false>(pm * 128, pn * 128, FF, ARowH{C.HLO, C.HHI}, BRowExp{C.WD, DM, FF, e}, FGate{C.YE, C.GATE}, 0, lds); __syncthreads(); }
}
template <int DQK, int DV, bool DIFF>
__device__ __forceinline__ void naive_attn_block(const Ctx& C, int b, int h, int m, int qb, float* lds) {
    float* Ks = lds; float* Vs = lds + 32 * DQK;
    const int tid = threadIdx.x, t = b * SEQ + qb * 256 + tid;
    float q[DQK], o[DV];
#pragma unroll
    for (int d = 0; d < DV; ++d) o[d] = 0.f;
    if (DIFF) {
#pragma unroll
        for (int d = 0; d < DQK; ++d) q[d] = bf2f(C.PROJ[(size_t)t * NPROJ + 512 + (h * 2 + m) * 64 + d]);
    } else {
#pragma unroll
        for (int d = 0; d < 64; ++d) q[d] = bf2f(C.Q[(size_t)t * 768 + h * 64 + d]);
#pragma unroll
        for (int d = 0; d < 32; ++d) q[64 + d] = bf2f(C.Q[(size_t)t * 768 + 512 + h * 32 + d]);
    }
    const int qpos = C.pos[t]; const float* btab = C.MISC + 64 + h * 260 + 128;
    float mx = -1e30f, l = 0.f;
    for (int k0 = 0; k0 < SEQ; k0 += 32) {
        __syncthreads();
        for (int i = tid; i < 32 * DQK; i += 256) { const int kk = i / DQK, d = i % DQK; const size_t kt = (size_t)(b * SEQ + k0 + kk); float v;
            if (DIFF) v = bf2f(C.PROJ[kt * NPROJ + 1024 + (h * 2 + m) * 64 + d]);
            else v = d < 64 ? bf2f(C.KV[kt * 1024 + h * 64 + d]) : bf2f(C.KR[kt * 32 + (d - 64)]);
            Ks[i] = v; }
        for (int i = tid; i < 32 * DV; i += 256) { const int kk = i / DV, d = i % DV; const size_t kt = (size_t)(b * SEQ + k0 + kk);
            Vs[i] = DIFF ? bf2f(C.PROJ[kt * NPROJ + 1536 + h * 128 + d]) : bf2f(C.KV[kt * 1024 + 512 + h * 64 + d]); }
        __syncthreads();
        for (int kk = 0; kk < 32; ++kk) {
            float s = 0.f;
#pragma unroll
            for (int d = 0; d < DQK; d += 4) { const f32x4 kv = *(const f32x4*)(Ks + kk * DQK + d); s += q[d] * kv[0] + q[d + 1] * kv[1] + q[d + 2] * kv[2] + q[d + 3] * kv[3]; }
            if (DIFF) { int rel = C.pos[b * SEQ + k0 + kk] - qpos; rel = rel < -128 ? -128 : (rel > 128 ? 128 : rel); s += btab[rel]; }
            const float mn = fmaxf(mx, s), al = __builtin_amdgcn_exp2f(mx - mn), p = __builtin_amdgcn_exp2f(s - mn);
            mx = mn; l = l * al + p;
#pragma unroll
            for (int d = 0; d < DV; d += 4) { const f32x4 vv = *(const f32x4*)(Vs + kk * DV + d); o[d] = o[d] * al + p * vv[0]; o[d + 1] = o[d + 1] * al + p * vv[1]; o[d + 2] = o[d + 2] * al + p * vv[2]; o[d + 3] = o[d + 3] * al + p * vv[3]; }
        }
    }
    const float rl = 1.0f / l;
    if (DIFF) { float* od = (float*)(C.ws + WS_ODIFF) + ((size_t)m * T + t) * 512 + h * 128;
#pragma unroll
        for (int d = 0; d < DV; d += 4) *(f32x4*)(od + d) = (f32x4){o[d] * rl, o[d + 1] * rl, o[d + 2] * rl, o[d + 3] * rl};
    } else { bf16* ao = C.AO + (size_t)t * DM + h * 64;
#pragma unroll
        for (int d = 0; d < DV; d += 8) { float v[8];
#pragma unroll
            for (int i = 0; i < 8; ++i) v[i] = o[d + i] * rl;
            store8_bf16(ao + d, v); } }
}
__global__ void __launch_bounds__(256) nk_attn_mla(Args a) {
    __shared__ __attribute__((aligned(16))) float lds[32 * 96 + 32 * 64]; Ctx C; ctx_init(C, a);
    const int u = blockIdx.x; naive_attn_block<96, 64, false>(C, u >> 6, (u >> 3) & 7, 0, u & 7, lds);
}
__global__ void __launch_bounds__(256) nk_attn_diff(Args a) {
    __shared__ __attribute__((aligned(16))) float lds[32 * 64 + 32 * 128]; Ctx C; ctx_init(C, a);
    const int u = blockIdx.x; naive_attn_block<64, 128, true>(C, u >> 6, (u >> 4) & 3, (u >> 3) & 1, u & 7, lds);
}
__global__ void __launch_bounds__(256) nk_attn_diff_combine(Args a) {
    Ctx C; ctx_init(C, a); const int lane = threadIdx.x & 63; const float lam = C.MISC[0];
    const float* od = (const float*)(C.ws + WS_ODIFF);
    for (int w = blockIdx.x * 4 + (threadIdx.x >> 6); w < T * 4; w += gridDim.x * 4) { const int t = w >> 2, h = w & 3;
        const f32x2 o0 = *(const f32x2*)(od + (size_t)t * 512 + h * 128 + 2 * lane), o1 = *(const f32x2*)(od + ((size_t)T + t) * 512 + h * 128 + 2 * lane);
        const float a0 = o0[0] - lam * o1[0], a1 = o0[1] - lam * o1[1];
        const float r = 1.0f / sqrtf(wave_sum(a0 * a0 + a1 * a1) * (1.f / 128.f) + RMS_EPS);
        const float v0 = a0 * r * C.subln[2 * lane] * (1.f - LAMBDA_INIT), v1 = a1 * r * C.subln[2 * lane + 1] * (1.f - LAMBDA_INIT);
        *(unsigned*)(C.AO + (size_t)t * DM + 512 + h * 128 + 2 * lane) = pk2(v0, v1); }
}

constexpr int NPHASE = 11;
__global__ void __launch_bounds__(NTHREADS, 2) mega(Args args) {
    extern __shared__ __attribute__((aligned(16))) unsigned char lds[];
    Ctx C; ctx_init(C, args);
    C.lds = (LAS unsigned char*)lds; C.lds_g = lds;
    C.tid = threadIdx.x; C.lane = C.tid & 63; C.wave = __builtin_amdgcn_readfirstlane(C.tid >> 6);
    C.G = gridDim.x; { const int bx = blockIdx.x; C.vcu = (C.G % 8 == 0) ? (bx % 8) * (C.G / 8) + bx / 8 : bx; }
    volatile LAS unsigned* MISCL = (volatile LAS unsigned*)(C.lds + MISC_OFF);
    for (int u = C.tid; u < (LDS_BYTES - LDSCTL_OFF) / 4; u += NTHREADS) ((LAS unsigned*)(C.lds + LDSCTL_OFF))[u] = 0u;
    __syncthreads();
    const int lo = args.ph_lo, hi = args.ph_hi;
    XcdBarrier bar; bar.bar = (unsigned*)(args.ws + WS_CTL) + CW_BAR + args.li * XCD_BAR_WORDS; bar.x = 0; bar.st = nullptr;
    if (hi - lo > 1) bar = xcd_barrier_post((unsigned*)(args.ws + WS_CTL) + CW_BAR + args.li * XCD_BAR_WORDS, MISCL + 8);
#define IN(k) (lo <= (k) && (k) < hi)
#define SEAM(k) do { if (IN(k) && IN((k) + 1)) xcd_barrier(bar); } while (0)
    if (IN(0)) { phase_prep(C); } SEAM(0);
    if (IN(1)) { phase_u(C); } SEAM(1);
    if (IN(2)) { phase_fix1(C); } SEAM(2);
    SEAM(3); SEAM(4); SEAM(5);
    if (IN(6)) { phase_ln1(C); } SEAM(6);
    if (IN(7)) { phase_topk(C); phase_wconv(C); } SEAM(7);
    SEAM(8); SEAM(9);
    if (IN(10)) { phase_final(C); }
#undef IN
#undef SEAM
}

static void launch_mega(const Args& base, int lo, int hi, int li, int grid, hipStream_t stream) {
    Args a = base; a.ph_lo = lo; a.ph_hi = hi; a.li = li;
    hipLaunchKernelGGL(mega, dim3(grid), dim3(NTHREADS), LDS_BYTES, stream, a);
}
extern "C" void kernel_launch(void* const* d_in, const int* in_sizes, int n_in, void* d_out, int out_size, void* d_ws, size_t ws_size, hipStream_t stream) {
    static int grid = 0;
    if (grid == 0) {
        if (n_in != 25 || out_size != T * DM || ws_size < WS_END) { fprintf(stderr, "kernel_launch: unexpected shapes (n_in %d out %d ws %zu, need %zu)\n", n_in, out_size, ws_size, (size_t)WS_END); grid = -1; return; }
        int dev = 0, cus = 0;
        if (hipGetDevice(&dev) != hipSuccess || hipDeviceGetAttribute(&cus, hipDeviceAttributeMultiprocessorCount, dev) != hipSuccess) { grid = -1; return; }
        if (hipFuncSetAttribute((const void*)mega, hipFuncAttributeMaxDynamicSharedMemorySize, LDS_BYTES) != hipSuccess) { fprintf(stderr, "kernel_launch: hipFuncSetAttribute failed\n"); grid = -1; return; }
        int per_cu = 0; (void)hipOccupancyMaxActiveBlocksPerMultiprocessor(&per_cu, (const void*)mega, NTHREADS, LDS_BYTES); (void)hipGetLastError();
        if (per_cu < 1) fprintf(stderr, "kernel_launch: occupancy query reports %d\n", per_cu);
        grid = cus;
        if (grid != 256) fprintf(stderr, "kernel_launch: %d CUs (built for 256)\n", grid);
    }
    if (grid < 0) return;
    (void)hipMemsetAsync((char*)d_ws + WS_CTL, 0, CTL_BYTES, stream);
    Args a{};
    for (int i = 0; i < 25; ++i) a.in[i] = d_in[i];
    a.out = (float*)d_out; a.ws = (unsigned char*)d_ws;
    launch_mega(a, 0, 2, 0, grid, stream);
    hipLaunchKernelGGL(nk_proj, dim3(1024), dim3(NTHREADS), 0, stream, a);
    launch_mega(a, 2, 3, 1, grid, stream);
    hipLaunchKernelGGL(nk_qkv, dim3(1024), dim3(NTHREADS), 0, stream, a);
    hipLaunchKernelGGL(nk_attn_mla, dim3(1024), dim3(256), 0, stream, a);
    hipLaunchKernelGGL(nk_attn_diff, dim3(1024), dim3(256), 0, stream, a);
    hipLaunchKernelGGL(nk_attn_diff_combine, dim3(2048), dim3(256), 0, stream, a);
    hipLaunchKernelGGL(nk_out, dim3(1024), dim3(NTHREADS), 0, stream, a);
    launch_mega(a, 6, 8, 2, grid, stream);
    hipLaunchKernelGGL(nk_up, dim3(2048), dim3(NTHREADS), 0, stream, a);
    hipLaunchKernelGGL(nk_down, dim3(1024), dim3(NTHREADS), 0, stream, a);
    launch_mega(a, 10, 11, 3, grid, stream);
}
```

```cpp
#include <hip/hip_runtime.h>
#include <cstdio>
#include <cstdint>

#ifndef CFG_OPT_MASK
#define CFG_OPT_MASK 1652
#endif
#ifndef CFG_ONE_LAUNCH
#define CFG_ONE_LAUNCH 0
#endif

constexpr int BATCH = 16, SEQ = 2048, DM = 1024, T = BATCH * SEQ;
constexpr int NE = 16, FF = 2048, CAP = 256, NSEL = BATCH * NE * CAP;
constexpr int NPROJ = 2048;
constexpr float LOG2E = 1.4426950408889634f;
constexpr float MLA_SCALE = 0.10206207261596575f;
constexpr float DIFF_SCALE = 0.125f;
constexpr float ALPHA = 1.189207115002721f;
constexpr float LN_EPS = 1e-5f, RMS_EPS = 1e-6f;
constexpr float LAMBDA_INIT = 0.2f;

constexpr size_t MiB = 1u << 20;
constexpr size_t WS_CTL = 0, CTL_BYTES = 1 * MiB;
constexpr size_t WS_MOD = 1 * MiB;
constexpr size_t WS_MISC = 1 * MiB + 512 * 1024;
constexpr size_t WS_PMM = 1 * MiB + 768 * 1024;
constexpr size_t WS_CS = 2 * MiB, WS_SN = 4 * MiB;
constexpr size_t WS_AFF = 6 * MiB;
constexpr size_t WS_IDX = 8 * MiB, WS_GATE = 8 * MiB + 512 * 1024;
constexpr size_t WS_SLOT = 9 * MiB;
constexpr size_t WS_RINVQ = 11 * MiB, WS_RINVKV = 11 * MiB + 256 * 1024;
constexpr size_t WS_KR = 12 * MiB;
constexpr size_t WS_WIN = 14 * MiB, WS_WUQ = 18 * MiB, WS_WUKV = 18 * MiB + 512 * 1024, WS_WOUT = 19 * MiB;
constexpr size_t WS_WD = 22 * MiB;
constexpr size_t WS_WGU = 86 * MiB;
constexpr size_t WS_YE = WS_WGU;
constexpr size_t WS_PROJ = 214 * MiB;
constexpr size_t WS_Y = WS_PROJ, WS_HLO = WS_PROJ;
constexpr size_t WS_Q = 342 * MiB;
constexpr size_t WS_KV = 390 * MiB;
constexpr size_t WS_U2 = 342 * MiB;
constexpr size_t WS_U = 454 * MiB, WS_AO = 454 * MiB;
constexpr size_t WS_HHI = 406 * MiB;
constexpr size_t WS_END = 534 * MiB;
constexpr size_t WS_ODIFF = WS_WGU;

#define GAS __attribute__((address_space(1)))
#define LAS __attribute__((address_space(3)))
typedef unsigned short bf16;
typedef short bf16x8 __attribute__((ext_vector_type(8)));
typedef float f32x4 __attribute__((ext_vector_type(4)));
typedef float f32x2 __attribute__((ext_vector_type(2)));
typedef unsigned u32x4 __attribute__((ext_vector_type(4)));
typedef unsigned u32x2 __attribute__((ext_vector_type(2)));
typedef GAS unsigned gu32;
#define RLX_AGENT __ATOMIC_RELAXED, __HIP_MEMORY_SCOPE_AGENT
#define LDS_WAIT() asm volatile("s_waitcnt lgkmcnt(0)" ::: "memory")
#define VM_WAIT() asm volatile("s_waitcnt vmcnt(0)" ::: "memory")
__device__ __forceinline__ unsigned f2bf(float f) { unsigned u = __builtin_bit_cast(unsigned, f); return (u + 0x7fffu + ((u >> 16) & 1u)) >> 16; }
__device__ __forceinline__ unsigned pk2(float lo, float hi) { return f2bf(lo) | (f2bf(hi) << 16); }
__device__ __forceinline__ float bflo(unsigned w) { return __uint_as_float(w << 16); }
__device__ __forceinline__ float bfhi(unsigned w) { return __uint_as_float(w & 0xffff0000u); }
__device__ __forceinline__ float bf2f(bf16 h) { return __uint_as_float((unsigned)h << 16); }
__device__ __forceinline__ float wave_sum(float v) {
#pragma unroll
    for (int o = 1; o < 64; o <<= 1) v += __shfl_xor(v, o);
    return v;
}
__device__ __forceinline__ float wave_max(float v) {
#pragma unroll
    for (int o = 1; o < 64; o <<= 1) v = fmaxf(v, __shfl_xor(v, o));
    return v;
}
__device__ __forceinline__ float silu_f(float g) { return g * __builtin_amdgcn_rcpf(1.0f + __builtin_amdgcn_exp2f(-g * LOG2E)); }

#define XB_TMO      128
#define XB_XCNT(j)  (256  + 64 * (j))
#define XB_XSUB(j)  (1280 + 64 * (j))
#define XB_XGEN(j)  (2304 + 64 * (j))
#define XB_TOP      3328
#define XB_TOPGEN   3392
#define XCD_BAR_WORDS 3456
#define XB_SPIN_CAP (1u << 18)
__device__ __forceinline__ unsigned xb_ld(unsigned* p)              { return __hip_atomic_load(p, __ATOMIC_RELAXED, __HIP_MEMORY_SCOPE_AGENT); }
__device__ __forceinline__ unsigned xb_add(unsigned* p, unsigned v) { return __hip_atomic_fetch_add(p, v, __ATOMIC_RELAXED, __HIP_MEMORY_SCOPE_AGENT); }
__device__ __forceinline__ unsigned xb_xcc_id() { return (unsigned)__builtin_amdgcn_s_getreg((3 << 11) | 20) & 0xFu; }
#define XB_SPIN(cond, bar) do { unsigned _sp = 0; while (cond) { __builtin_amdgcn_s_sleep(1); \
    if ((++_sp & 255u) == 0u) { if (xb_ld(&(bar)[XB_TMO])) break; if (_sp > XB_SPIN_CAP) { atomicAdd(&(bar)[XB_TMO], 1u); break; } } } } while (0)
struct XcdBarrier { unsigned* bar; unsigned x; volatile LAS unsigned* st; };
__device__ __forceinline__ XcdBarrier xcd_barrier_post(unsigned* bar, volatile LAS unsigned* st) {
    XcdBarrier b; b.bar = bar; b.x = xb_xcc_id(); b.st = st;
    if (threadIdx.x == 0) (void)xb_add(&bar[XB_XCNT(b.x)], 1u);
    return b;
}
__device__ __forceinline__ void xcd_barrier_complete(unsigned* bar, unsigned x, unsigned& nloc, unsigned& nx) {
    const unsigned G = gridDim.x * gridDim.y * gridDim.z;
    unsigned sum, cnt, mine, sp = 0u;
    for (;;) {
        sum = 0u; cnt = 0u; mine = 0u;
#pragma unroll
        for (unsigned j = 0; j < 16; ++j) { const unsigned c = xb_ld(&bar[XB_XCNT(j)]); sum += c; cnt += (c > 0u) ? 1u : 0u; mine = (j == x) ? c : mine; }
        if (sum == G) break;
        __builtin_amdgcn_s_sleep(1);
        if ((++sp & 255u) == 0u) { if (xb_ld(&bar[XB_TMO])) break; if (sp > XB_SPIN_CAP) { atomicAdd(&bar[XB_TMO], 1u); break; } }
    }
    nloc = mine > 0u ? mine : 1u; nx = cnt > 0u ? cnt : 1u;
}
__device__ __forceinline__ void xcd_barrier(const XcdBarrier& b) {
    asm volatile("s_waitcnt vmcnt(0)" ::: "memory");
    __syncthreads();
    if (threadIdx.x == 0) {
        unsigned* bar = b.bar;
        __builtin_amdgcn_s_waitcnt(0);
        unsigned nloc = b.st[0], nx = b.st[1];
        if (nloc == 0u) { xcd_barrier_complete(bar, b.x, nloc, nx); b.st[0] = nloc; b.st[1] = nx; }
        const unsigned old = xb_add(&bar[XB_XSUB(b.x)], 1u);
        const unsigned gen = old / nloc;
        if (old + 1u == (gen + 1u) * nloc) {
            __builtin_amdgcn_fence(__ATOMIC_RELEASE, "agent");
            asm volatile("s_waitcnt vmcnt(0)" ::: "memory");
            const unsigned og = xb_add(&bar[XB_TOP], 1u);
            const unsigned tg = og / nx;
            if (og + 1u == (tg + 1u) * nx) xb_add(&bar[XB_TOPGEN], 1u);
            else XB_SPIN(xb_ld(&bar[XB_TOPGEN]) == tg, bar);
            __builtin_amdgcn_fence(__ATOMIC_ACQUIRE, "agent");
            xb_add(&bar[XB_XGEN(b.x)], 1u);
            asm volatile("s_waitcnt vmcnt(0)" ::: "memory");
        } else {
            XB_SPIN(xb_ld(&bar[XB_XGEN(b.x)]) == gen, bar);
            __builtin_amdgcn_fence(__ATOMIC_ACQUIRE, "agent");
            asm volatile("s_waitcnt vmcnt(0)" ::: "memory");
        }
    }
    __syncthreads();
}

constexpr int NWAVES = 8, NTHREADS = 512;
constexpr int RING_BYTES = 131072, LDSCTL_OFF = RING_BYTES, MISC_OFF = LDSCTL_OFF + 320, LDS_BYTES = 147456;
constexpr int CW_BAR = 4096;

struct Args { const void* in[25]; float* out; unsigned char* ws; int ph_lo, ph_hi, li, pad; };

struct Ctx {
    LAS unsigned char* lds; unsigned char* lds_g;
    int tid, lane, wave, vcu, G;
    const float *x, *c, *rel_bias, *w_ada, *b_ada, *w_in, *qnorm, *w_uq, *kvnorm, *w_ukv, *lq1, *lk1, *lq2, *lk2, *subln, *w_out, *ln1g, *ln1b, *w_router, *w_gate, *w_up, *w_down, *ln2g, *ln2b;
    const int* pos;
    float* out; unsigned char* ws;
    float *MOD, *MISC, *CS, *SN, *AFF, *GATE, *RINVQ, *RINVKV, *Y;
    int *PMM, *IDX, *SLOT;
    bf16 *KR, *WIN, *WUQ, *WUKV, *WOUT, *WD, *WGU, *YE, *PROJ, *Q, *KV, *U2, *U, *AO, *HLO, *HHI;
};
__device__ __forceinline__ void ctx_init(Ctx& C, const Args& a) {
    C.x = (const float*)a.in[0]; C.c = (const float*)a.in[1]; C.pos = (const int*)a.in[2]; C.rel_bias = (const float*)a.in[3];
    C.w_ada = (const float*)a.in[4]; C.b_ada = (const float*)a.in[5]; C.w_in = (const float*)a.in[6]; C.qnorm = (const float*)a.in[7];
    C.w_uq = (const float*)a.in[8]; C.kvnorm = (const float*)a.in[9]; C.w_ukv = (const float*)a.in[10];
    C.lq1 = (const float*)a.in[11]; C.lk1 = (const float*)a.in[12]; C.lq2 = (const float*)a.in[13]; C.lk2 = (const float*)a.in[14];
    C.subln = (const float*)a.in[15]; C.w_out = (const float*)a.in[16]; C.ln1g = (const float*)a.in[17]; C.ln1b = (const float*)a.in[18];
    C.w_router = (const float*)a.in[19]; C.w_gate = (const float*)a.in[20]; C.w_up = (const float*)a.in[21]; C.w_down = (const float*)a.in[22];
    C.ln2g = (const float*)a.in[23]; C.ln2b = (const float*)a.in[24];
    C.out = a.out; unsigned char* ws = a.ws; C.ws = ws;
    C.MOD = (float*)(ws + WS_MOD); C.MISC = (float*)(ws + WS_MISC); C.PMM = (int*)(ws + WS_PMM); C.CS = (float*)(ws + WS_CS); C.SN = (float*)(ws + WS_SN);
    C.AFF = (float*)(ws + WS_AFF); C.IDX = (int*)(ws + WS_IDX); C.GATE = (float*)(ws + WS_GATE); C.SLOT = (int*)(ws + WS_SLOT);
    C.RINVQ = (float*)(ws + WS_RINVQ); C.RINVKV = (float*)(ws + WS_RINVKV); C.KR = (bf16*)(ws + WS_KR);
    C.WIN = (bf16*)(ws + WS_WIN); C.WUQ = (bf16*)(ws + WS_WUQ); C.WUKV = (bf16*)(ws + WS_WUKV); C.WOUT = (bf16*)(ws + WS_WOUT);
    C.WD = (bf16*)(ws + WS_WD); C.WGU = (bf16*)(ws + WS_WGU); C.YE = (bf16*)(ws + WS_YE);
    C.PROJ = (bf16*)(ws + WS_PROJ); C.Y = (float*)(ws + WS_Y); C.HLO = (bf16*)(ws + WS_HLO); C.HHI = (bf16*)(ws + WS_HHI);
    C.Q = (bf16*)(ws + WS_Q); C.KV = (bf16*)(ws + WS_KV); C.U2 = (bf16*)(ws + WS_U2); C.U = (bf16*)(ws + WS_U); C.AO = (bf16*)(ws + WS_AO);
}

__device__ __forceinline__ void store8_bf16(bf16* p, const float (&v)[8]) {
    u32x4 w; w.x = pk2(v[0], v[1]); w.y = pk2(v[2], v[3]); w.z = pk2(v[4], v[5]); w.w = pk2(v[6], v[7]); *(u32x4*)p = w;
}
struct FPlain { bf16* O; int ldc;
    __device__ __forceinline__ void row8(int kind, int row, int col, const float (&v)[8]) const { store8_bf16(O + (size_t)row * ldc + col, v); } };
struct FRowScale { bf16* O; int ldc; const float* rs;
    __device__ __forceinline__ void row8(int kind, int row, int col, const float (&v)[8]) const {
        const float s = rs[row]; float o[8];
#pragma unroll
        for (int i = 0; i < 8; ++i) o[i] = v[i] * s;
        store8_bf16(O + (size_t)row * ldc + col, o);
    } };
struct FY { float* Y; const float* x; const float* mod;
    __device__ __forceinline__ void row8(int kind, int row, int col, const float (&v)[8]) const {
        const int b = row >> 11; const float* ga = mod + b * 6144 + 2048 + col; const float* xr = x + (size_t)row * DM + col; float* yo = Y + (size_t)row * DM + col;
        const f32x4 g0 = *(const f32x4*)ga, g1 = *(const f32x4*)(ga + 4), x0 = *(const f32x4*)xr, x1 = *(const f32x4*)(xr + 4);
        f32x4 y0, y1;
#pragma unroll
        for (int i = 0; i < 4; ++i) { y0[i] = ALPHA * x0[i] + g0[i] * v[i]; y1[i] = ALPHA * x1[i] + g1[i] * v[4 + i]; }
        *(f32x4*)yo = y0; *(f32x4*)(yo + 4) = y1;
    } };
struct FSwi { bf16* HLO; bf16* HHI;
    __device__ __forceinline__ void pair8(int row, int col, const float (&g)[8], const float (&u)[8]) const {
        float o[8];
#pragma unroll
        for (int i = 0; i < 8; ++i) o[i] = silu_f(g[i]) * u[i];
        bf16* p = (row < NSEL / 2) ? HLO + (size_t)row * FF : HHI + (size_t)(row - NSEL / 2) * FF;
        store8_bf16(p + col, o);
    } };
struct FGate { bf16* YE; const float* gate;
    __device__ __forceinline__ void row8(int kind, int row, int col, const float (&v)[8]) const {
        const float s = gate[row]; float o[8];
#pragma unroll
        for (int i = 0; i < 8; ++i) o[i] = v[i] * s;
        store8_bf16(YE + (size_t)row * DM + col, o);
    } };

template <bool DUAL, class ARow, class BRow, class Epi>
__device__ __forceinline__ void naive_gemm_tile(int m0, int n0, int K, const ARow& arow, const BRow& brow, const Epi& epi, int kind, float* lds) {
    const int tid = threadIdx.x, ty = tid >> 4, tx = tid & 15;
    float* As = lds;
    float* Bs = lds + 16 * 132;
    float* Cs = lds + 32 * 132;
    float acc[4][8], acc2[4][8];
#pragma unroll
    for (int i = 0; i < 4; ++i)
#pragma unroll
        for (int j = 0; j < 8; ++j) { acc[i][j] = 0.f; acc2[i][j] = 0.f; }
    const int lr = tid >> 2, lk = (tid & 3) * 4;
    const bf16* ap = arow(m0 + lr); const bf16* bp = brow(n0 + lr, 0); const bf16* cp = DUAL ? brow(n0 + lr, 1) : bp;
    for (int k0 = 0; k0 < K; k0 += 16) {
        const u32x2 av = *(const u32x2*)(ap + k0 + lk), bv = *(const u32x2*)(bp + k0 + lk);
        u32x2 cv = bv; if (DUAL) cv = *(const u32x2*)(cp + k0 + lk);
        __syncthreads();
        As[(lk + 0) * 132 + lr] = bflo(av.x); As[(lk + 1) * 132 + lr] = bfhi(av.x); As[(lk + 2) * 132 + lr] = bflo(av.y); As[(lk + 3) * 132 + lr] = bfhi(av.y);
        Bs[(lk + 0) * 132 + lr] = bflo(bv.x); Bs[(lk + 1) * 132 + lr] = bfhi(bv.x); Bs[(lk + 2) * 132 + lr] = bflo(bv.y); Bs[(lk + 3) * 132 + lr] = bfhi(bv.y);
        if (DUAL) { Cs[(lk + 0) * 132 + lr] = bflo(cv.x); Cs[(lk + 1) * 132 + lr] = bfhi(cv.x); Cs[(lk + 2) * 132 + lr] = bflo(cv.y); Cs[(lk + 3) * 132 + lr] = bfhi(cv.y); }
        __syncthreads();
#pragma unroll
        for (int kk = 0; kk < 16; ++kk) {
            const f32x4 a = *(const f32x4*)(As + kk * 132 + ty * 4);
            const f32x4 b0 = *(const f32x4*)(Bs + kk * 132 + tx * 8), b1 = *(const f32x4*)(Bs + kk * 132 + tx * 8 + 4);
#pragma unroll
            for (int i = 0; i < 4; ++i)
#pragma unroll
                for (int j = 0; j < 4; ++j) { acc[i][j] += a[i] * b0[j]; acc[i][4 + j] += a[i] * b1[j]; }
            if (DUAL) {
                const f32x4 c0 = *(const f32x4*)(Cs + kk * 132 + tx * 8), c1 = *(const f32x4*)(Cs + kk * 132 + tx * 8 + 4);
#pragma unroll
                for (int i = 0; i < 4; ++i)
#pragma unroll
                    for (int j = 0; j < 4; ++j) { acc2[i][j] += a[i] * c0[j]; acc2[i][4 + j] += a[i] * c1[j]; }
            }
        }
    }
#pragma unroll
    for (int i = 0; i < 4; ++i) {
        if constexpr (DUAL) epi.pair8(m0 + ty * 4 + i, n0 + tx * 8, acc[i], acc2[i]);
        else epi.row8(kind, m0 + ty * 4 + i, n0 + tx * 8, acc[i]);
    }
}

__device__ __forceinline__ void tr_item(const float* W, int ldw, int kb, int srccol0, bool perm, float scale, const float* kgain, int kvalid,
                                        bf16* WT, int ldt, int n0, LAS float* scr, int lane) {
    const int k0 = 64 * kb, cl = lane & 31;
    const int sc = perm ? (16 * ((cl >> 2) & 1) + 4 * (cl >> 3) + (cl & 3)) : cl;
#pragma unroll 8
    for (int i = 0; i < 32; ++i) { const int kk = 2 * i + (lane >> 5), k = k0 + kk; float v = 0.f;
        if (srccol0 >= 0 && k < kvalid) { v = W[(size_t)k * ldw + srccol0 + sc] * scale; if (kgain) v *= kgain[k]; }
        scr[kk * 33 + cl] = v; }
    LDS_WAIT(); asm volatile("" ::: "memory");
    const int c = lane & 7;
#pragma unroll
    for (int j = 0; j < 4; ++j) { const int n = (lane >> 3) + 8 * j; const LAS float* s = scr + (8 * c) * 33 + n;
        u32x4 o; o.x = pk2(s[0 * 33], s[1 * 33]); o.y = pk2(s[2 * 33], s[3 * 33]); o.z = pk2(s[4 * 33], s[5 * 33]); o.w = pk2(s[6 * 33], s[7 * 33]);
        *(GAS u32x4*)(WT + (size_t)(n0 + n) * ldt + k0 + 8 * c) = o; }
    LDS_WAIT(); asm volatile("" ::: "memory");
}
__device__ __forceinline__ int t5_bucket(int rel) {
    const int nb = 16, max_exact = 8; int ret = rel > 0 ? nb : 0; const int n = rel < 0 ? -rel : rel;
    const float nf = (float)(n > 1 ? n : 1);
    int large = max_exact + (int)(logf(nf / 8.0f) / 2.772588722239781f * 8.0f);
    large = large < nb - 1 ? large : nb - 1;
    return ret + (n < max_exact ? n : large);
}

__device__ __forceinline__ void phase_prep(const Ctx& C) {
    LAS float* scr = (LAS float*)(C.lds + C.wave * 8448);
    const int gw = C.vcu * NWAVES + C.wave, NGW = C.G * NWAVES;
    constexpr int I_IN = 16 * 64, I_UQ = 4 * 24, I_UKV = 4 * 32, I_OUT = 16 * 32, NIT = I_IN + I_UQ + I_UKV + I_OUT;
    for (int it = gw; it < NIT; it += NGW) {
        int r = it;
        if (r < I_IN) { const int kb = r / 64, nb = r % 64, n0 = 32 * nb; int src; bool perm = false; float sc = 1.f;
            if (nb < 12) src = n0; else if (nb == 12) { src = 384; perm = true; } else if (nb < 16) src = -1; else { src = 416 + (n0 - 512); if (n0 < 1024) sc = DIFF_SCALE * LOG2E; }
            tr_item(C.w_in, 1952, kb, src, perm, sc, nullptr, 1024, C.WIN, 1024, n0, scr, C.lane); continue; }
        r -= I_IN;
        if (r < I_UQ) { const int kb = r / 24, nb = r % 24, n0 = 32 * nb; int src; bool perm = false;
            if (nb < 16) { src = 96 * (n0 >> 6) + (n0 & 63); } else { src = 96 * (nb - 16) + 64; perm = true; }
            tr_item(C.w_uq, 768, kb, src, perm, MLA_SCALE * LOG2E, C.qnorm, 256, C.WUQ, 256, n0, scr, C.lane); continue; }
        r -= I_UQ;
        if (r < I_UKV) { const int kb = r / 32, nb = r % 32, n0 = 32 * nb; int src;
            if (nb < 16) src = 128 * (n0 >> 6) + (n0 & 63); else { const int n1 = n0 - 512; src = 128 * (n1 >> 6) + 64 + (n1 & 63); }
            tr_item(C.w_ukv, 1024, kb, src, false, 1.f, C.kvnorm, 128, C.WUKV, 256, n0, scr, C.lane); continue; }
        r -= I_UKV;
        { const int kb = r / 32, nb = r % 32; tr_item(C.w_out, 1024, kb, 32 * nb, false, 1.f, nullptr, 1024, C.WOUT, 1024, 32 * nb, scr, C.lane); }
    }
    for (int i = (C.vcu * NTHREADS + C.tid); i < T * 16; i += C.G * NTHREADS) { const int t = i >> 4, j = i & 15;
        const float freq = (float)pow(10000.0, -(double)j / 16.0); const float ang = (float)C.pos[t] * freq; float s, c; sincosf(ang, &s, &c);
        C.CS[i] = c; C.SN[i] = s; }
    for (int i = (C.vcu * NTHREADS + C.tid); i < BATCH * 32; i += C.G * NTHREADS) { int mn = 0x7fffffff, mx = -0x7fffffff - 1;
        for (int k = 0; k < 64; ++k) { const int p = C.pos[i * 64 + k]; mn = p < mn ? p : mn; mx = p > mx ? p : mx; }
        C.PMM[2 * i] = mn; C.PMM[2 * i + 1] = mx; }
    if (C.vcu == 255 % C.G) {
        for (int i = C.tid; i < 4 * 257; i += NTHREADS) { const int h = i / 257, r = i % 257 - 128; C.MISC[64 + h * 260 + (r + 128)] = C.rel_bias[t5_bucket(r) * 4 + h] * LOG2E; }
        if (C.wave == 0) { const float a = wave_sum(C.lq1[C.lane] * C.lk1[C.lane]), b = wave_sum(C.lq2[C.lane] * C.lk2[C.lane]);
            if (C.lane == 0) C.MISC[0] = expf(a) - expf(b) + LAMBDA_INIT; }
    }
    __syncthreads();
    LAS float* cact = (LAS float*)C.lds;
    LAS float* red = (LAS float*)(C.lds + 65536);
    bool have = false;
    for (int u = C.vcu; u < 192; u += C.G) {
        if (!have) { for (int i = C.tid; i < 16 * 1024; i += NTHREADS) { const int b = i >> 10, d = i & 1023; const float v = C.c[i]; cact[d * 16 + b] = v / (1.0f + expf(-v)); } have = true; __syncthreads(); }
        const int nl = C.tid & 31, kc = C.tid >> 5, n = 32 * u + nl;
        float acc[16];
#pragma unroll
        for (int b = 0; b < 16; ++b) acc[b] = 0.f;
#pragma unroll 8
        for (int i = 0; i < 64; ++i) { const int d = kc * 64 + i; const float w = C.w_ada[(size_t)d * 6144 + n];
#pragma unroll
            for (int q = 0; q < 4; ++q) { const f32x4 ca = *(const LAS f32x4*)(cact + d * 16 + 4 * q); acc[4 * q] += w * ca[0]; acc[4 * q + 1] += w * ca[1]; acc[4 * q + 2] += w * ca[2]; acc[4 * q + 3] += w * ca[3]; } }
#pragma unroll
        for (int b = 0; b < 16; ++b) red[(kc * 16 + b) * 32 + nl] = acc[b];
        __syncthreads();
        { const int b = C.tid >> 5; float s = C.b_ada[n];
#pragma unroll
            for (int k = 0; k < 16; ++k) s += red[(k * 16 + b) * 32 + nl];
            C.MOD[b * 6144 + n] = s; }
        __syncthreads();
    }
}
__device__ __forceinline__ void phase_u(const Ctx& C) {
    for (size_t i = (size_t)C.vcu * NTHREADS + C.tid; i < (size_t)T * DM / 8; i += (size_t)C.G * NTHREADS) {
        const size_t e = i * 8; const int row = (int)(e >> 10), col = (int)(e & 1023), b = row >> 11;
        const f32x4 x0 = *(const f32x4*)(C.x + e), x1 = *(const f32x4*)(C.x + e + 4);
        const float* sh = C.MOD + b * 6144 + col; const float* sc = sh + 1024;
        const f32x4 h0 = *(const f32x4*)sh, h1 = *(const f32x4*)(sh + 4), c0 = *(const f32x4*)sc, c1 = *(const f32x4*)(sc + 4);
        u32x4 w; w.x = pk2(x0[0] * (1.f + c0[0]) + h0[0], x0[1] * (1.f + c0[1]) + h0[1]); w.y = pk2(x0[2] * (1.f + c0[2]) + h0[2], x0[3] * (1.f + c0[3]) + h0[3]);
        w.z = pk2(x1[0] * (1.f + c1[0]) + h1[0], x1[1] * (1.f + c1[1]) + h1[1]); w.w = pk2(x1[2] * (1.f + c1[2]) + h1[2], x1[3] * (1.f + c1[3]) + h1[3]);
        *(u32x4*)(C.U + e) = w;
    }
}
__device__ __forceinline__ void phase_fix1(const Ctx& C) {
    const int gw = C.vcu * NWAVES + C.wave, NGW = C.G * NWAVES;
    for (int t = gw; t < T; t += NGW) {
        const bf16* pr = C.PROJ + (size_t)t * NPROJ;
        const u32x2 q = *(const u32x2*)(pr + 4 * C.lane); const unsigned kv = *(const unsigned*)(pr + 256 + 2 * C.lane);
        float sq = bflo(q.x) * bflo(q.x) + bfhi(q.x) * bfhi(q.x) + bflo(q.y) * bflo(q.y) + bfhi(q.y) * bfhi(q.y);
        float sk = bflo(kv) * bflo(kv) + bfhi(kv) * bfhi(kv);
        sq = wave_sum(sq); sk = wave_sum(sk);
        if (C.lane == 0) { C.RINVQ[t] = 1.0f / sqrtf(sq * (1.f / 256.f) + RMS_EPS); C.RINVKV[t] = 1.0f / sqrtf(sk * (1.f / 128.f) + RMS_EPS); }
        if (C.lane < 4) { const int fq = C.lane; const u32x4 w = *(const u32x4*)(pr + 384 + 8 * fq);
            const f32x4 c4 = *(const f32x4*)(C.CS + (size_t)t * 16 + 4 * fq), s4 = *(const f32x4*)(C.SN + (size_t)t * 16 + 4 * fq);
            const float t1[4] = {bflo(w.x), bfhi(w.x), bflo(w.y), bfhi(w.y)}, t2[4] = {bflo(w.z), bfhi(w.z), bflo(w.w), bfhi(w.w)};
            float o[8];
#pragma unroll
            for (int i = 0; i < 4; ++i) { o[i] = t1[i] * c4[i] - t2[i] * s4[i]; o[4 + i] = t1[i] * s4[i] + t2[i] * c4[i]; }
            store8_bf16(C.KR + (size_t)t * 32 + 8 * fq, o); }
    }
}
__device__ __forceinline__ void phase_ln1(const Ctx& C) {
    LAS float* wr = (LAS float*)C.lds;
    LAS float* urow = (LAS float*)(C.lds + 65536) + C.wave * 1024;
    for (int i = C.tid; i < 1024 * 4; i += NTHREADS) { const int d = i >> 2, ch = i & 3; const f32x4 v = *(const f32x4*)(C.w_router + d * 16 + 4 * ch);
        *(LAS f32x4*)(wr + d * 16 + 4 * (ch ^ ((d >> 2) & 3))) = v; }
    __syncthreads();
    const int gw = C.vcu * NWAVES + C.wave, NGW = C.G * NWAVES;
    for (int t = gw; t < T; t += NGW) {
        const int b = t >> 11, s = t & 2047;
        const f32x4* yr = (const f32x4*)(C.Y + (size_t)t * DM) + C.lane;
        f32x4 v[4]; float sum = 0.f;
#pragma unroll
        for (int j = 0; j < 4; ++j) { v[j] = yr[64 * j]; sum += (v[j][0] + v[j][1]) + (v[j][2] + v[j][3]); }
        const float mean = wave_sum(sum) * (1.f / DM); float s2 = 0.f;
#pragma unroll
        for (int j = 0; j < 4; ++j) { v[j] = v[j] - mean; s2 += (v[j][0] * v[j][0] + v[j][1] * v[j][1]) + (v[j][2] * v[j][2] + v[j][3] * v[j][3]); }
        const float rstd = 1.0f / sqrtf(wave_sum(s2) * (1.f / DM) + LN_EPS);
        const float* mod = C.MOD + b * 6144;
#pragma unroll
        for (int j = 0; j < 4; ++j) { const int col = 4 * C.lane + 256 * j;
            const f32x4 g = *(const f32x4*)(C.ln1g + col), be = *(const f32x4*)(C.ln1b + col), sh = *(const f32x4*)(mod + 3072 + col), sc = *(const f32x4*)(mod + 4096 + col);
            f32x4 x1, u2;
#pragma unroll
            for (int i = 0; i < 4; ++i) { x1[i] = v[j][i] * rstd * g[i] + be[i]; u2[i] = x1[i] * (1.f + sc[i]) + sh[i]; }
            *(f32x4*)(C.out + (size_t)t * DM + col) = x1;
            u32x2 w; w.x = pk2(u2[0], u2[1]); w.y = pk2(u2[2], u2[3]); *(u32x2*)(C.U2 + (size_t)t * DM + col) = w;
            *(LAS f32x4*)(urow + col) = u2; }
        LDS_WAIT(); asm volatile("" ::: "memory");
        float lg[16];
#pragma unroll
        for (int e = 0; e < 16; ++e) lg[e] = 0.f;
#pragma unroll 4
        for (int k = 0; k < 16; ++k) { const int d = C.lane + 64 * k; const float uv = urow[d]; const int sw = (d >> 2) & 3;
#pragma unroll
            for (int ch = 0; ch < 4; ++ch) { const f32x4 w = *(const LAS f32x4*)(wr + d * 16 + 4 * (ch ^ sw)); lg[4 * ch] += uv * w[0]; lg[4 * ch + 1] += uv * w[1]; lg[4 * ch + 2] += uv * w[2]; lg[4 * ch + 3] += uv * w[3]; } }
        float mx = -1e30f;
#pragma unroll
        for (int e = 0; e < 16; ++e) { lg[e] = wave_sum(lg[e]); mx = fmaxf(mx, lg[e]); }
        float den = 0.f;
#pragma unroll
        for (int e = 0; e < 16; ++e) { lg[e] = expf(lg[e] - mx); den += lg[e]; }
        const float rden = 1.0f / den; float mine = 0.f;
#pragma unroll
        for (int e = 0; e < 16; ++e) mine = (C.lane == e) ? lg[e] * rden : mine;
        if (C.lane < 16) C.AFF[((size_t)b * 16 + C.lane) * SEQ + s] = mine;
        LDS_WAIT(); asm volatile("" ::: "memory");
    }
}
__device__ __forceinline__ unsigned block_count(LAS unsigned* cnt, int wave, int lane, unsigned c) {
    c += __shfl_xor(c, 1); c += __shfl_xor(c, 2); c += __shfl_xor(c, 4); c += __shfl_xor(c, 8); c += __shfl_xor(c, 16); c += __shfl_xor(c, 32);
    __syncthreads();
    if (lane == 0) cnt[wave] = c;
    __syncthreads();
    unsigned s = 0;
#pragma unroll
    for (int w = 0; w < NWAVES; ++w) s += cnt[w];
    return s;
}
__device__ __forceinline__ unsigned block_excl_scan(LAS unsigned* cnt, int wave, int lane, unsigned c) {
    unsigned inc = c;
#pragma unroll
    for (int o = 1; o < 64; o <<= 1) { const unsigned n = __shfl_up(inc, o); if (lane >= o) inc += n; }
    __syncthreads();
    if (lane == 63) cnt[wave] = inc;
    __syncthreads();
    unsigned base = 0;
#pragma unroll
    for (int w = 0; w < NWAVES; ++w) base += (w < wave) ? cnt[w] : 0u;
    return base + inc - c;
}
__device__ __forceinline__ void phase_topk(const Ctx& C) {
    LAS unsigned* cnt = (LAS unsigned*)(C.lds + 4096);
    for (int be = C.vcu; be < BATCH * NE; be += C.G) {
        const int b = be >> 4, e = be & 15;
        const float* aff = C.AFF + ((size_t)b * 16 + e) * SEQ;
        const u32x4 kv = *(const u32x4*)(aff + 4 * C.tid);
        const unsigned key[4] = {kv.x, kv.y, kv.z, kv.w};
        unsigned prefix = 0;
        for (int bit = 30; bit >= 0; --bit) { const unsigned cand = prefix | (1u << bit);
            unsigned c = 0;
#pragma unroll
            for (int i = 0; i < 4; ++i) c += key[i] >= cand ? 1u : 0u;
            if (block_count(cnt, C.wave, C.lane, c) >= (unsigned)CAP) prefix = cand; }
        unsigned cg = 0, ce = 0;
#pragma unroll
        for (int i = 0; i < 4; ++i) { cg += key[i] > prefix ? 1u : 0u; ce += key[i] == prefix ? 1u : 0u; }
        const unsigned ngt = block_count(cnt, C.wave, C.lane, cg);
        const unsigned need = (unsigned)CAP - ngt;
        unsigned tb = block_excl_scan(cnt, C.wave, C.lane, ce);
        unsigned sel[4], cs = 0;
#pragma unroll
        for (int i = 0; i < 4; ++i) { const bool eq = key[i] == prefix; sel[i] = (key[i] > prefix || (eq && tb < need)) ? 1u : 0u; tb += eq ? 1u : 0u; cs += sel[i]; }
        unsigned p = block_excl_scan(cnt, C.wave, C.lane, cs);
#pragma unroll
        for (int i = 0; i < 4; ++i) { const int s = 4 * C.tid + i; int slot = -1;
            if (sel[i]) { slot = (int)p; C.IDX[be * CAP + p] = s; C.GATE[be * CAP + p] = __uint_as_float(key[i]); ++p; }
            C.SLOT[((size_t)b * 16 + e) * SEQ + s] = slot; }
        __syncthreads();
    }
}
__device__ __forceinline__ void phase_wconv(const Ctx& C) {
    LAS float* scr = (LAS float*)(C.lds + 8192 + C.wave * 8448);
    const int gw = C.vcu * NWAVES + C.wave, NGW = C.G * NWAVES;
    constexpr int I_GU = 16 * 128, I_D = 32 * 32, I_E = I_GU + I_D;
    for (int it = gw; it < NE * I_E; it += NGW) {
        const int e = it / I_E; int r = it % I_E;
        if (r < I_GU) { const int kb = r / 128, nb = r % 128, n0 = 32 * nb, pn = n0 >> 8, j = n0 & 255;
            const float* W = (j < 128 ? C.w_gate : C.w_up) + (size_t)e * DM * FF;
            tr_item(W, FF, kb, 128 * pn + (j & 127), false, 1.f, nullptr, DM, C.WGU + (size_t)e * 4096 * DM, DM, n0, scr, C.lane); }
        else { r -= I_GU; const int kb = r / 32, nb = r % 32;
            tr_item(C.w_down + (size_t)e * FF * DM, DM, kb, 32 * nb, false, 1.f, nullptr, FF, C.WD + (size_t)e * DM * FF, FF, 32 * nb, scr, C.lane); }
    }
}
__device__ __forceinline__ void phase_final(const Ctx& C) {
    const int gw = C.vcu * NWAVES + C.wave, NGW = C.G * NWAVES;
    for (int t = gw; t < T; t += NGW) {
        const int b = t >> 11, s = t & 2047;
        f32x4 a[4];
#pragma unroll
        for (int j = 0; j < 4; ++j) a[j] = (f32x4){0.f, 0.f, 0.f, 0.f};
        const int myslot = C.lane < 16 ? C.SLOT[((size_t)b * 16 + C.lane) * SEQ + s] : -1;
        for (int e = 0; e < 16; ++e) { const int p = __shfl(myslot, e);
            if (p >= 0) { const bf16* yr = C.YE + ((size_t)(b * 16 + e) * CAP + p) * DM;
#pragma unroll
                for (int j = 0; j < 4; ++j) { const u32x2 w = *(const u32x2*)(yr + 4 * C.lane + 256 * j); a[j][0] += bflo(w.x); a[j][1] += bfhi(w.x); a[j][2] += bflo(w.y); a[j][3] += bfhi(w.y); } } }
        const float* mod = C.MOD + b * 6144 + 5120;
        f32x4 v[4]; float sum = 0.f;
#pragma unroll
        for (int j = 0; j < 4; ++j) { const int col = 4 * C.lane + 256 * j; const f32x4 x1 = *(const f32x4*)(C.out + (size_t)t * DM + col), g = *(const f32x4*)(mod + col);
#pragma unroll
            for (int i = 0; i < 4; ++i) v[j][i] = ALPHA * x1[i] + g[i] * a[j][i];
            sum += (v[j][0] + v[j][1]) + (v[j][2] + v[j][3]); }
        const float mean = wave_sum(sum) * (1.f / DM); float s2 = 0.f;
#pragma unroll
        for (int j = 0; j < 4; ++j) { v[j] = v[j] - mean; s2 += (v[j][0] * v[j][0] + v[j][1] * v[j][1]) + (v[j][2] * v[j][2] + v[j][3] * v[j][3]); }
        const float rstd = 1.0f / sqrtf(wave_sum(s2) * (1.f / DM) + LN_EPS);
#pragma unroll
        for (int j = 0; j < 4; ++j) { const int col = 4 * C.lane + 256 * j; const f32x4 g = *(const f32x4*)(C.ln2g + col), be = *(const f32x4*)(C.ln2b + col); f32x4 o;
#pragma unroll
            for (int i = 0; i < 4; ++i) o[i] = v[j][i] * rstd * g[i] + be[i];
            *(f32x4*)(C.out + (size_t)t * DM + col) = o; }
    }
}


namespace pg8 {
#define PG8_LAS __attribute__((address_space(3)))
constexpr int BM = 256, BK = 64, HALF = 128, HTB = HALF * BK * 2, STAGE_BYTES = 8 * HTB;
__host__ __device__ __forceinline__ int lds_byte(int r, int c) { const int st = (r >> 4) * 2 + (c >> 5), rr = r & 15, cc = c & 31, ob = rr * 64 + cc * 2; return st * 1024 + (ob ^ (((ob >> 9) & 1) << 5)); }
__host__ __device__ __forceinline__ void stage_rc(int b, int& R, int& C) { const int st = b / 1024, sb = b % 1024, swz = sb ^ (((sb >> 9) & 1) << 5); R = (st >> 1) * 16 + swz / 64; C = (st & 1) * 32 + (swz % 64) / 2; }
__host__ __device__ __forceinline__ int perm32(int rho) { const int n = rho >> 4, i = rho & 15; return 8 * (i >> 2) + 4 * n + (i & 3); }
struct Unit { int pm, pn, kind; };

template <class F> struct EpiRow8 { static constexpr bool PERM = true; F f;
    __device__ __forceinline__ void operator()(const f32x4 (&acc)[2][2][4][2], const Unit& u, int wr, int wc, int fr, int fq) const {
        const int row0 = u.pm * BM + wr * 64 + fr, col0 = u.pn * BM + wc * 32 + 8 * fq;
#pragma unroll
        for (int ai = 0; ai < 2; ++ai)
#pragma unroll
            for (int m = 0; m < 4; ++m)
#pragma unroll
                for (int bj = 0; bj < 2; ++bj) { const f32x4 a = acc[ai][bj][m][0], b = acc[ai][bj][m][1]; const float v[8] = {a[0], a[1], a[2], a[3], b[0], b[1], b[2], b[3]};
                    f.row8(u.kind, row0 + ai * HALF + m * 16, col0 + bj * HALF, v); }
    } };
struct EpiQKV { static constexpr bool PERM = true; FRowScale fq, fkv;
    __device__ __forceinline__ void operator()(const f32x4 (&acc)[2][2][4][2], const Unit& u, int wr, int wc, int fr, int fq_) const {
        EpiRow8<FRowScale> e{u.kind ? fkv : fq}; e(acc, u, wr, wc, fr, fq_);
    } };
template <class F> struct EpiPair8 { static constexpr bool PERM = true; F f;
    __device__ __forceinline__ void operator()(const f32x4 (&acc)[2][2][4][2], const Unit& u, int wr, int wc, int fr, int fq) const {
        const int row0 = u.pm * BM + wr * 64 + fr, col0 = u.pn * HALF + wc * 32 + 8 * fq;
#pragma unroll
        for (int ai = 0; ai < 2; ++ai)
#pragma unroll
            for (int m = 0; m < 4; ++m) { const f32x4 a = acc[ai][0][m][0], b = acc[ai][0][m][1], c = acc[ai][1][m][0], d = acc[ai][1][m][1];
                const float g[8] = {a[0], a[1], a[2], a[3], b[0], b[1], b[2], b[3]}, up[8] = {c[0], c[1], c[2], c[3], d[0], d[1], d[2], d[3]};
                f.pair8(row0 + ai * HALF + m * 16, col0, g, up); }
    } };

template <class Epi, class Sched, bool ALIGN_EPI = true, bool SP2 = true>
__device__ __forceinline__ void gemm_phase(PG8_LAS unsigned char* lds, const int K, const Sched& S, const Epi& E) {
    const int tid = threadIdx.x, wid = __builtin_amdgcn_readfirstlane(tid >> 6), lane = tid & 63, wr = wid >> 2, wc = wid & 3, fr = lane & 15, fq = lane >> 4;
    const int nt = K / BK;
    Unit cur, nxt; int ui = 0;
    if (!S.next(0, cur)) return;
    unsigned voffA[2][2], voffB[2];
#pragma unroll
    for (int i = 0; i < 2; ++i) { int R, C; stage_rc(tid * 16 + i * 8192, R, C); const int Rb = Epi::PERM ? ((R & ~31) + perm32(R & 31)) : R;
        voffB[i] = (unsigned)(Rb * S.ldb + C) * 2u;
#pragma unroll
        for (int h = 0; h < 2; ++h) voffA[h][i] = S.a_rowoff(cur, h * HALF + R) + (unsigned)C * 2u; }
    const size_t kstep = (size_t)(BK * 2);
    const size_t hstepB = (size_t)HALF * S.ldb * 2;
    const unsigned ldsw = (unsigned)wid * 1024u;
    const int aoff = lds_byte(wr * 64 + fr, fq * 8), boff = lds_byte(wc * 32 + fr, fq * 8);
#define PG8_SA(b, h) (((b) * 2 + (h)) * HTB)
#define PG8_SB(b, h) ((4 + (b) * 2 + (h)) * HTB)
#define PG8_STAGE_A(bufoff, gbase, h) do { _Pragma("unroll") for (int _i = 0; _i < 2; ++_i) \
        __builtin_amdgcn_global_load_lds((const unsigned*)((const char*)(gbase) + voffA[h][_i]), (PG8_LAS unsigned*)(lds + (bufoff) + ldsw + _i * 8192), 16, 0, 0); } while (0)
#define PG8_STAGE_B(bufoff, gbase) do { _Pragma("unroll") for (int _i = 0; _i < 2; ++_i) \
        __builtin_amdgcn_global_load_lds((const unsigned*)((const char*)(gbase) + voffB[_i]), (PG8_LAS unsigned*)(lds + (bufoff) + ldsw + _i * 8192), 16, 0, 0); } while (0)
#define PG8_LDA(dst, b, h) do { _Pragma("unroll") for (int m = 0; m < 4; ++m) _Pragma("unroll") for (int k = 0; k < 2; ++k) dst[m][k] = *(const PG8_LAS bf16x8*)(lds + PG8_SA(b, h) + aoff + m * 2048 + k * 1024); } while (0)
#define PG8_LDB(dst, b, h) do { _Pragma("unroll") for (int n = 0; n < 2; ++n) _Pragma("unroll") for (int k = 0; k < 2; ++k) dst[n][k] = *(const PG8_LAS bf16x8*)(lds + PG8_SB(b, h) + boff + n * 2048 + k * 1024); } while (0)
#define PG8_MMA(ai, bj, At, Bt) do { __builtin_amdgcn_s_setprio(1); _Pragma("unroll") for (int m = 0; m < 4; ++m) _Pragma("unroll") for (int n = 0; n < 2; ++n) _Pragma("unroll") for (int k = 0; k < 2; ++k) \
        acc[ai][bj][m][n] = __builtin_amdgcn_mfma_f32_16x16x32_bf16(Bt[n][k], At[m][k], acc[ai][bj][m][n], 0, 0, 0); __builtin_amdgcn_s_setprio(0); } while (0)
#define PG8_WAIT_V(n) asm volatile("s_waitcnt vmcnt(" #n ")" ::: "memory")
#define PG8_WAIT_L(n) asm volatile("s_waitcnt lgkmcnt(" #n ")" ::: "memory")
#define PG8_BAR __builtin_amdgcn_s_barrier()
#define PG8_SCHED __builtin_amdgcn_sched_barrier(0)
    f32x4 acc[2][2][4][2];
#pragma unroll
    for (int a = 0; a < 2; ++a)
#pragma unroll
        for (int b = 0; b < 2; ++b)
#pragma unroll
            for (int m = 0; m < 4; ++m)
#pragma unroll
                for (int n = 0; n < 2; ++n) acc[a][b][m][n] = (f32x4){0.f, 0.f, 0.f, 0.f};
    bf16x8 At[4][2], B0[2][2], B1[2][2];
    const char* cA = S.a_base(cur); const char* cB = S.b_base(cur);
    if constexpr (SP2) {
        PG8_STAGE_B(PG8_SB(0, 0), cB); PG8_STAGE_B(PG8_SB(0, 1), cB + hstepB); PG8_STAGE_A(PG8_SA(0, 0), cA, 0); PG8_STAGE_A(PG8_SA(0, 1), cA, 1);
        if (wr == 1) PG8_BAR;
        PG8_WAIT_V(2); PG8_BAR;
        PG8_STAGE_B(PG8_SB(1, 0), cB + kstep); PG8_STAGE_A(PG8_SA(1, 0), cA + kstep, 0); PG8_STAGE_B(PG8_SB(1, 1), cB + hstepB + kstep);
        PG8_WAIT_V(6); PG8_BAR;
    } else {
        PG8_STAGE_B(PG8_SB(0, 0), cB); PG8_STAGE_A(PG8_SA(0, 0), cA, 0); PG8_STAGE_B(PG8_SB(0, 1), cB + hstepB); PG8_STAGE_A(PG8_SA(0, 1), cA, 1);
        if (wr == 1) PG8_BAR;
        PG8_WAIT_V(4); PG8_BAR;
        PG8_STAGE_B(PG8_SB(1, 0), cB + kstep); PG8_STAGE_A(PG8_SA(1, 0), cA + kstep, 0); PG8_STAGE_B(PG8_SB(1, 1), cB + hstepB + kstep);
        PG8_WAIT_V(6); PG8_BAR;
    }
    for (;;) {
        const bool has_next = S.next(ui + 1, nxt);
        const char* nA = has_next ? S.a_base(nxt) : cA; const char* nB = has_next ? S.b_base(nxt) : cB;
#pragma unroll 1
        for (int t = 0; t < nt; t += 2) {
            const bool last = (t == nt - 2);
            const char* a1 = cA + (size_t)(t + 1) * kstep;
            const char* a2 = last ? nA : cA + (size_t)(t + 2) * kstep; const char* b2 = last ? nB : cB + (size_t)(t + 2) * kstep;
            const char* a3 = a2 + kstep; const char* b3 = b2 + kstep;
            if constexpr (SP2) {
            PG8_LDB(B0, 0, 0); PG8_LDB(B1, 0, 1); PG8_SCHED; PG8_LDA(At, 0, 0); PG8_STAGE_A(PG8_SA(1, 1), a1, 1);
            PG8_WAIT_V(8); PG8_WAIT_L(0); PG8_BAR; PG8_MMA(0, 0, At, B0); PG8_MMA(0, 1, At, B1); PG8_BAR; PG8_SCHED;
            PG8_LDA(At, 0, 1); PG8_STAGE_B(PG8_SB(0, 0), b2); PG8_STAGE_B(PG8_SB(0, 1), b2 + hstepB); PG8_STAGE_A(PG8_SA(0, 0), a2, 0);
            PG8_WAIT_V(8); PG8_WAIT_L(0); PG8_BAR; PG8_MMA(1, 0, At, B0); PG8_MMA(1, 1, At, B1); PG8_BAR; PG8_SCHED;
            PG8_LDB(B0, 1, 0); PG8_LDB(B1, 1, 1); PG8_SCHED; PG8_LDA(At, 1, 0); PG8_STAGE_A(PG8_SA(0, 1), a2, 1);
            PG8_WAIT_V(8); PG8_WAIT_L(0); PG8_BAR; PG8_MMA(0, 0, At, B0); PG8_MMA(0, 1, At, B1); PG8_BAR; PG8_SCHED;
            PG8_LDA(At, 1, 1); PG8_STAGE_B(PG8_SB(1, 0), b3); PG8_STAGE_B(PG8_SB(1, 1), b3 + hstepB); PG8_STAGE_A(PG8_SA(1, 0), a3, 0);
            PG8_WAIT_V(8); PG8_WAIT_L(0); PG8_BAR; PG8_MMA(1, 0, At, B0); PG8_MMA(1, 1, At, B1); PG8_BAR; PG8_SCHED;
            } else {
            PG8_LDB(B0, 0, 0); PG8_SCHED; PG8_LDA(At, 0, 0); PG8_STAGE_A(PG8_SA(1, 1), a1, 1);
            PG8_WAIT_L(8); PG8_BAR; PG8_WAIT_L(0); PG8_MMA(0, 0, At, B0); PG8_BAR; PG8_SCHED;
            PG8_LDB(B1, 0, 1); PG8_STAGE_B(PG8_SB(0, 0), b2);
            PG8_BAR; PG8_WAIT_L(0); PG8_MMA(0, 1, At, B1); PG8_BAR;
            PG8_LDA(At, 0, 1); PG8_STAGE_A(PG8_SA(0, 0), a2, 0);
            PG8_BAR; PG8_WAIT_L(0); PG8_MMA(1, 0, At, B0); PG8_BAR; PG8_SCHED;
            PG8_STAGE_B(PG8_SB(0, 1), b2 + hstepB);
            PG8_WAIT_V(6); PG8_BAR; PG8_MMA(1, 1, At, B1); PG8_BAR;
            PG8_LDB(B0, 1, 0); PG8_SCHED; PG8_LDA(At, 1, 0); PG8_STAGE_A(PG8_SA(0, 1), a2, 1);
            PG8_WAIT_L(8); PG8_BAR; PG8_WAIT_L(0); PG8_MMA(0, 0, At, B0); PG8_BAR; PG8_SCHED;
            PG8_LDB(B1, 1, 1); PG8_STAGE_B(PG8_SB(1, 0), b3);
            PG8_BAR; PG8_WAIT_L(0); PG8_MMA(0, 1, At, B1); PG8_BAR;
            PG8_LDA(At, 1, 1); PG8_STAGE_A(PG8_SA(1, 0), a3, 0);
            PG8_BAR; PG8_WAIT_L(0); PG8_MMA(1, 0, At, B0); PG8_BAR; PG8_SCHED;
            PG8_STAGE_B(PG8_SB(1, 1), b3 + hstepB);
            PG8_WAIT_V(6); PG8_BAR; PG8_MMA(1, 1, At, B1); PG8_BAR;
            }
        }
        if constexpr (ALIGN_EPI) { if (wr == 0) PG8_BAR; }
        E(acc, cur, wr, wc, fr, fq);
        if (!has_next) break;
#pragma unroll
        for (int a = 0; a < 2; ++a)
#pragma unroll
            for (int b = 0; b < 2; ++b)
#pragma unroll
                for (int m = 0; m < 4; ++m)
#pragma unroll
                    for (int n = 0; n < 2; ++n) acc[a][b][m][n] = (f32x4){0.f, 0.f, 0.f, 0.f};
        cur = nxt; cA = nA; cB = nB; ++ui;
        if constexpr (ALIGN_EPI) { if (wr == 1) PG8_BAR; }
    }
    PG8_WAIT_V(0);
    if constexpr (!ALIGN_EPI) { if (wr == 0) PG8_BAR; }
    PG8_BAR;
#undef PG8_SA
#undef PG8_SB
#undef PG8_STAGE_A
#undef PG8_STAGE_B
#undef PG8_LDA
#undef PG8_LDB
#undef PG8_MMA
#undef PG8_WAIT_V
#undef PG8_WAIT_L
#undef PG8_BAR
#undef PG8_SCHED
}
struct SchedDense {
    const char* A; const char* Bt; int lda, ldb; int nM, nN, nwg, G, c;
    __device__ __forceinline__ void init(const void* A_, int lda_, const void* Bt_, int ldb_, int M, int N, int G_, int c_) { A = (const char*)A_; Bt = (const char*)Bt_; lda = lda_; ldb = ldb_; nM = M / BM; nN = N / BM; nwg = nM * nN; G = G_; c = c_; }
    __device__ __forceinline__ bool next(int i, Unit& u) const {
        const long L = (long)i * G + c; if (L >= nwg) return false;
        int wgid = (int)L; { const int q = nwg / 8, r = nwg % 8, xcd = wgid % 8, off = wgid / 8; wgid = (xcd < r ? xcd * (q + 1) : r * (q + 1) + (xcd - r) * q) + off; }
        const int nig = 8 * nN, gid = wgid / nig, fm = gid * 8, gsz = (nM - fm) < 8 ? (nM - fm) : 8;
        u.pm = fm + ((wgid % nig) % gsz); u.pn = (wgid % nig) / gsz; u.kind = 0; return true;
    }
    __device__ __forceinline__ const char* a_base(const Unit& u) const { return A + (size_t)u.pm * BM * lda * 2; }
    __device__ __forceinline__ const char* b_base(const Unit& u) const { return Bt + (size_t)u.pn * BM * ldb * 2; }
    __device__ __forceinline__ unsigned a_rowoff(const Unit&, int r) const { return (unsigned)(r * lda) * 2u; }
};
struct SchedQKV {
    const char* proj; const char* wuq; const char* wukv; int lda, ldb; int G, vcu;
    __device__ __forceinline__ bool next(int i, Unit& u) const {
        const int L = i * G + vcu; if (L >= (T / BM) * 7) return false;
        u.pm = L / 7; const int j = L % 7; u.kind = j < 3 ? 0 : 1; u.pn = j < 3 ? j : j - 3; return true; }
    __device__ __forceinline__ const char* a_base(const Unit& u) const { return proj + ((size_t)u.pm * BM * NPROJ + (u.kind == 1 ? 256 : 0)) * 2; }
    __device__ __forceinline__ const char* b_base(const Unit& u) const { return (u.kind == 1 ? wukv : wuq) + (size_t)u.pn * BM * 256 * 2; }
    __device__ __forceinline__ unsigned a_rowoff(const Unit&, int r) const { return (unsigned)(r * lda) * 2u; }
};
__device__ __forceinline__ int be_of_vcu(int vcu) { const int x = vcu >> 5, j = vcu & 31; return (j & 15) * 16 + 2 * x + (j >> 4); }
struct SchedUp {
    const char* u2; const int* idx; const char* wgu; int lda, ldb; int G, vcu;
    __device__ __forceinline__ bool next(int i, Unit& u) const { if (i >= 16 || vcu >= 256) return false; u.pm = be_of_vcu(vcu); u.pn = i; u.kind = 0; return true; }
    __device__ __forceinline__ const char* a_base(const Unit& u) const { return u2 + (size_t)(u.pm >> 4) * SEQ * DM * 2; }
    __device__ __forceinline__ const char* b_base(const Unit& u) const { return wgu + ((size_t)(u.pm & 15) * 4096 + (size_t)u.pn * BM) * DM * 2; }
    __device__ __forceinline__ unsigned a_rowoff(const Unit& u, int r) const { return (unsigned)idx[u.pm * CAP + r] * (unsigned)(DM * 2); }
};
struct SchedDown {
    const char* hlo; const char* hhi; const char* wd; int lda, ldb; int G, vcu;
    __device__ __forceinline__ bool next(int i, Unit& u) const { if (i >= 4 || vcu >= 256) return false; u.pm = be_of_vcu(vcu); u.pn = i; u.kind = 0; return true; }
    __device__ __forceinline__ const char* a_base(const Unit& u) const { return u.pm < 128 ? hlo + (size_t)u.pm * BM * FF * 2 : hhi + (size_t)(u.pm - 128) * BM * FF * 2; }
    __device__ __forceinline__ const char* b_base(const Unit& u) const { return wd + ((size_t)(u.pm & 15) * DM + (size_t)u.pn * BM) * FF * 2; }
    __device__ __forceinline__ unsigned a_rowoff(const Unit&, int r) const { return (unsigned)(r * lda) * 2u; }
};
}


namespace att {
using f32x16 = __attribute__((ext_vector_type(16))) float;
using s16x4  = __attribute__((ext_vector_type(4))) short;
constexpr int SHM_V = 16384, SHM_K = 16384;
constexpr int L_V = 0, L_K = 2 * SHM_V, L_WS = L_K + 2 * SHM_K, L_KPOS = L_WS + 8 * 64 * 4, L_TAB = L_KPOS + SEQ * 4, L_Q = L_TAB + 272 * 4, L_END = L_Q + 8 * 4096;
#ifndef ATT_SDEPTH
#define ATT_SDEPTH 2
#endif
constexpr float THR2 = 11.5f;
#define ATT_KSWZ(row, colB) ((row) * 256 + ((colB) ^ (((row) & 7) << 4)))
#define ATT_SBAR() __builtin_amdgcn_sched_barrier(0)
__device__ __forceinline__ int crow(int r, int hi) { return (r & 3) + 8 * (r >> 2) + 4 * hi; }
__device__ __forceinline__ unsigned cvtpk(float lo, float hi) { unsigned r; asm volatile("v_cvt_pk_bf16_f32 %0, %1, %2" : "=v"(r) : "v"(lo), "v"(hi)); return r; }
__device__ __forceinline__ int v_st(int k, int c) { const int kk = (k & ~0xC) | ((k & 4) << 1) | ((k & 8) >> 1); return ((kk >> 3) * 4 + (c >> 5)) * 512 + ((kk & 7) * 32 + (c & 31)) * 2; }
__device__ __forceinline__ int v_rd_base(int lane) { return ((lane & 3) << 3) | (((lane >> 2) & 3) << 6) | (((lane >> 4) & 1) << 5) | (((lane >> 5) & 1) << 8); }
constexpr int v_rd_off(int d0, int ks, int half) { return d0 * 512 + ks * 4096 + half * 2048; }
template <int OFF> __device__ __forceinline__ s16x4 tr_read(int vb) { s16x4 r; asm volatile("ds_read_b64_tr_b16 %0, %1 offset:%2" : "=&v"(r) : "v"(vb), "i"(OFF) : "memory"); return r; }
template <int D0> __device__ __forceinline__ void pv_one(f32x16& od, int vb, bf16x8 pa0, bf16x8 pa1, bf16x8 pa2, bf16x8 pa3) {
    const s16x4 l0 = tr_read<v_rd_off(D0, 0, 0)>(vb), h0 = tr_read<v_rd_off(D0, 0, 1)>(vb), l1 = tr_read<v_rd_off(D0, 1, 0)>(vb), h1 = tr_read<v_rd_off(D0, 1, 1)>(vb);
    const s16x4 l2 = tr_read<v_rd_off(D0, 2, 0)>(vb), h2 = tr_read<v_rd_off(D0, 2, 1)>(vb), l3 = tr_read<v_rd_off(D0, 3, 0)>(vb), h3 = tr_read<v_rd_off(D0, 3, 1)>(vb);
    asm volatile("s_waitcnt lgkmcnt(0)" ::: "memory"); ATT_SBAR();
#define ATT_PK(L, H) (bf16x8){L[0], L[1], L[2], L[3], H[0], H[1], H[2], H[3]}
    od = __builtin_amdgcn_mfma_f32_32x32x16_bf16(pa0, ATT_PK(l0, h0), od, 0, 0, 0);
    od = __builtin_amdgcn_mfma_f32_32x32x16_bf16(pa1, ATT_PK(l1, h1), od, 0, 0, 0);
    od = __builtin_amdgcn_mfma_f32_32x32x16_bf16(pa2, ATT_PK(l2, h2), od, 0, 0, 0);
    od = __builtin_amdgcn_mfma_f32_32x32x16_bf16(pa3, ATT_PK(l3, h3), od, 0, 0, 0);
#undef ATT_PK
}
template <int NDV> __device__ __forceinline__ void pv_all(f32x16 (&o)[NDV], int vb, bf16x8 pa0, bf16x8 pa1, bf16x8 pa2, bf16x8 pa3) {
    pv_one<0>(o[0], vb, pa0, pa1, pa2, pa3); pv_one<1>(o[1], vb, pa0, pa1, pa2, pa3);
    if constexpr (NDV == 4) { pv_one<2>(o[2], vb, pa0, pa1, pa2, pa3); pv_one<3>(o[3], vb, pa0, pa1, pa2, pa3); }
}
template <int NDQ, bool QLDS> __device__ __forceinline__ void qkt(f32x16& p0, f32x16& p1, const LAS char* Kl, const bf16x8 (&qr)[NDQ], const LAS char* ql, int r32, int hi, float cinit) {
#pragma unroll
    for (int r = 0; r < 16; ++r) { p0[r] = cinit; p1[r] = cinit; }
#pragma unroll
    for (int d0 = 0; d0 < NDQ; ++d0) { const int cb = (d0 * 16 + hi * 8) * 2;
        const bf16x8 b0 = *(const LAS bf16x8*)(Kl + ATT_KSWZ(r32, cb)), b1 = *(const LAS bf16x8*)(Kl + ATT_KSWZ(32 + r32, cb));
        bf16x8 q; if constexpr (QLDS) q = *(const LAS bf16x8*)(ql + d0 * 1024); else q = qr[d0];
        p0 = __builtin_amdgcn_mfma_f32_32x32x16_bf16(b0, q, p0, 0, 0, 0);
        p1 = __builtin_amdgcn_mfma_f32_32x32x16_bf16(b1, q, p1, 0, 0, 0); }
}
template <bool BAND> __device__ __forceinline__ void partialSM(f32x16& p0, f32x16& p1, float& m_reg, float& alpha, const LAS int* kposl, const LAS float* tabl, int qpos, int hi) {
    if constexpr (BAND) {
#pragma unroll
        for (int r = 0; r < 16; ++r) { const int kc = crow(r, hi); int r0 = kposl[kc] - qpos, r1 = kposl[32 + kc] - qpos;
            r0 = r0 < -128 ? -128 : (r0 > 128 ? 128 : r0); r1 = r1 < -128 ? -128 : (r1 > 128 ? 128 : r1);
            p0[r] += tabl[r0 + 128]; p1[r] += tabl[r1 + 128];
            if ((r & 3) == 3) asm volatile("" ::: "memory"); }
    }
    float pmax = p0[0];
#pragma unroll
    for (int r = 1; r < 16; ++r) pmax = fmaxf(pmax, p0[r]);
#pragma unroll
    for (int r = 0; r < 16; ++r) pmax = fmaxf(pmax, p1[r]);
    { auto rr = __builtin_amdgcn_permlane32_swap(__float_as_uint(pmax), __float_as_uint(pmax), false, false); pmax = fmaxf(__uint_as_float(rr[0]), __uint_as_float(rr[1])); }
    float mn;
    if (__builtin_expect(__all(pmax - m_reg <= THR2), 1)) { mn = m_reg; alpha = 1.f; }
    else { mn = fmaxf(m_reg, pmax); alpha = __builtin_amdgcn_exp2f(m_reg - mn); m_reg = mn; }
#pragma unroll
    for (int r = 0; r < 16; ++r) { p0[r] -= mn; p1[r] -= mn; }
#pragma unroll
    for (int r = 0; r < 16; ++r) p0[r] = __builtin_amdgcn_exp2f(p0[r]);
}
__device__ __forceinline__ void finishSM(f32x16& p0, f32x16& p1, float alpha, float& l_reg, bf16x8& pa0, bf16x8& pa1, bf16x8& pa2, bf16x8& pa3) {
#pragma unroll
    for (int r = 0; r < 16; ++r) p1[r] = __builtin_amdgcn_exp2f(p1[r]);
    float ps = 0;
#pragma unroll
    for (int r = 0; r < 16; ++r) ps += p0[r];
#pragma unroll
    for (int r = 0; r < 16; ++r) ps += p1[r];
    { auto rr = __builtin_amdgcn_permlane32_swap(__float_as_uint(ps), __float_as_uint(ps), false, false); ps = __uint_as_float(rr[0]) + __uint_as_float(rr[1]); }
    l_reg = l_reg * alpha + ps;
#define ATT_PK4(P, BASE, OUT) do { unsigned a0 = cvtpk(P[BASE + 0], P[BASE + 1]), a1 = cvtpk(P[BASE + 2], P[BASE + 3]);   \
    unsigned b0 = cvtpk(P[BASE + 4], P[BASE + 5]), b1 = cvtpk(P[BASE + 6], P[BASE + 7]);                              \
    auto r0 = __builtin_amdgcn_permlane32_swap(a0, b0, false, false); auto r1 = __builtin_amdgcn_permlane32_swap(a1, b1, false, false); \
    u32x4 w = {r0[0], r1[0], r0[1], r1[1]}; OUT = __builtin_bit_cast(bf16x8, w); } while (0)
    ATT_PK4(p0, 0, pa0); ATT_PK4(p0, 8, pa1); ATT_PK4(p1, 0, pa2); ATT_PK4(p1, 8, pa3);
#undef ATT_PK4
}
struct Src { const bf16* kp; int kpitch; const bf16* vp; int vpitch; const int* pos; };

template <int NDQ, int NDV, bool DIFF, bool QLDS>
__device__ __forceinline__ void attn_pass(LAS char* lds, const bf16x8 (&qr)[NDQ], const Src& S, f32x16 (&o)[NDV], float& l_out,
                                          int qpos, int qmn, int qmx, const int* pmm, float cL, float cR) {
    const int tid = threadIdx.x, wid = __builtin_amdgcn_readfirstlane(tid >> 6), lane = tid & 63, r32 = lane & 31, hi = lane >> 5;
    LAS char* V_lds = lds + L_V; LAS char* K_lds = lds + L_K;
    LAS float* al_l = (LAS float*)(lds + L_WS) + wid * 64 + 32;
    LAS int* kposl = (LAS int*)(lds + L_KPOS); const LAS float* tabl = (const LAS float*)(lds + L_TAB);
    const LAS char* ql = lds + L_Q + wid * 4096 + lane * 16;
    float m_reg = -1e30f, l_reg = 0.f;
#pragma unroll
    for (int d = 0; d < NDV; ++d)
#pragma unroll
        for (int r = 0; r < 16; ++r) o[d][r] = 0.f;
    const int sr = tid >> 4, sc = (tid & 15) * 8, vst0 = v_st(sr, sc), vst1 = v_st(32 + sr, sc);
    const int vb0 = (int)(unsigned)(size_t)V_lds + v_rd_base(lane);
    constexpr int SD = ATT_SDEPTH;
    struct { bf16x8 vs0, vs1, ks0, ks1; } sr_[SD];
#define ATT_SLOAD(i, k0) do { sr_[i].vs0 = *(const bf16x8*)(S.vp + (size_t)((k0) + sr) * S.vpitch); sr_[i].vs1 = *(const bf16x8*)(S.vp + (size_t)((k0) + 32 + sr) * S.vpitch); \
    sr_[i].ks0 = *(const bf16x8*)(S.kp + (size_t)((k0) + sr) * S.kpitch); sr_[i].ks1 = *(const bf16x8*)(S.kp + (size_t)((k0) + 32 + sr) * S.kpitch); } while (0)
#define ATT_SWRITE(b, i) do { *(LAS bf16x8*)(V_lds + (b) * SHM_V + vst0) = sr_[i].vs0; *(LAS bf16x8*)(V_lds + (b) * SHM_V + vst1) = sr_[i].vs1; const int kc_ = sc * 2; \
    *(LAS bf16x8*)(K_lds + (b) * SHM_K + ATT_KSWZ(sr, kc_)) = sr_[i].ks0; *(LAS bf16x8*)(K_lds + (b) * SHM_K + ATT_KSWZ(32 + sr, kc_)) = sr_[i].ks1; } while (0)
#define ATT_SWAIT() do { if constexpr (SD == 2) asm volatile("s_waitcnt vmcnt(4)" ::: "memory"); else asm volatile("s_waitcnt vmcnt(0)" ::: "memory"); } while (0)
#define ATT_RESC(a) do { if (__any((a) < 1.f)) { if (hi == 0) al_l[r32] = (a); asm volatile("s_waitcnt lgkmcnt(0)" ::: "memory"); \
    _Pragma("unroll") for (int d = 0; d < NDV; ++d) _Pragma("unroll") for (int r = 0; r < 16; ++r) o[d][r] *= al_l[crow(r, hi)]; } } while (0)
#define ATT_CLASS(j, cinit, band) do { cinit = 0.f; band = false; if constexpr (DIFF) { const int kmn_ = __hip_atomic_load(pmm + 2 * (j), RLX_AGENT), kmx_ = __hip_atomic_load(pmm + 2 * (j) + 1, RLX_AGENT); \
    if (kmn_ - qmx >= 128) cinit = cR; else if (qmn - kmx_ >= 128) cinit = cL; else band = true; } } while (0)
#define ATT_PSM(P0, P1, AL, band, tile) do { if (DIFF && (band)) partialSM<true>(P0, P1, m_reg, AL, kposl + (tile) * 64, tabl, qpos, hi); else partialSM<false>(P0, P1, m_reg, AL, kposl, tabl, qpos, hi); } while (0)
    f32x16 pA0, pA1, pB0, pB1; float alA, alB, ci; bool band; bf16x8 pa0, pa1, pa2, pa3; constexpr int NT = SEQ / 64;
    constexpr int SE = 0, SO = SD - 1;
    ATT_SLOAD(SE, 0); asm volatile("s_waitcnt vmcnt(0)" ::: "memory"); ATT_SWRITE(0, SE); __syncthreads();
    ATT_CLASS(0, ci, band); qkt<NDQ, QLDS>(pA0, pA1, K_lds, qr, ql, r32, hi, ci); ATT_PSM(pA0, pA1, alA, band, 0);
    ATT_SLOAD(SO, 64); if constexpr (SD == 2) ATT_SLOAD(SE, 128);
    ATT_SWAIT(); ATT_SWRITE(1, SO); __syncthreads();
    for (int j = 1; j + 1 < NT; j += 2) {
        ATT_SBAR(); ATT_CLASS(j, ci, band); qkt<NDQ, QLDS>(pB0, pB1, K_lds + SHM_K, qr, ql, r32, hi, ci);
        finishSM(pA0, pA1, alA, l_reg, pa0, pa1, pa2, pa3); ATT_SBAR();
        ATT_SLOAD(SO, (j + SD) * 64); ATT_SBAR();
        pv_all<NDV>(o, vb0, pa0, pa1, pa2, pa3); ATT_PSM(pB0, pB1, alB, band, j);
        __syncthreads(); ATT_SWAIT(); ATT_SWRITE(0, SE);
        ATT_RESC(alB); __syncthreads();
        ATT_SBAR(); ATT_CLASS(j + 1, ci, band); qkt<NDQ, QLDS>(pA0, pA1, K_lds, qr, ql, r32, hi, ci);
        finishSM(pB0, pB1, alB, l_reg, pa0, pa1, pa2, pa3); ATT_SBAR();
        if (SD == 1 || j + 3 < NT) ATT_SLOAD(SE, (j + 1 + SD) * 64); ATT_SBAR();
        pv_all<NDV>(o, vb0 + SHM_V, pa0, pa1, pa2, pa3); ATT_PSM(pA0, pA1, alA, band, j + 1);
        __syncthreads(); ATT_SWAIT(); ATT_SWRITE(1, SO);
        ATT_RESC(alA); __syncthreads();
    }
    ATT_SBAR(); ATT_CLASS(NT - 1, ci, band); qkt<NDQ, QLDS>(pB0, pB1, K_lds + SHM_K, qr, ql, r32, hi, ci);
    finishSM(pA0, pA1, alA, l_reg, pa0, pa1, pa2, pa3); ATT_SBAR();
    pv_all<NDV>(o, vb0, pa0, pa1, pa2, pa3); ATT_PSM(pB0, pB1, alB, band, NT - 1);
    __syncthreads(); ATT_RESC(alB);
    finishSM(pB0, pB1, alB, l_reg, pa0, pa1, pa2, pa3); ATT_SBAR();
    pv_all<NDV>(o, vb0 + SHM_V, pa0, pa1, pa2, pa3);
    l_out = l_reg;
    __syncthreads();
#undef ATT_SLOAD
#undef ATT_SWRITE
#undef ATT_SWAIT
#undef ATT_RESC
#undef ATT_CLASS
#undef ATT_PSM
}
__device__ __forceinline__ void row_recip(LAS float* li_l, float l_reg, int r32, int hi, float (&rli)[16]) {
    if (hi == 0) li_l[r32] = l_reg; asm volatile("s_waitcnt lgkmcnt(0)" ::: "memory");
#pragma unroll
    for (int r = 0; r < 16; ++r) rli[r] = __builtin_amdgcn_rcpf(li_l[crow(r, hi)]);
    asm volatile("s_waitcnt lgkmcnt(0)" ::: "memory");
}
__device__ __forceinline__ void mla_unit(const Ctx& C, int b, int h, int qb) {
    LAS char* lds = (LAS char*)C.lds;
    const int tid = threadIdx.x, wid = __builtin_amdgcn_readfirstlane(tid >> 6), lane = tid & 63, r32 = lane & 31, hi = lane >> 5;
    const int t0 = b * SEQ + qb * 256 + wid * 32;
    bf16x8 qr[6];
    const bf16* qrow = C.Q + (size_t)(t0 + r32) * 768;
#pragma unroll
    for (int d0 = 0; d0 < 4; ++d0) qr[d0] = *(const bf16x8*)(qrow + h * 64 + d0 * 16 + hi * 8);
#pragma unroll
    for (int d0 = 4; d0 < 6; ++d0) { const int fqi = 2 * (d0 - 4) + hi; const u32x4 w = *(const u32x4*)(qrow + 512 + h * 32 + (d0 - 4) * 16 + hi * 8);
        const f32x4 c4 = *(const f32x4*)(C.CS + (size_t)(t0 + r32) * 16 + 4 * fqi), s4 = *(const f32x4*)(C.SN + (size_t)(t0 + r32) * 16 + 4 * fqi);
        const float t1[4] = {bflo(w.x), bfhi(w.x), bflo(w.y), bfhi(w.y)}, t2[4] = {bflo(w.z), bfhi(w.z), bflo(w.w), bfhi(w.w)};
        float a[4], bb[4];
#pragma unroll
        for (int i = 0; i < 4; ++i) { a[i] = t1[i] * c4[i] - t2[i] * s4[i]; bb[i] = t1[i] * s4[i] + t2[i] * c4[i]; }
        u32x4 ww; ww.x = pk2(a[0], a[1]); ww.y = pk2(a[2], a[3]); ww.z = pk2(bb[0], bb[1]); ww.w = pk2(bb[2], bb[3]); qr[d0] = __builtin_bit_cast(bf16x8, ww); }
    const int sc = (tid & 15) * 8;
    Src S; S.kp = sc < 64 ? C.KV + (size_t)b * SEQ * 1024 + h * 64 + sc : C.KR + (size_t)b * SEQ * 32 + ((sc - 64) & 31); S.kpitch = sc < 64 ? 1024 : 32;
    S.vp = C.KV + (size_t)b * SEQ * 1024 + 512 + h * 64 + (sc & 63); S.vpitch = 1024; S.pos = C.pos + b * SEQ;
    f32x16 o[2]; float l;
    attn_pass<6, 2, false, false>(lds, qr, S, o, l, 0, 0, 0, nullptr, 0.f, 0.f);
    float rli[16]; row_recip((LAS float*)(lds + L_WS) + wid * 64, l, r32, hi, rli);
    bf16* ao = C.AO + (size_t)t0 * DM + h * 64; const int loff = hi * 4 * DM + r32;
#pragma unroll
    for (int r = 0; r < 16; ++r) {
#pragma unroll
        for (int d0 = 0; d0 < 2; ++d0) ao[crow(r, 0) * DM + d0 * 32 + loff] = (bf16)f2bf(o[d0][r] * rli[r]); }
}
__device__ __forceinline__ void diff_unit(const Ctx& C, int b, int h, int qb) {
    LAS char* lds = (LAS char*)C.lds;
    int tid = threadIdx.x; asm volatile("" : "+v"(tid));
    const int wid = __builtin_amdgcn_readfirstlane(tid >> 6);
    const int t0 = b * SEQ + qb * 256 + wid * 32;
    LAS float* tabl = (LAS float*)(lds + L_TAB);
    if (tid < 257) tabl[tid] = __hip_atomic_load(C.MISC + 64 + h * 260 + tid, RLX_AGENT);
    { LAS int* kposl = (LAS int*)(lds + L_KPOS);
#pragma unroll
      for (int i = 0; i < SEQ / NTHREADS; ++i) kposl[tid + i * NTHREADS] = C.pos[b * SEQ + tid + i * NTHREADS]; }
    const float cL = __hip_atomic_load(C.MISC + 64 + h * 260 + 0, RLX_AGENT), cR = __hip_atomic_load(C.MISC + 64 + h * 260 + 256, RLX_AGENT);
    const float lam = __hip_atomic_load(C.MISC, RLX_AGENT);
    const int qpos = C.pos[t0 + (tid & 31)]; int qmn = qpos, qmx = qpos;
#pragma unroll
    for (int o_ = 1; o_ < 64; o_ <<= 1) { const int a = __shfl_xor(qmn, o_), c = __shfl_xor(qmx, o_); qmn = a < qmn ? a : qmn; qmx = c > qmx ? c : qmx; }
    qmn = __builtin_amdgcn_readfirstlane(qmn); qmx = __builtin_amdgcn_readfirstlane(qmx);
    __syncthreads();
    float* scr = C.out + (size_t)t0 * DM + h * 128;
    const int* pmm = C.PMM + b * 64;
#pragma unroll
    for (int m = 0; m < 2; ++m) {
        f32x16 o[4]; float l;
        {
            int tl = threadIdx.x; asm volatile("" : "+v"(tl));
            const int lane = tl & 63, r32 = lane & 31, hi = lane >> 5, sc = (tl & 15) * 8;
            bf16x8 qr[4];
            const bf16* qrow = C.PROJ + (size_t)(t0 + r32) * NPROJ + 512 + (h * 2 + m) * 64;
#pragma unroll
            for (int d0 = 0; d0 < 4; ++d0) { qr[d0] = *(const bf16x8*)(qrow + d0 * 16 + hi * 8); *(LAS bf16x8*)(lds + L_Q + wid * 4096 + lane * 16 + d0 * 1024) = qr[d0]; }
            Src S; S.kp = C.PROJ + (size_t)b * SEQ * NPROJ + 1024 + (h * 2 + m) * 64 + (sc & 63); S.kpitch = NPROJ;
            S.vp = C.PROJ + (size_t)b * SEQ * NPROJ + 1536 + h * 128 + sc; S.vpitch = NPROJ; S.pos = C.pos + b * SEQ;
            attn_pass<4, 4, true, true>(lds, qr, S, o, l, qpos, qmn, qmx, pmm, cL, cR);
        }
        int te = threadIdx.x; asm volatile("" : "+v"(te));
        const int r32 = te & 31, hi = (te >> 5) & 1, loff = hi * 4 * DM + r32;
        float rli[16]; row_recip((LAS float*)(lds + L_WS) + wid * 64, l, r32, hi, rli);
        if (m == 0) {
#pragma unroll
            for (int r = 0; r < 16; ++r) {
#pragma unroll
                for (int d0 = 0; d0 < 4; ++d0) scr[crow(r, 0) * DM + d0 * 32 + loff] = o[d0][r] * rli[r]; }
        } else {
#pragma unroll
            for (int r = 0; r < 16; ++r) { float s = 0.f;
#pragma unroll
                for (int d0 = 0; d0 < 4; ++d0) { const float a = scr[crow(r, 0) * DM + d0 * 32 + loff] - lam * (o[d0][r] * rli[r]); o[d0][r] = a; s += a * a; }
                s += __shfl_xor(s, 1); s += __shfl_xor(s, 2); s += __shfl_xor(s, 4); s += __shfl_xor(s, 8); s += __shfl_xor(s, 16);
                const float f = (1.0f - LAMBDA_INIT) / sqrtf(s * (1.f / 128.f) + RMS_EPS);
#pragma unroll
                for (int d0 = 0; d0 < 4; ++d0) o[d0][r] *= f;
                asm volatile("" : "+v"(o[0][r]), "+v"(o[1][r]), "+v"(o[2][r]), "+v"(o[3][r]));
                if (r & 1) asm volatile("" ::: "memory"); }
            bf16* ao = C.AO + (size_t)t0 * DM + 512 + h * 128;
#pragma unroll
            for (int d0 = 0; d0 < 4; ++d0) { const float g = C.subln[d0 * 32 + r32];
#pragma unroll
                for (int r = 0; r < 16; ++r) ao[crow(r, 0) * DM + d0 * 32 + loff] = (bf16)f2bf(o[d0][r] * g); }
        }
    }
}
__device__ __forceinline__ void attn_phase(const Ctx& C) {
#ifndef ATT_SKIP_DIFF
#pragma unroll 1
    for (int U = C.vcu; U < BATCH * 4 * 8; U += C.G) diff_unit(C, U >> 5, (U >> 3) & 3, U & 7);
#endif
#ifndef ATT_SKIP_MLA
#pragma unroll 1
    for (int U = C.vcu; U < BATCH * 8 * 8; U += C.G) mla_unit(C, U >> 6, (U >> 3) & 7, U & 7);
#endif
}
}

struct ARowLd { const bf16* A; int lda; __device__ __forceinline__ const bf16* operator()(int m) const { return A + (size_t)m * lda; } };
struct ARowGather { const bf16* A; const int* idx; __device__ __forceinline__ const bf16* operator()(int m) const { const int be = m >> 8; return A + ((size_t)(be >> 4) * SEQ + idx[m]) * DM; } };
struct BRowLd { const bf16* B; int ldb; __device__ __forceinline__ const bf16* operator()(int n, int) const { return B + (size_t)n * ldb; } };
struct BRowExp { const bf16* B; int rows_per_e, ldb, e; __device__ __forceinline__ const bf16* operator()(int n, int) const { return B + ((size_t)e * rows_per_e + n) * ldb; } };
struct BRowGU { const bf16* B; int e; __device__ __forceinline__ const bf16* operator()(int n, int up) const { return B + ((size_t)e * 4096 + (n >> 7) * 256 + (n & 127) + up * 128) * DM; } };

__global__ void __launch_bounds__(NTHREADS) nk_proj(Args a) {
    __shared__ __attribute__((aligned(16))) float lds[48 * 132]; Ctx C; ctx_init(C, a);
    for (int u = blockIdx.x; u < (T / 128) * (NPROJ / 128); u += gridDim.x) { const int pm = u / (NPROJ / 128), pn = u % (NPROJ / 128);
        naive_gemm_tile<false>(pm * 128, pn * 128, DM, ARowLd{C.U, DM}, BRowLd{C.WIN, DM}, FPlain{C.PROJ, NPROJ}, 0, lds); __syncthreads(); }
}
__global__ void __launch_bounds__(NTHREADS) nk_qkv(Args a) {
    __shared__ __attribute__((aligned(16))) float lds[48 * 132]; Ctx C; ctx_init(C, a);
    const FRowScale f0{C.Q, 768, C.RINVQ}, f1{C.KV, 1024, C.RINVKV};
    for (int u = blockIdx.x; u < (T / 128) * 14; u += gridDim.x) { const int pm = u / 14, j = u % 14;
        if (j < 6) naive_gemm_tile<false>(pm * 128, j * 128, 256, ARowLd{C.PROJ, NPROJ}, BRowLd{C.WUQ, 256}, f0, 0, lds);
        else naive_gemm_tile<false>(pm * 128, (j - 6) * 128, 256, ARowLd{C.PROJ + 256, NPROJ}, BRowLd{C.WUKV, 256}, f1, 1, lds);
        __syncthreads(); }
}
__global__ void __launch_bounds__(NTHREADS) nk_out(Args a) {
    __shared__ __attribute__((aligned(16))) float lds[48 * 132]; Ctx C; ctx_init(C, a);
    for (int u = blockIdx.x; u < (T / 128) * 8; u += gridDim.x) { const int pm = u / 8, pn = u % 8;
        naive_gemm_tile<false>(pm * 128, pn * 128, DM, ARowLd{C.AO, DM}, BRowLd{C.WOUT, DM}, FY{C.Y, C.x, C.MOD}, 0, lds); __syncthreads(); }
}
__global__ void __launch_bounds__(NTHREADS) nk_up(Args a) {
    __shared__ __attribute__((aligned(16))) float lds[48 * 132]; Ctx C; ctx_init(C, a);
    for (int u = blockIdx.x; u < (NSEL / 128) * (FF / 128); u += gridDim.x) { const int pm = u / (FF / 128), pn = u % (FF / 128); const int e = (pm >> 1) & 15;
        naive_gemm_tile<true>(pm * 128, pn * 128, DM, ARowGather{C.U2, C.IDX}, BRowGU{C.WGU, e}, FSwi{C.HLO, C.HHI}, 0, lds); __syncthreads(); }
}
struct ARowH { const bf16* lo; const bf16* hi; __device__ __forceinline__ const bf16* operator()(int m) const { return m < NSEL / 2 ? lo + (size_t)m * FF : hi + (size_t)(m - NSEL / 2) * FF; } };
__global__ void __launch_bounds__(NTHREADS) nk_down(Args a) {
    __shared__ __attribute__((aligned(16))) float lds[48 * 132]; Ctx C; ctx_init(C, a);
    for (int u = blockIdx.x; u < (NSEL / 128) * 8; u += gridDim.x) { const int pm = u / 8, pn = u % 8; const int e = (pm >> 1) & 15;
        naive_gemm_tile<false>(pm * 128, pn * 128, FF, ARowH{C.HLO, C.HHI}, BRowExp{C.WD, DM, FF, e}, FGate{C.YE, C.GATE}, 0, lds); __syncthreads(); }
}
template <int DQK, int DV, bool DIFF>
__device__ __forceinline__ void naive_attn_block(const Ctx& C, int b, int h, int m, int qb, float* lds) {
    float* Ks = lds; float* Vs = lds + 32 * DQK;
    const int tid = threadIdx.x, t = b * SEQ + qb * 256 + tid;
    float q[DQK], o[DV];
#pragma unroll
    for (int d = 0; d < DV; ++d) o[d] = 0.f;
    if (DIFF) {
#pragma unroll
        for (int d = 0; d < DQK; ++d) q[d] = bf2f(C.PROJ[(size_t)t * NPROJ + 512 + (h * 2 + m) * 64 + d]);
    } else {
#pragma unroll
        for (int d = 0; d < 64; ++d) q[d] = bf2f(C.Q[(size_t)t * 768 + h * 64 + d]);
#pragma unroll
        for (int d = 0; d < 32; ++d) { const int fq = d >> 3, n = (d >> 2) & 1, i = d & 3; const float cs = C.CS[(size_t)t * 16 + 4 * fq + i], sn = C.SN[(size_t)t * 16 + 4 * fq + i];
            const float t1 = bf2f(C.Q[(size_t)t * 768 + 512 + h * 32 + (d & ~4)]), t2 = bf2f(C.Q[(size_t)t * 768 + 512 + h * 32 + (d | 4)]);
            q[64 + d] = bf2f((bf16)f2bf(n == 0 ? t1 * cs - t2 * sn : t1 * sn + t2 * cs)); }
    }
    const int qpos = C.pos[t]; const float* btab = C.MISC + 64 + h * 260 + 128;
    float mx = -1e30f, l = 0.f;
    for (int k0 = 0; k0 < SEQ; k0 += 32) {
        __syncthreads();
        for (int i = tid; i < 32 * DQK; i += 256) { const int kk = i / DQK, d = i % DQK; const size_t kt = (size_t)(b * SEQ + k0 + kk); float v;
            if (DIFF) v = bf2f(C.PROJ[kt * NPROJ + 1024 + (h * 2 + m) * 64 + d]);
            else v = d < 64 ? bf2f(C.KV[kt * 1024 + h * 64 + d]) : bf2f(C.KR[kt * 32 + (d - 64)]);
            Ks[i] = v; }
        for (int i = tid; i < 32 * DV; i += 256) { const int kk = i / DV, d = i % DV; const size_t kt = (size_t)(b * SEQ + k0 + kk);
            Vs[i] = DIFF ? bf2f(C.PROJ[kt * NPROJ + 1536 + h * 128 + d]) : bf2f(C.KV[kt * 1024 + 512 + h * 64 + d]); }
        __syncthreads();
        for (int kk = 0; kk < 32; ++kk) {
            float s = 0.f;
#pragma unroll
            for (int d = 0; d < DQK; d += 4) { const f32x4 kv = *(const f32x4*)(Ks + kk * DQK + d); s += q[d] * kv[0] + q[d + 1] * kv[1] + q[d + 2] * kv[2] + q[d + 3] * kv[3]; }
            if (DIFF) { int rel = C.pos[b * SEQ + k0 + kk] - qpos; rel = rel < -128 ? -128 : (rel > 128 ? 128 : rel); s += btab[rel]; }
            const float mn = fmaxf(mx, s), al = __builtin_amdgcn_exp2f(mx - mn), p = __builtin_amdgcn_exp2f(s - mn);
            mx = mn; l = l * al + p;
#pragma unroll
            for (int d = 0; d < DV; d += 4) { const f32x4 vv = *(const f32x4*)(Vs + kk * DV + d); o[d] = o[d] * al + p * vv[0]; o[d + 1] = o[d + 1] * al + p * vv[1]; o[d + 2] = o[d + 2] * al + p * vv[2]; o[d + 3] = o[d + 3] * al + p * vv[3]; }
        }
    }
    const float rl = 1.0f / l;
    if (DIFF) { float* od = (float*)(C.ws + WS_ODIFF) + ((size_t)m * T + t) * 512 + h * 128;
#pragma unroll
        for (int d = 0; d < DV; d += 4) *(f32x4*)(od + d) = (f32x4){o[d] * rl, o[d + 1] * rl, o[d + 2] * rl, o[d + 3] * rl};
    } else { bf16* ao = C.AO + (size_t)t * DM + h * 64;
#pragma unroll
        for (int d = 0; d < DV; d += 8) { float v[8];
#pragma unroll
            for (int i = 0; i < 8; ++i) v[i] = o[d + i] * rl;
            store8_bf16(ao + d, v); } }
}
__global__ void __launch_bounds__(256) nk_attn_mla(Args a) {
    __shared__ __attribute__((aligned(16))) float lds[32 * 96 + 32 * 64]; Ctx C; ctx_init(C, a);
    const int u = blockIdx.x; naive_attn_block<96, 64, false>(C, u >> 6, (u >> 3) & 7, 0, u & 7, lds);
}
__global__ void __launch_bounds__(256) nk_attn_diff(Args a) {
    __shared__ __attribute__((aligned(16))) float lds[32 * 64 + 32 * 128]; Ctx C; ctx_init(C, a);
    const int u = blockIdx.x; naive_attn_block<64, 128, true>(C, u >> 6, (u >> 4) & 3, (u >> 3) & 1, u & 7, lds);
}
__global__ void __launch_bounds__(256) nk_attn_diff_combine(Args a) {
    Ctx C; ctx_init(C, a); const int lane = threadIdx.x & 63; const float lam = C.MISC[0];
    const float* od = (const float*)(C.ws + WS_ODIFF);
    for (int w = blockIdx.x * 4 + (threadIdx.x >> 6); w < T * 4; w += gridDim.x * 4) { const int t = w >> 2, h = w & 3;
        const f32x2 o0 = *(const f32x2*)(od + (size_t)t * 512 + h * 128 + 2 * lane), o1 = *(const f32x2*)(od + ((size_t)T + t) * 512 + h * 128 + 2 * lane);
        const float a0 = o0[0] - lam * o1[0], a1 = o0[1] - lam * o1[1];
        const float r = 1.0f / sqrtf(wave_sum(a0 * a0 + a1 * a1) * (1.f / 128.f) + RMS_EPS);
        const float v0 = a0 * r * C.subln[2 * lane] * (1.f - LAMBDA_INIT), v1 = a1 * r * C.subln[2 * lane + 1] * (1.f - LAMBDA_INIT);
        *(unsigned*)(C.AO + (size_t)t * DM + 512 + h * 128 + 2 * lane) = pk2(v0, v1); }
}

constexpr int NPHASE = 12;
__global__ void __launch_bounds__(NTHREADS, 2) mega(Args args) {
    extern __shared__ __attribute__((aligned(16))) unsigned char lds[];
    Ctx C; ctx_init(C, args);
    C.lds = (LAS unsigned char*)lds; C.lds_g = lds;
    C.tid = threadIdx.x; C.lane = C.tid & 63; C.wave = __builtin_amdgcn_readfirstlane(C.tid >> 6);
    C.G = gridDim.x; { const int bx = blockIdx.x; C.vcu = (C.G % 8 == 0) ? (bx % 8) * (C.G / 8) + bx / 8 : bx; }
    volatile LAS unsigned* MISCL = (volatile LAS unsigned*)(C.lds + MISC_OFF);
    for (int u = C.tid; u < (LDS_BYTES - LDSCTL_OFF) / 4; u += NTHREADS) ((LAS unsigned*)(C.lds + LDSCTL_OFF))[u] = 0u;
    __syncthreads();
    const int lo = args.ph_lo, hi = args.ph_hi;
    XcdBarrier bar; bar.bar = (unsigned*)(args.ws + WS_CTL) + CW_BAR + args.li * XCD_BAR_WORDS; bar.x = 0; bar.st = nullptr;
    if (hi - lo > 1) bar = xcd_barrier_post((unsigned*)(args.ws + WS_CTL) + CW_BAR + args.li * XCD_BAR_WORDS, MISCL + 8);
#ifndef CFG_DISABLE
#define CFG_DISABLE 0
#endif
#define IN(k) (!((CFG_DISABLE >> (k)) & 1) && lo <= (k) && (k) < hi)
#define SEAM(k) do { if (IN(k) && IN((k) + 1)) xcd_barrier(bar); } while (0)
    if (IN(0)) { phase_prep(C); } SEAM(0);
    if (IN(1)) { phase_u(C); } SEAM(1);
    if (IN(2)) {
        pg8::SchedDense S; S.init(C.U, DM, C.WIN, DM, T, NPROJ, C.G, (int)blockIdx.x);
        pg8::EpiRow8<FPlain> E{FPlain{C.PROJ, NPROJ}};
        pg8::gemm_phase(C.lds, DM, S, E);
    } SEAM(2);
    if (IN(3)) { phase_fix1(C); } SEAM(3);
    if (IN(4)) {
        pg8::SchedQKV S{(const char*)C.PROJ, (const char*)C.WUQ, (const char*)C.WUKV, NPROJ, 256, C.G, C.vcu};
        pg8::EpiQKV E{FRowScale{C.Q, 768, C.RINVQ}, FRowScale{C.KV, 1024, C.RINVKV}};
        pg8::gemm_phase(C.lds, 256, S, E);
    } SEAM(4);
    if (IN(5)) { att::attn_phase(C); } SEAM(5);
    if (IN(6)) {
        pg8::SchedDense S; S.init(C.AO, DM, C.WOUT, DM, T, DM, C.G, (int)blockIdx.x);
        pg8::EpiRow8<FY> E{FY{C.Y, C.x, C.MOD}};
        pg8::gemm_phase(C.lds, DM, S, E);
    } SEAM(6);
    if (IN(7)) { phase_ln1(C); } SEAM(7);
    if (IN(8)) { phase_topk(C); phase_wconv(C); } SEAM(8);
    if (IN(9)) {
        pg8::SchedUp S{(const char*)C.U2, C.IDX, (const char*)C.WGU, DM, DM, C.G, C.vcu};
        pg8::EpiPair8<FSwi> E{FSwi{C.HLO, C.HHI}};
        pg8::gemm_phase(C.lds, DM, S, E);
    } SEAM(9);
    if (IN(10)) {
        pg8::SchedDown S{(const char*)C.HLO, (const char*)C.HHI, (const char*)C.WD, FF, FF, C.G, C.vcu};
        pg8::EpiRow8<FGate> E{FGate{C.YE, C.GATE}};
        pg8::gemm_phase(C.lds, FF, S, E);
    } SEAM(10);
    if (IN(11)) { phase_final(C); }
#undef IN
#undef SEAM
}

#ifndef CFG_SPLIT
#define CFG_SPLIT 0
#endif
static void launch_mega(const Args& base, int lo, int hi, int li, int grid, hipStream_t stream) {
    Args a = base; a.ph_lo = lo; a.ph_hi = hi; a.li = li;
    hipLaunchKernelGGL(mega, dim3(grid), dim3(NTHREADS), LDS_BYTES, stream, a);
}
static bool phase_in_mega(int p) { const bool has_naive = (p == 2 || p == 4 || p == 5 || p == 6 || p == 9 || p == 10); return has_naive ? (((unsigned)CFG_OPT_MASK >> p) & 1u) != 0u : true; }
extern "C" void kernel_launch(void* const* d_in, const int* in_sizes, int n_in, void* d_out, int out_size, void* d_ws, size_t ws_size, hipStream_t stream) {
    static int grid = 0;
    if (grid == 0) {
        if (n_in != 25 || out_size != T * DM || ws_size < WS_END) { fprintf(stderr, "kernel_launch: unexpected shapes (n_in %d out %d ws %zu, need %zu)\n", n_in, out_size, ws_size, (size_t)WS_END); grid = -1; return; }
        int dev = 0, cus = 0;
        if (hipGetDevice(&dev) != hipSuccess || hipDeviceGetAttribute(&cus, hipDeviceAttributeMultiprocessorCount, dev) != hipSuccess) { grid = -1; return; }
        if (hipFuncSetAttribute((const void*)mega, hipFuncAttributeMaxDynamicSharedMemorySize, LDS_BYTES) != hipSuccess) { fprintf(stderr, "kernel_launch: hipFuncSetAttribute failed\n"); grid = -1; return; }
        int per_cu = 0; (void)hipOccupancyMaxActiveBlocksPerMultiprocessor(&per_cu, (const void*)mega, NTHREADS, LDS_BYTES); (void)hipGetLastError();
        if (per_cu < 1) fprintf(stderr, "kernel_launch: occupancy query reports %d\n", per_cu);
        grid = cus;
        if (grid != 256) fprintf(stderr, "kernel_launch: %d CUs (built for 256)\n", grid);
    }
    if (grid < 0) return;
    (void)hipMemsetAsync((char*)d_ws + WS_CTL, 0, CTL_BYTES, stream);
    Args a{};
    for (int i = 0; i < 25; ++i) a.in[i] = d_in[i];
    a.out = (float*)d_out; a.ws = (unsigned char*)d_ws;
    int p = 0, li = 0;
    while (p < NPHASE) {
        if (phase_in_mega(p)) { int q = p + 1; if (!CFG_SPLIT) while (q < NPHASE && phase_in_mega(q)) ++q; launch_mega(a, p, q, li++, grid, stream); p = q; continue; }
        switch (p) {
            case 2: hipLaunchKernelGGL(nk_proj, dim3(1024), dim3(NTHREADS), 0, stream, a); break;
            case 4: hipLaunchKernelGGL(nk_qkv, dim3(1024), dim3(NTHREADS), 0, stream, a); break;
            case 5: hipLaunchKernelGGL(nk_attn_mla, dim3(1024), dim3(256), 0, stream, a);
                    hipLaunchKernelGGL(nk_attn_diff, dim3(1024), dim3(256), 0, stream, a);
                    hipLaunchKernelGGL(nk_attn_diff_combine, dim3(2048), dim3(256), 0, stream, a); break;
            case 6: hipLaunchKernelGGL(nk_out, dim3(1024), dim3(NTHREADS), 0, stream, a); break;
            case 9: hipLaunchKernelGGL(nk_up, dim3(2048), dim3(NTHREADS), 0, stream, a); break;
            case 10: hipLaunchKernelGGL(nk_down, dim3(1024), dim3(NTHREADS), 0, stream, a); break;
            default: break;
        }
        ++p;
    }
}
```

```cpp
#include <hip/hip_runtime.h>
#include <cstdio>
#include <cstdint>

#ifndef CFG_OPT_MASK
#define CFG_OPT_MASK 1652
#endif
#ifndef CFG_ONE_LAUNCH
#define CFG_ONE_LAUNCH 0
#endif

constexpr int BATCH = 16, SEQ = 2048, DM = 1024, T = BATCH * SEQ;
constexpr int NE = 16, FF = 2048, CAP = 256, NSEL = BATCH * NE * CAP;
constexpr int NPROJ = 2048;
constexpr float LOG2E = 1.4426950408889634f;
constexpr float MLA_SCALE = 0.10206207261596575f;
constexpr float DIFF_SCALE = 0.125f;
constexpr float ALPHA = 1.189207115002721f;
constexpr float LN_EPS = 1e-5f, RMS_EPS = 1e-6f;
constexpr float LAMBDA_INIT = 0.2f;

constexpr size_t MiB = 1u << 20;
constexpr size_t WS_CTL = 0, CTL_BYTES = 1 * MiB;
constexpr size_t WS_MOD = 1 * MiB;
constexpr size_t WS_MISC = 1 * MiB + 512 * 1024;
constexpr size_t WS_PMM = 1 * MiB + 768 * 1024;
constexpr size_t WS_CS = 2 * MiB, WS_SN = 4 * MiB;
constexpr size_t WS_AFF = 6 * MiB;
constexpr size_t WS_IDX = 8 * MiB, WS_GATE = 8 * MiB + 512 * 1024;
constexpr size_t WS_SLOT = 9 * MiB;
constexpr size_t WS_RINVQ = 11 * MiB, WS_RINVKV = 11 * MiB + 256 * 1024;
constexpr size_t WS_KR = 12 * MiB;
constexpr size_t WS_WIN = 14 * MiB, WS_WUQ = 18 * MiB, WS_WUKV = 18 * MiB + 512 * 1024, WS_WOUT = 19 * MiB;
constexpr size_t WS_WD = 22 * MiB;
constexpr size_t WS_WGU = 86 * MiB;
constexpr size_t WS_YE = WS_WGU;
constexpr size_t WS_PROJ = 214 * MiB;
constexpr size_t WS_Y = WS_PROJ, WS_HLO = WS_PROJ;
constexpr size_t WS_Q = 342 * MiB;
constexpr size_t WS_KV = 390 * MiB;
constexpr size_t WS_U2 = 342 * MiB;
constexpr size_t WS_U = 454 * MiB, WS_AO = 454 * MiB;
constexpr size_t WS_HHI = 406 * MiB;
constexpr size_t WS_END = 534 * MiB;
constexpr size_t WS_ODIFF = WS_WGU;

#define GAS __attribute__((address_space(1)))
#define LAS __attribute__((address_space(3)))
typedef unsigned short bf16;
typedef short bf16x8 __attribute__((ext_vector_type(8)));
typedef float f32x4 __attribute__((ext_vector_type(4)));
typedef float f32x2 __attribute__((ext_vector_type(2)));
typedef unsigned u32x4 __attribute__((ext_vector_type(4)));
typedef unsigned u32x2 __attribute__((ext_vector_type(2)));
typedef GAS unsigned gu32;
#define RLX_AGENT __ATOMIC_RELAXED, __HIP_MEMORY_SCOPE_AGENT
#define LDS_WAIT() asm volatile("s_waitcnt lgkmcnt(0)" ::: "memory")
#define VM_WAIT() asm volatile("s_waitcnt vmcnt(0)" ::: "memory")
__device__ __forceinline__ unsigned f2bf(float f) { unsigned u = __builtin_bit_cast(unsigned, f); return (u + 0x7fffu + ((u >> 16) & 1u)) >> 16; }
__device__ __forceinline__ unsigned pk2(float lo, float hi) { return f2bf(lo) | (f2bf(hi) << 16); }
__device__ __forceinline__ float bflo(unsigned w) { return __uint_as_float(w << 16); }
__device__ __forceinline__ float bfhi(unsigned w) { return __uint_as_float(w & 0xffff0000u); }
__device__ __forceinline__ float bf2f(bf16 h) { return __uint_as_float((unsigned)h << 16); }
__device__ __forceinline__ float wave_sum(float v) {
#pragma unroll
    for (int o = 1; o < 64; o <<= 1) v += __shfl_xor(v, o);
    return v;
}
__device__ __forceinline__ float wave_max(float v) {
#pragma unroll
    for (int o = 1; o < 64; o <<= 1) v = fmaxf(v, __shfl_xor(v, o));
    return v;
}
typedef int i32x4 __attribute__((ext_vector_type(4)));
typedef int i32x8 __attribute__((ext_vector_type(8)));
constexpr float FP8_MAX = 448.0f;
constexpr float SC_U2 = 16.0f, SC_WGU = 512.0f, SC_H = 4.0f, SC_WD = 1024.0f;
constexpr float DS_UP = 1.0f / (SC_U2 * SC_WGU), DS_DOWN = 1.0f / (SC_H * SC_WD);
__device__ __forceinline__ unsigned cvt4_fp8(float a, float b, float c, float d) {
    a = __builtin_amdgcn_fmed3f(a, -FP8_MAX, FP8_MAX); b = __builtin_amdgcn_fmed3f(b, -FP8_MAX, FP8_MAX); c = __builtin_amdgcn_fmed3f(c, -FP8_MAX, FP8_MAX); d = __builtin_amdgcn_fmed3f(d, -FP8_MAX, FP8_MAX);
    int w = 0; w = __builtin_amdgcn_cvt_pk_fp8_f32(a, b, w, false); w = __builtin_amdgcn_cvt_pk_fp8_f32(c, d, w, true); return (unsigned)w;
}
__device__ __forceinline__ float silu_f(float g) { return g * __builtin_amdgcn_rcpf(1.0f + __builtin_amdgcn_exp2f(-g * LOG2E)); }

#define XB_TMO      128
#define XB_XCNT(j)  (256  + 64 * (j))
#define XB_XSUB(j)  (1280 + 64 * (j))
#define XB_XGEN(j)  (2304 + 64 * (j))
#define XB_TOP      3328
#define XB_TOPGEN   3392
#define XCD_BAR_WORDS 3456
#define XB_SPIN_CAP (1u << 18)
__device__ __forceinline__ unsigned xb_ld(unsigned* p)              { return __hip_atomic_load(p, __ATOMIC_RELAXED, __HIP_MEMORY_SCOPE_AGENT); }
__device__ __forceinline__ unsigned xb_add(unsigned* p, unsigned v) { return __hip_atomic_fetch_add(p, v, __ATOMIC_RELAXED, __HIP_MEMORY_SCOPE_AGENT); }
__device__ __forceinline__ unsigned xb_xcc_id() { return (unsigned)__builtin_amdgcn_s_getreg((3 << 11) | 20) & 0xFu; }
#define XB_SPIN(cond, bar) do { unsigned _sp = 0; while (cond) { __builtin_amdgcn_s_sleep(1); \
    if ((++_sp & 255u) == 0u) { if (xb_ld(&(bar)[XB_TMO])) break; if (_sp > XB_SPIN_CAP) { atomicAdd(&(bar)[XB_TMO], 1u); break; } } } } while (0)
struct XcdBarrier { unsigned* bar; unsigned x; volatile LAS unsigned* st; };
__device__ __forceinline__ XcdBarrier xcd_barrier_post(unsigned* bar, volatile LAS unsigned* st) {
    XcdBarrier b; b.bar = bar; b.x = xb_xcc_id(); b.st = st;
    if (threadIdx.x == 0) (void)xb_add(&bar[XB_XCNT(b.x)], 1u);
    return b;
}
__device__ __forceinline__ void xcd_barrier_complete(unsigned* bar, unsigned x, unsigned& nloc, unsigned& nx) {
    const unsigned G = gridDim.x * gridDim.y * gridDim.z;
    unsigned sum, cnt, mine, sp = 0u;
    for (;;) {
        sum = 0u; cnt = 0u; mine = 0u;
#pragma unroll
        for (unsigned j = 0; j < 16; ++j) { const unsigned c = xb_ld(&bar[XB_XCNT(j)]); sum += c; cnt += (c > 0u) ? 1u : 0u; mine = (j == x) ? c : mine; }
        if (sum == G) break;
        __builtin_amdgcn_s_sleep(1);
        if ((++sp & 255u) == 0u) { if (xb_ld(&bar[XB_TMO])) break; if (sp > XB_SPIN_CAP) { atomicAdd(&bar[XB_TMO], 1u); break; } }
    }
    nloc = mine > 0u ? mine : 1u; nx = cnt > 0u ? cnt : 1u;
}
__device__ __forceinline__ void xcd_barrier(const XcdBarrier& b) {
    asm volatile("s_waitcnt vmcnt(0)" ::: "memory");
    __syncthreads();
    if (threadIdx.x == 0) {
        unsigned* bar = b.bar;
        __builtin_amdgcn_s_waitcnt(0);
        unsigned nloc = b.st[0], nx = b.st[1];
        if (nloc == 0u) { xcd_barrier_complete(bar, b.x, nloc, nx); b.st[0] = nloc; b.st[1] = nx; }
        const unsigned old = xb_add(&bar[XB_XSUB(b.x)], 1u);
        const unsigned gen = old / nloc;
        if (old + 1u == (gen + 1u) * nloc) {
            __builtin_amdgcn_fence(__ATOMIC_RELEASE, "agent");
            asm volatile("s_waitcnt vmcnt(0)" ::: "memory");
            const unsigned og = xb_add(&bar[XB_TOP], 1u);
            const unsigned tg = og / nx;
            if (og + 1u == (tg + 1u) * nx) xb_add(&bar[XB_TOPGEN], 1u);
            else XB_SPIN(xb_ld(&bar[XB_TOPGEN]) == tg, bar);
            __builtin_amdgcn_fence(__ATOMIC_ACQUIRE, "agent");
            xb_add(&bar[XB_XGEN(b.x)], 1u);
            asm volatile("s_waitcnt vmcnt(0)" ::: "memory");
        } else {
            XB_SPIN(xb_ld(&bar[XB_XGEN(b.x)]) == gen, bar);
            __builtin_amdgcn_fence(__ATOMIC_ACQUIRE, "agent");
            asm volatile("s_waitcnt vmcnt(0)" ::: "memory");
        }
    }
    __syncthreads();
}

constexpr int NWAVES = 8, NTHREADS = 512;
constexpr int RING_BYTES = 131072, LDSCTL_OFF = RING_BYTES, MISC_OFF = LDSCTL_OFF + 320, LDS_BYTES = 147456;
constexpr int CW_BAR = 4096;

struct Args { const void* in[25]; float* out; unsigned char* ws; int ph_lo, ph_hi, li, pad; };

struct Ctx {
    LAS unsigned char* lds; unsigned char* lds_g;
    int tid, lane, wave, vcu, G;
    const float *x, *c, *rel_bias, *w_ada, *b_ada, *w_in, *qnorm, *w_uq, *kvnorm, *w_ukv, *lq1, *lk1, *lq2, *lk2, *subln, *w_out, *ln1g, *ln1b, *w_router, *w_gate, *w_up, *w_down, *ln2g, *ln2b;
    const int* pos;
    float* out; unsigned char* ws;
    float *MOD, *MISC, *CS, *SN, *AFF, *GATE, *RINVQ, *RINVKV, *Y;
    int *PMM, *IDX, *SLOT;
    bf16 *KR, *WIN, *WUQ, *WUKV, *WOUT, *WD, *WGU, *YE, *PROJ, *Q, *KV, *U2, *U, *AO, *HLO, *HHI;
};
__device__ __forceinline__ void ctx_init(Ctx& C, const Args& a) {
    C.x = (const float*)a.in[0]; C.c = (const float*)a.in[1]; C.pos = (const int*)a.in[2]; C.rel_bias = (const float*)a.in[3];
    C.w_ada = (const float*)a.in[4]; C.b_ada = (const float*)a.in[5]; C.w_in = (const float*)a.in[6]; C.qnorm = (const float*)a.in[7];
    C.w_uq = (const float*)a.in[8]; C.kvnorm = (const float*)a.in[9]; C.w_ukv = (const float*)a.in[10];
    C.lq1 = (const float*)a.in[11]; C.lk1 = (const float*)a.in[12]; C.lq2 = (const float*)a.in[13]; C.lk2 = (const float*)a.in[14];
    C.subln = (const float*)a.in[15]; C.w_out = (const float*)a.in[16]; C.ln1g = (const float*)a.in[17]; C.ln1b = (const float*)a.in[18];
    C.w_router = (const float*)a.in[19]; C.w_gate = (const float*)a.in[20]; C.w_up = (const float*)a.in[21]; C.w_down = (const float*)a.in[22];
    C.ln2g = (const float*)a.in[23]; C.ln2b = (const float*)a.in[24];
    C.out = a.out; unsigned char* ws = a.ws; C.ws = ws;
    C.MOD = (float*)(ws + WS_MOD); C.MISC = (float*)(ws + WS_MISC); C.PMM = (int*)(ws + WS_PMM); C.CS = (float*)(ws + WS_CS); C.SN = (float*)(ws + WS_SN);
    C.AFF = (float*)(ws + WS_AFF); C.IDX = (int*)(ws + WS_IDX); C.GATE = (float*)(ws + WS_GATE); C.SLOT = (int*)(ws + WS_SLOT);
    C.RINVQ = (float*)(ws + WS_RINVQ); C.RINVKV = (float*)(ws + WS_RINVKV); C.KR = (bf16*)(ws + WS_KR);
    C.WIN = (bf16*)(ws + WS_WIN); C.WUQ = (bf16*)(ws + WS_WUQ); C.WUKV = (bf16*)(ws + WS_WUKV); C.WOUT = (bf16*)(ws + WS_WOUT);
    C.WD = (bf16*)(ws + WS_WD); C.WGU = (bf16*)(ws + WS_WGU); C.YE = (bf16*)(ws + WS_YE);
    C.PROJ = (bf16*)(ws + WS_PROJ); C.Y = (float*)(ws + WS_Y); C.HLO = (bf16*)(ws + WS_HLO); C.HHI = (bf16*)(ws + WS_HHI);
    C.Q = (bf16*)(ws + WS_Q); C.KV = (bf16*)(ws + WS_KV); C.U2 = (bf16*)(ws + WS_U2); C.U = (bf16*)(ws + WS_U); C.AO = (bf16*)(ws + WS_AO);
}

__device__ __forceinline__ void store8_bf16(bf16* p, const float (&v)[8]) {
    u32x4 w; w.x = pk2(v[0], v[1]); w.y = pk2(v[2], v[3]); w.z = pk2(v[4], v[5]); w.w = pk2(v[6], v[7]); *(u32x4*)p = w;
}
struct FPlain { bf16* O; int ldc;
    __device__ __forceinline__ void row8(int kind, int row, int col, const float (&v)[8]) const { store8_bf16(O + (size_t)row * ldc + col, v); } };
struct FRowScale { bf16* O; int ldc; const float* rs;
    __device__ __forceinline__ void row8(int kind, int row, int col, const float (&v)[8]) const {
        const float s = rs[row]; float o[8];
#pragma unroll
        for (int i = 0; i < 8; ++i) o[i] = v[i] * s;
        store8_bf16(O + (size_t)row * ldc + col, o);
    } };
struct FY { float* Y; const float* x; const float* mod;
    __device__ __forceinline__ void row8(int kind, int row, int col, const float (&v)[8]) const {
        const int b = row >> 11; const float* ga = mod + b * 6144 + 2048 + col; const float* xr = x + (size_t)row * DM + col; float* yo = Y + (size_t)row * DM + col;
        const f32x4 g0 = *(const f32x4*)ga, g1 = *(const f32x4*)(ga + 4), x0 = *(const f32x4*)xr, x1 = *(const f32x4*)(xr + 4);
        f32x4 y0, y1;
#pragma unroll
        for (int i = 0; i < 4; ++i) { y0[i] = ALPHA * x0[i] + g0[i] * v[i]; y1[i] = ALPHA * x1[i] + g1[i] * v[4 + i]; }
        *(f32x4*)yo = y0; *(f32x4*)(yo + 4) = y1;
    } };
struct FSwi { unsigned char* H;
    __device__ __forceinline__ void pair8(int row, int col, const float (&g)[8], const float (&u)[8]) const {
        float o[8];
#pragma unroll
        for (int i = 0; i < 8; ++i) o[i] = silu_f(g[i] * DS_UP) * (u[i] * (DS_UP * SC_H));
        u32x2 w; w.x = cvt4_fp8(o[0], o[1], o[2], o[3]); w.y = cvt4_fp8(o[4], o[5], o[6], o[7]);
        *(u32x2*)(H + (size_t)row * FF + col) = w;
    } };
struct FGate { bf16* YE; const float* gate;
    __device__ __forceinline__ void row8(int kind, int row, int col, const float (&v)[8]) const {
        const float s = gate[row] * DS_DOWN; float o[8];
#pragma unroll
        for (int i = 0; i < 8; ++i) o[i] = v[i] * s;
        store8_bf16(YE + (size_t)row * DM + col, o);
    } };

template <bool DUAL, class ARow, class BRow, class Epi>
__device__ __forceinline__ void naive_gemm_tile(int m0, int n0, int K, const ARow& arow, const BRow& brow, const Epi& epi, int kind, float* lds) {
    const int tid = threadIdx.x, ty = tid >> 4, tx = tid & 15;
    float* As = lds;
    float* Bs = lds + 16 * 132;
    float* Cs = lds + 32 * 132;
    float acc[4][8], acc2[4][8];
#pragma unroll
    for (int i = 0; i < 4; ++i)
#pragma unroll
        for (int j = 0; j < 8; ++j) { acc[i][j] = 0.f; acc2[i][j] = 0.f; }
    const int lr = tid >> 2, lk = (tid & 3) * 4;
    const bf16* ap = arow(m0 + lr); const bf16* bp = brow(n0 + lr, 0); const bf16* cp = DUAL ? brow(n0 + lr, 1) : bp;
    for (int k0 = 0; k0 < K; k0 += 16) {
        const u32x2 av = *(const u32x2*)(ap + k0 + lk), bv = *(const u32x2*)(bp + k0 + lk);
        u32x2 cv = bv; if (DUAL) cv = *(const u32x2*)(cp + k0 + lk);
        __syncthreads();
        As[(lk + 0) * 132 + lr] = bflo(av.x); As[(lk + 1) * 132 + lr] = bfhi(av.x); As[(lk + 2) * 132 + lr] = bflo(av.y); As[(lk + 3) * 132 + lr] = bfhi(av.y);
        Bs[(lk + 0) * 132 + lr] = bflo(bv.x); Bs[(lk + 1) * 132 + lr] = bfhi(bv.x); Bs[(lk + 2) * 132 + lr] = bflo(bv.y); Bs[(lk + 3) * 132 + lr] = bfhi(bv.y);
        if (DUAL) { Cs[(lk + 0) * 132 + lr] = bflo(cv.x); Cs[(lk + 1) * 132 + lr] = bfhi(cv.x); Cs[(lk + 2) * 132 + lr] = bflo(cv.y); Cs[(lk + 3) * 132 + lr] = bfhi(cv.y); }
        __syncthreads();
#pragma unroll
        for (int kk = 0; kk < 16; ++kk) {
            const f32x4 a = *(const f32x4*)(As + kk * 132 + ty * 4);
            const f32x4 b0 = *(const f32x4*)(Bs + kk * 132 + tx * 8), b1 = *(const f32x4*)(Bs + kk * 132 + tx * 8 + 4);
#pragma unroll
            for (int i = 0; i < 4; ++i)
#pragma unroll
                for (int j = 0; j < 4; ++j) { acc[i][j] += a[i] * b0[j]; acc[i][4 + j] += a[i] * b1[j]; }
            if (DUAL) {
                const f32x4 c0 = *(const f32x4*)(Cs + kk * 132 + tx * 8), c1 = *(const f32x4*)(Cs + kk * 132 + tx * 8 + 4);
#pragma unroll
                for (int i = 0; i < 4; ++i)
#pragma unroll
                    for (int j = 0; j < 4; ++j) { acc2[i][j] += a[i] * c0[j]; acc2[i][4 + j] += a[i] * c1[j]; }
            }
        }
    }
#pragma unroll
    for (int i = 0; i < 4; ++i) {
        if constexpr (DUAL) epi.pair8(m0 + ty * 4 + i, n0 + tx * 8, acc[i], acc2[i]);
        else epi.row8(kind, m0 + ty * 4 + i, n0 + tx * 8, acc[i]);
    }
}

__device__ __forceinline__ void tr_item(const float* W, int ldw, int kb, int srccol0, bool perm, float scale, const float* kgain, int kvalid,
                                        bf16* WT, int ldt, int n0, LAS float* scr, int lane) {
    const int k0 = 64 * kb, cl = lane & 31;
    const int sc = perm ? (16 * ((cl >> 2) & 1) + 4 * (cl >> 3) + (cl & 3)) : cl;
#pragma unroll 8
    for (int i = 0; i < 32; ++i) { const int kk = 2 * i + (lane >> 5), k = k0 + kk; float v = 0.f;
        if (srccol0 >= 0 && k < kvalid) { v = W[(size_t)k * ldw + srccol0 + sc] * scale; if (kgain) v *= kgain[k]; }
        scr[kk * 33 + cl] = v; }
    LDS_WAIT(); asm volatile("" ::: "memory");
    const int c = lane & 7;
#pragma unroll
    for (int j = 0; j < 4; ++j) { const int n = (lane >> 3) + 8 * j; const LAS float* s = scr + (8 * c) * 33 + n;
        u32x4 o; o.x = pk2(s[0 * 33], s[1 * 33]); o.y = pk2(s[2 * 33], s[3 * 33]); o.z = pk2(s[4 * 33], s[5 * 33]); o.w = pk2(s[6 * 33], s[7 * 33]);
        *(GAS u32x4*)(WT + (size_t)(n0 + n) * ldt + k0 + 8 * c) = o; }
    LDS_WAIT(); asm volatile("" ::: "memory");
}
__device__ __forceinline__ int t5_bucket(int rel) {
    const int nb = 16, max_exact = 8; int ret = rel > 0 ? nb : 0; const int n = rel < 0 ? -rel : rel;
    const float nf = (float)(n > 1 ? n : 1);
    int large = max_exact + (int)(logf(nf / 8.0f) / 2.772588722239781f * 8.0f);
    large = large < nb - 1 ? large : nb - 1;
    return ret + (n < max_exact ? n : large);
}

__device__ __forceinline__ void phase_prep(const Ctx& C) {
    LAS float* scr = (LAS float*)(C.lds + C.wave * 8448);
    const int gw = C.vcu * NWAVES + C.wave, NGW = C.G * NWAVES;
    constexpr int I_IN = 16 * 64, I_UQ = 4 * 24, I_UKV = 4 * 32, I_OUT = 16 * 32, NIT = I_IN + I_UQ + I_UKV + I_OUT;
    for (int it = gw; it < NIT; it += NGW) {
        int r = it;
        if (r < I_IN) { const int kb = r / 64, nb = r % 64, n0 = 32 * nb; int src; bool perm = false; float sc = 1.f;
            if (nb < 12) src = n0; else if (nb == 12) { src = 384; perm = true; } else if (nb < 16) src = -1; else { src = 416 + (n0 - 512); if (n0 < 1024) sc = DIFF_SCALE * LOG2E; }
            tr_item(C.w_in, 1952, kb, src, perm, sc, nullptr, 1024, C.WIN, 1024, n0, scr, C.lane); continue; }
        r -= I_IN;
        if (r < I_UQ) { const int kb = r / 24, nb = r % 24, n0 = 32 * nb; int src; bool perm = false;
            if (nb < 16) { src = 96 * (n0 >> 6) + (n0 & 63); } else { src = 96 * (nb - 16) + 64; perm = true; }
            tr_item(C.w_uq, 768, kb, src, perm, MLA_SCALE * LOG2E, C.qnorm, 256, C.WUQ, 256, n0, scr, C.lane); continue; }
        r -= I_UQ;
        if (r < I_UKV) { const int kb = r / 32, nb = r % 32, n0 = 32 * nb; int src;
            if (nb < 16) src = 128 * (n0 >> 6) + (n0 & 63); else { const int n1 = n0 - 512; src = 128 * (n1 >> 6) + 64 + (n1 & 63); }
            tr_item(C.w_ukv, 1024, kb, src, false, 1.f, C.kvnorm, 128, C.WUKV, 256, n0, scr, C.lane); continue; }
        r -= I_UKV;
        { const int kb = r / 32, nb = r % 32; tr_item(C.w_out, 1024, kb, 32 * nb, false, 1.f, nullptr, 1024, C.WOUT, 1024, 32 * nb, scr, C.lane); }
    }
    for (int i = (C.vcu * NTHREADS + C.tid); i < T * 16; i += C.G * NTHREADS) { const int t = i >> 4, j = i & 15;
        const float freq = (float)pow(10000.0, -(double)j / 16.0); const float ang = (float)C.pos[t] * freq; float s, c; sincosf(ang, &s, &c);
        C.CS[i] = c; C.SN[i] = s; }
    for (int i = (C.vcu * NTHREADS + C.tid); i < BATCH * 32; i += C.G * NTHREADS) { int mn = 0x7fffffff, mx = -0x7fffffff - 1;
        for (int k = 0; k < 64; ++k) { const int p = C.pos[i * 64 + k]; mn = p < mn ? p : mn; mx = p > mx ? p : mx; }
        C.PMM[2 * i] = mn; C.PMM[2 * i + 1] = mx; }
    if (C.vcu == 255 % C.G) {
        for (int i = C.tid; i < 4 * 257; i += NTHREADS) { const int h = i / 257, r = i % 257 - 128; C.MISC[64 + h * 260 + (r + 128)] = C.rel_bias[t5_bucket(r) * 4 + h] * LOG2E; }
        if (C.wave == 0) { const float a = wave_sum(C.lq1[C.lane] * C.lk1[C.lane]), b = wave_sum(C.lq2[C.lane] * C.lk2[C.lane]);
            if (C.lane == 0) C.MISC[0] = expf(a) - expf(b) + LAMBDA_INIT; }
    }
    __syncthreads();
    LAS float* cact = (LAS float*)C.lds;
    LAS float* red = (LAS float*)(C.lds + 65536);
    bool have = false;
    for (int u = C.vcu; u < 192; u += C.G) {
        if (!have) { for (int i = C.tid; i < 16 * 1024; i += NTHREADS) { const int b = i >> 10, d = i & 1023; const float v = C.c[i]; cact[d * 16 + b] = v / (1.0f + expf(-v)); } have = true; __syncthreads(); }
        const int nl = C.tid & 31, kc = C.tid >> 5, n = 32 * u + nl;
        float acc[16];
#pragma unroll
        for (int b = 0; b < 16; ++b) acc[b] = 0.f;
#pragma unroll 8
        for (int i = 0; i < 64; ++i) { const int d = kc * 64 + i; const float w = C.w_ada[(size_t)d * 6144 + n];
#pragma unroll
            for (int q = 0; q < 4; ++q) { const f32x4 ca = *(const LAS f32x4*)(cact + d * 16 + 4 * q); acc[4 * q] += w * ca[0]; acc[4 * q + 1] += w * ca[1]; acc[4 * q + 2] += w * ca[2]; acc[4 * q + 3] += w * ca[3]; } }
#pragma unroll
        for (int b = 0; b < 16; ++b) red[(kc * 16 + b) * 32 + nl] = acc[b];
        __syncthreads();
        { const int b = C.tid >> 5; float s = C.b_ada[n];
#pragma unroll
            for (int k = 0; k < 16; ++k) s += red[(k * 16 + b) * 32 + nl];
            C.MOD[b * 6144 + n] = s; }
        __syncthreads();
    }
}
__device__ __forceinline__ void phase_u(const Ctx& C) {
    for (size_t i = (size_t)C.vcu * NTHREADS + C.tid; i < (size_t)T * DM / 8; i += (size_t)C.G * NTHREADS) {
        const size_t e = i * 8; const int row = (int)(e >> 10), col = (int)(e & 1023), b = row >> 11;
        const f32x4 x0 = *(const f32x4*)(C.x + e), x1 = *(const f32x4*)(C.x + e + 4);
        const float* sh = C.MOD + b * 6144 + col; const float* sc = sh + 1024;
        const f32x4 h0 = *(const f32x4*)sh, h1 = *(const f32x4*)(sh + 4), c0 = *(const f32x4*)sc, c1 = *(const f32x4*)(sc + 4);
        u32x4 w; w.x = pk2(x0[0] * (1.f + c0[0]) + h0[0], x0[1] * (1.f + c0[1]) + h0[1]); w.y = pk2(x0[2] * (1.f + c0[2]) + h0[2], x0[3] * (1.f + c0[3]) + h0[3]);
        w.z = pk2(x1[0] * (1.f + c1[0]) + h1[0], x1[1] * (1.f + c1[1]) + h1[1]); w.w = pk2(x1[2] * (1.f + c1[2]) + h1[2], x1[3] * (1.f + c1[3]) + h1[3]);
        *(u32x4*)(C.U + e) = w;
    }
}
__device__ __forceinline__ void phase_fix1(const Ctx& C) {
    const int gw = C.vcu * NWAVES + C.wave, NGW = C.G * NWAVES;
    for (int t = gw; t < T; t += NGW) {
        const bf16* pr = C.PROJ + (size_t)t * NPROJ;
        const u32x2 q = *(const u32x2*)(pr + 4 * C.lane); const unsigned kv = *(const unsigned*)(pr + 256 + 2 * C.lane);
        float sq = bflo(q.x) * bflo(q.x) + bfhi(q.x) * bfhi(q.x) + bflo(q.y) * bflo(q.y) + bfhi(q.y) * bfhi(q.y);
        float sk = bflo(kv) * bflo(kv) + bfhi(kv) * bfhi(kv);
        sq = wave_sum(sq); sk = wave_sum(sk);
        if (C.lane == 0) { C.RINVQ[t] = 1.0f / sqrtf(sq * (1.f / 256.f) + RMS_EPS); C.RINVKV[t] = 1.0f / sqrtf(sk * (1.f / 128.f) + RMS_EPS); }
        if (C.lane < 4) { const int fq = C.lane; const u32x4 w = *(const u32x4*)(pr + 384 + 8 * fq);
            const f32x4 c4 = *(const f32x4*)(C.CS + (size_t)t * 16 + 4 * fq), s4 = *(const f32x4*)(C.SN + (size_t)t * 16 + 4 * fq);
            const float t1[4] = {bflo(w.x), bfhi(w.x), bflo(w.y), bfhi(w.y)}, t2[4] = {bflo(w.z), bfhi(w.z), bflo(w.w), bfhi(w.w)};
            float o[8];
#pragma unroll
            for (int i = 0; i < 4; ++i) { o[i] = t1[i] * c4[i] - t2[i] * s4[i]; o[4 + i] = t1[i] * s4[i] + t2[i] * c4[i]; }
            store8_bf16(C.KR + (size_t)t * 32 + 8 * fq, o); }
    }
}
__device__ __forceinline__ void phase_ln1(const Ctx& C) {
    LAS float* wr = (LAS float*)C.lds;
    LAS float* urow = (LAS float*)(C.lds + 65536) + C.wave * 1024;
    for (int i = C.tid; i < 1024 * 4; i += NTHREADS) { const int d = i >> 2, ch = i & 3; const f32x4 v = *(const f32x4*)(C.w_router + d * 16 + 4 * ch);
        *(LAS f32x4*)(wr + d * 16 + 4 * (ch ^ ((d >> 2) & 3))) = v; }
    __syncthreads();
    const int gw = C.vcu * NWAVES + C.wave, NGW = C.G * NWAVES;
    for (int t = gw; t < T; t += NGW) {
        const int b = t >> 11, s = t & 2047;
        const f32x4* yr = (const f32x4*)(C.Y + (size_t)t * DM) + C.lane;
        f32x4 v[4]; float sum = 0.f;
#pragma unroll
        for (int j = 0; j < 4; ++j) { v[j] = yr[64 * j]; sum += (v[j][0] + v[j][1]) + (v[j][2] + v[j][3]); }
        const float mean = wave_sum(sum) * (1.f / DM); float s2 = 0.f;
#pragma unroll
        for (int j = 0; j < 4; ++j) { v[j] = v[j] - mean; s2 += (v[j][0] * v[j][0] + v[j][1] * v[j][1]) + (v[j][2] * v[j][2] + v[j][3] * v[j][3]); }
        const float rstd = 1.0f / sqrtf(wave_sum(s2) * (1.f / DM) + LN_EPS);
        const float* mod = C.MOD + b * 6144;
#pragma unroll
        for (int j = 0; j < 4; ++j) { const int col = 4 * C.lane + 256 * j;
            const f32x4 g = *(const f32x4*)(C.ln1g + col), be = *(const f32x4*)(C.ln1b + col), sh = *(const f32x4*)(mod + 3072 + col), sc = *(const f32x4*)(mod + 4096 + col);
            f32x4 x1, u2;
#pragma unroll
            for (int i = 0; i < 4; ++i) { x1[i] = v[j][i] * rstd * g[i] + be[i]; u2[i] = x1[i] * (1.f + sc[i]) + sh[i]; }
            *(f32x4*)(C.out + (size_t)t * DM + col) = x1;
            *(unsigned*)((unsigned char*)C.U2 + (size_t)t * DM + col) = cvt4_fp8(u2[0] * SC_U2, u2[1] * SC_U2, u2[2] * SC_U2, u2[3] * SC_U2);
            *(LAS f32x4*)(urow + col) = u2; }
        LDS_WAIT(); asm volatile("" ::: "memory");
        float lg[16];
#pragma unroll
        for (int e = 0; e < 16; ++e) lg[e] = 0.f;
#pragma unroll 4
        for (int k = 0; k < 16; ++k) { const int d = C.lane + 64 * k; const float uv = urow[d]; const int sw = (d >> 2) & 3;
#pragma unroll
            for (int ch = 0; ch < 4; ++ch) { const f32x4 w = *(const LAS f32x4*)(wr + d * 16 + 4 * (ch ^ sw)); lg[4 * ch] += uv * w[0]; lg[4 * ch + 1] += uv * w[1]; lg[4 * ch + 2] += uv * w[2]; lg[4 * ch + 3] += uv * w[3]; } }
        float mx = -1e30f;
#pragma unroll
        for (int e = 0; e < 16; ++e) { lg[e] = wave_sum(lg[e]); mx = fmaxf(mx, lg[e]); }
        float den = 0.f;
#pragma unroll
        for (int e = 0; e < 16; ++e) { lg[e] = expf(lg[e] - mx); den += lg[e]; }
        const float rden = 1.0f / den; float mine = 0.f;
#pragma unroll
        for (int e = 0; e < 16; ++e) mine = (C.lane == e) ? lg[e] * rden : mine;
        if (C.lane < 16) C.AFF[((size_t)b * 16 + C.lane) * SEQ + s] = mine;
        LDS_WAIT(); asm volatile("" ::: "memory");
    }
}
__device__ __forceinline__ unsigned block_count(LAS unsigned* cnt, int wave, int lane, unsigned c) {
    c += __shfl_xor(c, 1); c += __shfl_xor(c, 2); c += __shfl_xor(c, 4); c += __shfl_xor(c, 8); c += __shfl_xor(c, 16); c += __shfl_xor(c, 32);
    __syncthreads();
    if (lane == 0) cnt[wave] = c;
    __syncthreads();
    unsigned s = 0;
#pragma unroll
    for (int w = 0; w < NWAVES; ++w) s += cnt[w];
    return s;
}
__device__ __forceinline__ unsigned block_excl_scan(LAS unsigned* cnt, int wave, int lane, unsigned c) {
    unsigned inc = c;
#pragma unroll
    for (int o = 1; o < 64; o <<= 1) { const unsigned n = __shfl_up(inc, o); if (lane >= o) inc += n; }
    __syncthreads();
    if (lane == 63) cnt[wave] = inc;
    __syncthreads();
    unsigned base = 0;
#pragma unroll
    for (int w = 0; w < NWAVES; ++w) base += (w < wave) ? cnt[w] : 0u;
    return base + inc - c;
}
__device__ __forceinline__ void phase_topk(const Ctx& C) {
    LAS unsigned* cnt = (LAS unsigned*)(C.lds + 4096);
    for (int be = C.vcu; be < BATCH * NE; be += C.G) {
        const int b = be >> 4, e = be & 15;
        const float* aff = C.AFF + ((size_t)b * 16 + e) * SEQ;
        const u32x4 kv = *(const u32x4*)(aff + 4 * C.tid);
        const unsigned key[4] = {kv.x, kv.y, kv.z, kv.w};
        unsigned prefix = 0;
        for (int bit = 30; bit >= 0; --bit) { const unsigned cand = prefix | (1u << bit);
            unsigned c = 0;
#pragma unroll
            for (int i = 0; i < 4; ++i) c += key[i] >= cand ? 1u : 0u;
            if (block_count(cnt, C.wave, C.lane, c) >= (unsigned)CAP) prefix = cand; }
        unsigned cg = 0, ce = 0;
#pragma unroll
        for (int i = 0; i < 4; ++i) { cg += key[i] > prefix ? 1u : 0u; ce += key[i] == prefix ? 1u : 0u; }
        const unsigned ngt = block_count(cnt, C.wave, C.lane, cg);
        const unsigned need = (unsigned)CAP - ngt;
        unsigned tb = block_excl_scan(cnt, C.wave, C.lane, ce);
        unsigned sel[4], cs = 0;
#pragma unroll
        for (int i = 0; i < 4; ++i) { const bool eq = key[i] == prefix; sel[i] = (key[i] > prefix || (eq && tb < need)) ? 1u : 0u; tb += eq ? 1u : 0u; cs += sel[i]; }
        unsigned p = block_excl_scan(cnt, C.wave, C.lane, cs);
#pragma unroll
        for (int i = 0; i < 4; ++i) { const int s = 4 * C.tid + i; int slot = -1;
            if (sel[i]) { slot = (int)p; C.IDX[be * CAP + p] = s; C.GATE[be * CAP + p] = __uint_as_float(key[i]); ++p; }
            C.SLOT[((size_t)b * 16 + e) * SEQ + s] = slot; }
        __syncthreads();
    }
}
typedef short s16x4_t __attribute__((ext_vector_type(4)));
__device__ __forceinline__ void tr64_item(const float* W, int ldw, int k0, int n0, float scale, unsigned char* WT, int ldt, int nt0, LAS unsigned char* img, int lane) {
    const int kr = lane >> 4, c4 = lane & 15;
    f32x4 v[16];
    const float* src = W + (size_t)(k0 + kr) * ldw + n0 + 4 * c4;
#pragma unroll
    for (int i = 0; i < 16; ++i) v[i] = *(const f32x4*)(src + (size_t)(4 * i) * ldw);
#pragma unroll
    for (int i = 0; i < 16; ++i) { u32x2 w; w.x = pk2(v[i][0] * scale, v[i][1] * scale); w.y = pk2(v[i][2] * scale, v[i][3] * scale); *(LAS u32x2*)(img + (4 * i + kr) * 192 + 8 * c4) = w; }
    LDS_WAIT(); asm volatile("" ::: "memory");
    const int g = lane >> 4, q = (lane >> 2) & 3, p = lane & 3, i16 = lane & 15;
    const int rdbase = (int)(unsigned)(size_t)img + (8 * (g >> 1) + q) * 192 + (16 * (g & 1) + 4 * p) * 2;
#pragma unroll
    for (int s = 0; s < 8; ++s) { const int jj = s >> 1, nn = s & 1;
        s16x4_t lo, hi;
        asm volatile("ds_read_b64_tr_b16 %0, %1 offset:%2" : "=&v"(lo) : "v"(rdbase), "i"((16 * jj) * 192 + 64 * nn) : "memory");
        asm volatile("ds_read_b64_tr_b16 %0, %1 offset:%2" : "=&v"(hi) : "v"(rdbase), "i"((16 * jj + 4) * 192 + 64 * nn) : "memory");
        asm volatile("s_waitcnt lgkmcnt(0)" : "+v"(lo), "+v"(hi) :: "memory");
        const int kc = 2 * jj + (g >> 1), n = 16 * (2 * nn + (g & 1)) + i16;
        const u32x2 l2 = __builtin_bit_cast(u32x2, lo), h2 = __builtin_bit_cast(u32x2, hi);
        u32x2 o; o.x = cvt4_fp8(bflo(l2.x), bfhi(l2.x), bflo(l2.y), bfhi(l2.y)); o.y = cvt4_fp8(bflo(h2.x), bfhi(h2.x), bflo(h2.y), bfhi(h2.y));
        *(GAS u32x2*)(WT + (size_t)(nt0 + n) * ldt + k0 + 8 * kc) = o; }
    LDS_WAIT(); asm volatile("" ::: "memory");
}
__device__ __forceinline__ void phase_wconv(const Ctx& C) {
    LAS unsigned char* img = C.lds + 8192 + C.wave * 12288;
    const int gw = C.vcu * NWAVES + C.wave, NGW = C.G * NWAVES;
    constexpr int I_GU = 2 * 16 * 32, I_D = 32 * 16, I_E = I_GU + I_D;
    for (int it = gw; it < NE * I_E; it += NGW) {
        const int e = it / I_E; int r = it % I_E;
        if (r < I_GU) { const int up = r >> 9, kb = (r >> 5) & 15, nb = r & 31, n0 = 64 * nb;
            const float* W = (up ? C.w_up : C.w_gate) + (size_t)e * DM * FF;
            tr64_item(W, FF, 64 * kb, n0, SC_WGU, (unsigned char*)C.WGU + (size_t)e * 4096 * DM, DM, (n0 >> 7) * 256 + (n0 & 127) + up * 128, img, C.lane); }
        else { r -= I_GU; const int kb = r >> 4, nb = r & 15;
            tr64_item(C.w_down + (size_t)e * FF * DM, DM, 64 * kb, 64 * nb, SC_WD, (unsigned char*)C.WD + (size_t)e * DM * FF, FF, 64 * nb, img, C.lane); }
    }
}
__device__ __forceinline__ void phase_final(const Ctx& C) {
    const int gw = C.vcu * NWAVES + C.wave, NGW = C.G * NWAVES;
    for (int t = gw; t < T; t += NGW) {
        const int b = t >> 11, s = t & 2047;
        f32x4 a[4];
#pragma unroll
        for (int j = 0; j < 4; ++j) a[j] = (f32x4){0.f, 0.f, 0.f, 0.f};
        const int myslot = C.lane < 16 ? C.SLOT[((size_t)b * 16 + C.lane) * SEQ + s] : -1;
        for (int e = 0; e < 16; ++e) { const int p = __shfl(myslot, e);
            if (p >= 0) { const bf16* yr = C.YE + ((size_t)(b * 16 + e) * CAP + p) * DM;
#pragma unroll
                for (int j = 0; j < 4; ++j) { const u32x2 w = *(const u32x2*)(yr + 4 * C.lane + 256 * j); a[j][0] += bflo(w.x); a[j][1] += bfhi(w.x); a[j][2] += bflo(w.y); a[j][3] += bfhi(w.y); } } }
        const float* mod = C.MOD + b * 6144 + 5120;
        f32x4 v[4]; float sum = 0.f;
#pragma unroll
        for (int j = 0; j < 4; ++j) { const int col = 4 * C.lane + 256 * j; const f32x4 x1 = *(const f32x4*)(C.out + (size_t)t * DM + col), g = *(const f32x4*)(mod + col);
#pragma unroll
            for (int i = 0; i < 4; ++i) v[j][i] = ALPHA * x1[i] + g[i] * a[j][i];
            sum += (v[j][0] + v[j][1]) + (v[j][2] + v[j][3]); }
        const float mean = wave_sum(sum) * (1.f / DM); float s2 = 0.f;
#pragma unroll
        for (int j = 0; j < 4; ++j) { v[j] = v[j] - mean; s2 += (v[j][0] * v[j][0] + v[j][1] * v[j][1]) + (v[j][2] * v[j][2] + v[j][3] * v[j][3]); }
        const float rstd = 1.0f / sqrtf(wave_sum(s2) * (1.f / DM) + LN_EPS);
#pragma unroll
        for (int j = 0; j < 4; ++j) { const int col = 4 * C.lane + 256 * j; const f32x4 g = *(const f32x4*)(C.ln2g + col), be = *(const f32x4*)(C.ln2b + col); f32x4 o;
#pragma unroll
            for (int i = 0; i < 4; ++i) o[i] = v[j][i] * rstd * g[i] + be[i];
            *(f32x4*)(C.out + (size_t)t * DM + col) = o; }
    }
}


namespace pg8 {
#define PG8_LAS __attribute__((address_space(3)))
constexpr int BM = 256, BK = 64, HALF = 128, HTB = HALF * BK * 2, STAGE_BYTES = 8 * HTB;
__host__ __device__ __forceinline__ int lds_byte(int r, int c) { const int st = (r >> 4) * 2 + (c >> 5), rr = r & 15, cc = c & 31, ob = rr * 64 + cc * 2; return st * 1024 + (ob ^ (((ob >> 9) & 1) << 5)); }
__host__ __device__ __forceinline__ void stage_rc(int b, int& R, int& C) { const int st = b / 1024, sb = b % 1024, swz = sb ^ (((sb >> 9) & 1) << 5); R = (st >> 1) * 16 + swz / 64; C = (st & 1) * 32 + (swz % 64) / 2; }
__host__ __device__ __forceinline__ int perm32(int rho) { const int n = rho >> 4, i = rho & 15; return 8 * (i >> 2) + 4 * n + (i & 3); }
struct Unit { int pm, pn, kind; };

template <class F> struct EpiRow8 { static constexpr bool PERM = true; F f;
    __device__ __forceinline__ void operator()(const f32x4 (&acc)[2][2][4][2], const Unit& u, int wr, int wc, int fr, int fq) const {
        const int row0 = u.pm * BM + wr * 64 + fr, col0 = u.pn * BM + wc * 32 + 8 * fq;
#pragma unroll
        for (int ai = 0; ai < 2; ++ai)
#pragma unroll
            for (int m = 0; m < 4; ++m)
#pragma unroll
                for (int bj = 0; bj < 2; ++bj) { const f32x4 a = acc[ai][bj][m][0], b = acc[ai][bj][m][1]; const float v[8] = {a[0], a[1], a[2], a[3], b[0], b[1], b[2], b[3]};
                    f.row8(u.kind, row0 + ai * HALF + m * 16, col0 + bj * HALF, v); }
    } };
struct EpiQKV { static constexpr bool PERM = true; FRowScale fq, fkv;
    __device__ __forceinline__ void operator()(const f32x4 (&acc)[2][2][4][2], const Unit& u, int wr, int wc, int fr, int fq_) const {
        EpiRow8<FRowScale> e{u.kind ? fkv : fq}; e(acc, u, wr, wc, fr, fq_);
    } };
template <class F> struct EpiPair8 { static constexpr bool PERM = true; F f;
    __device__ __forceinline__ void operator()(const f32x4 (&acc)[2][2][4][2], const Unit& u, int wr, int wc, int fr, int fq) const {
        const int row0 = u.pm * BM + wr * 64 + fr, col0 = u.pn * HALF + wc * 32 + 8 * fq;
#pragma unroll
        for (int ai = 0; ai < 2; ++ai)
#pragma unroll
            for (int m = 0; m < 4; ++m) { const f32x4 a = acc[ai][0][m][0], b = acc[ai][0][m][1], c = acc[ai][1][m][0], d = acc[ai][1][m][1];
                const float g[8] = {a[0], a[1], a[2], a[3], b[0], b[1], b[2], b[3]}, up[8] = {c[0], c[1], c[2], c[3], d[0], d[1], d[2], d[3]};
                f.pair8(row0 + ai * HALF + m * 16, col0, g, up); }
    } };

template <class Epi, class Sched, bool FP8 = false, bool ALIGN_EPI = true, bool SP2 = true>
__device__ __forceinline__ void gemm_phase(PG8_LAS unsigned char* lds, const int KB  , const Sched& S, const Epi& E) {
    const int tid = threadIdx.x, wid = __builtin_amdgcn_readfirstlane(tid >> 6), lane = tid & 63, wr = wid >> 2, wc = wid & 3, fr = lane & 15, fq = lane >> 4;
    const int nt = KB / (BK * 2);
    Unit cur, nxt; int ui = 0;
    if (!S.next(0, cur)) return;
    unsigned voffA[2][2], voffB[2];
#pragma unroll
    for (int i = 0; i < 2; ++i) { int R, C; stage_rc(tid * 16 + i * 8192, R, C); const int Rb = Epi::PERM ? ((R & ~31) + perm32(R & 31)) : R;
        voffB[i] = (unsigned)(Rb * S.ldb) + (unsigned)C * 2u;
#pragma unroll
        for (int h = 0; h < 2; ++h) voffA[h][i] = S.a_rowoff(cur, h * HALF + R) + (unsigned)C * 2u; }
    const size_t kstep = (size_t)(BK * 2);
    const size_t hstepB = (size_t)HALF * S.ldb;
    const unsigned ldsw = (unsigned)wid * 1024u;
    const int aoff = lds_byte(wr * 64 + fr, fq * 8), boff = lds_byte(wc * 32 + fr, fq * 8);
#define PG8_SA(b, h) (((b) * 2 + (h)) * HTB)
#define PG8_SB(b, h) ((4 + (b) * 2 + (h)) * HTB)
#define PG8_STAGE_A(bufoff, gbase, h) do { _Pragma("unroll") for (int _i = 0; _i < 2; ++_i) \
        __builtin_amdgcn_global_load_lds((const unsigned*)((const char*)(gbase) + voffA[h][_i]), (PG8_LAS unsigned*)(lds + (bufoff) + ldsw + _i * 8192), 16, 0, 0); } while (0)
#define PG8_STAGE_B(bufoff, gbase) do { _Pragma("unroll") for (int _i = 0; _i < 2; ++_i) \
        __builtin_amdgcn_global_load_lds((const unsigned*)((const char*)(gbase) + voffB[_i]), (PG8_LAS unsigned*)(lds + (bufoff) + ldsw + _i * 8192), 16, 0, 0); } while (0)
#define PG8_LDA(dst, b, h) do { _Pragma("unroll") for (int m = 0; m < 4; ++m) dst[m] = PG8_CAT(*(const PG8_LAS i32x4*)(lds + PG8_SA(b, h) + aoff + m * 2048), *(const PG8_LAS i32x4*)(lds + PG8_SA(b, h) + aoff + m * 2048 + 1024)); } while (0)
#define PG8_LDB(dst, b, h) do { _Pragma("unroll") for (int n = 0; n < 2; ++n) dst[n] = PG8_CAT(*(const PG8_LAS i32x4*)(lds + PG8_SB(b, h) + boff + n * 2048), *(const PG8_LAS i32x4*)(lds + PG8_SB(b, h) + boff + n * 2048 + 1024)); } while (0)
#define PG8_CAT(x, y) __builtin_shufflevector(x, y, 0, 1, 2, 3, 4, 5, 6, 7)
#define PG8_LO(x) __builtin_bit_cast(bf16x8, __builtin_shufflevector(x, x, 0, 1, 2, 3))
#define PG8_HI(x) __builtin_bit_cast(bf16x8, __builtin_shufflevector(x, x, 4, 5, 6, 7))
#define PG8_MMA(ai, bj, At, Bt) do { __builtin_amdgcn_s_setprio(1); _Pragma("unroll") for (int m = 0; m < 4; ++m) _Pragma("unroll") for (int n = 0; n < 2; ++n) { \
        if constexpr (FP8) asm volatile("v_mfma_f32_16x16x128_f8f6f4 %0, %1, %2, %0" : "+v"(acc[ai][bj][m][n]) : "v"(Bt[n]), "v"(At[m]));   \
        else { acc[ai][bj][m][n] = __builtin_amdgcn_mfma_f32_16x16x32_bf16(PG8_LO(Bt[n]), PG8_LO(At[m]), acc[ai][bj][m][n], 0, 0, 0); \
               acc[ai][bj][m][n] = __builtin_amdgcn_mfma_f32_16x16x32_bf16(PG8_HI(Bt[n]), PG8_HI(At[m]), acc[ai][bj][m][n], 0, 0, 0); } } \
        __builtin_amdgcn_s_setprio(0); } while (0)
#define PG8_WAIT_V(n) asm volatile("s_waitcnt vmcnt(" #n ")" ::: "memory")
#define PG8_WAIT_L(n) asm volatile("s_waitcnt lgkmcnt(" #n ")" ::: "memory")
#define PG8_BAR __builtin_amdgcn_s_barrier()
#define PG8_SCHED __builtin_amdgcn_sched_barrier(0)
    f32x4 acc[2][2][4][2];
#pragma unroll
    for (int a = 0; a < 2; ++a)
#pragma unroll
        for (int b = 0; b < 2; ++b)
#pragma unroll
            for (int m = 0; m < 4; ++m)
#pragma unroll
                for (int n = 0; n < 2; ++n) acc[a][b][m][n] = (f32x4){0.f, 0.f, 0.f, 0.f};
    i32x8 At[4], B0[2], B1[2];
    const char* cA = S.a_base(cur); const char* cB = S.b_base(cur);
    if constexpr (SP2) {
        PG8_STAGE_B(PG8_SB(0, 0), cB); PG8_STAGE_B(PG8_SB(0, 1), cB + hstepB); PG8_STAGE_A(PG8_SA(0, 0), cA, 0); PG8_STAGE_A(PG8_SA(0, 1), cA, 1);
        if (wr == 1) PG8_BAR;
        PG8_WAIT_V(2); PG8_BAR;
        PG8_STAGE_B(PG8_SB(1, 0), cB + kstep); PG8_STAGE_A(PG8_SA(1, 0), cA + kstep, 0); PG8_STAGE_B(PG8_SB(1, 1), cB + hstepB + kstep);
        PG8_WAIT_V(6); PG8_BAR;
    } else {
        PG8_STAGE_B(PG8_SB(0, 0), cB); PG8_STAGE_A(PG8_SA(0, 0), cA, 0); PG8_STAGE_B(PG8_SB(0, 1), cB + hstepB); PG8_STAGE_A(PG8_SA(0, 1), cA, 1);
        if (wr == 1) PG8_BAR;
        PG8_WAIT_V(4); PG8_BAR;
        PG8_STAGE_B(PG8_SB(1, 0), cB + kstep); PG8_STAGE_A(PG8_SA(1, 0), cA + kstep, 0); PG8_STAGE_B(PG8_SB(1, 1), cB + hstepB + kstep);
        PG8_WAIT_V(6); PG8_BAR;
    }
    for (;;) {
        const bool has_next = S.next(ui + 1, nxt);
        const char* nA = has_next ? S.a_base(nxt) : cA; const char* nB = has_next ? S.b_base(nxt) : cB;
#pragma unroll 1
        for (int t = 0; t < nt; t += 2) {
            const bool last = (t == nt - 2);
            const char* a1 = cA + (size_t)(t + 1) * kstep;
            const char* a2 = last ? nA : cA + (size_t)(t + 2) * kstep; const char* b2 = last ? nB : cB + (size_t)(t + 2) * kstep;
            const char* a3 = a2 + kstep; const char* b3 = b2 + kstep;
            if constexpr (SP2) {
            PG8_LDB(B0, 0, 0); PG8_LDB(B1, 0, 1); PG8_SCHED; PG8_LDA(At, 0, 0); PG8_STAGE_A(PG8_SA(1, 1), a1, 1);
            PG8_WAIT_V(8); PG8_WAIT_L(0); PG8_BAR; PG8_MMA(0, 0, At, B0); PG8_MMA(0, 1, At, B1); PG8_BAR; PG8_SCHED;
            PG8_LDA(At, 0, 1); PG8_STAGE_B(PG8_SB(0, 0), b2); PG8_STAGE_B(PG8_SB(0, 1), b2 + hstepB); PG8_STAGE_A(PG8_SA(0, 0), a2, 0);
            PG8_WAIT_V(8); PG8_WAIT_L(0); PG8_BAR; PG8_MMA(1, 0, At, B0); PG8_MMA(1, 1, At, B1); PG8_BAR; PG8_SCHED;
            PG8_LDB(B0, 1, 0); PG8_LDB(B1, 1, 1); PG8_SCHED; PG8_LDA(At, 1, 0); PG8_STAGE_A(PG8_SA(0, 1), a2, 1);
            PG8_WAIT_V(8); PG8_WAIT_L(0); PG8_BAR; PG8_MMA(0, 0, At, B0); PG8_MMA(0, 1, At, B1); PG8_BAR; PG8_SCHED;
            PG8_LDA(At, 1, 1); PG8_STAGE_B(PG8_SB(1, 0), b3); PG8_STAGE_B(PG8_SB(1, 1), b3 + hstepB); PG8_STAGE_A(PG8_SA(1, 0), a3, 0);
            PG8_WAIT_V(8); PG8_WAIT_L(0); PG8_BAR; PG8_MMA(1, 0, At, B0); PG8_MMA(1, 1, At, B1); PG8_BAR; PG8_SCHED;
            } else {
            PG8_LDB(B0, 0, 0); PG8_SCHED; PG8_LDA(At, 0, 0); PG8_STAGE_A(PG8_SA(1, 1), a1, 1);
            PG8_WAIT_L(8); PG8_BAR; PG8_WAIT_L(0); PG8_MMA(0, 0, At, B0); PG8_BAR; PG8_SCHED;
            PG8_LDB(B1, 0, 1); PG8_STAGE_B(PG8_SB(0, 0), b2);
            PG8_BAR; PG8_WAIT_L(0); PG8_MMA(0, 1, At, B1); PG8_BAR;
            PG8_LDA(At, 0, 1); PG8_STAGE_A(PG8_SA(0, 0), a2, 0);
            PG8_BAR; PG8_WAIT_L(0); PG8_MMA(1, 0, At, B0); PG8_BAR; PG8_SCHED;
            PG8_STAGE_B(PG8_SB(0, 1), b2 + hstepB);
            PG8_WAIT_V(6); PG8_BAR; PG8_MMA(1, 1, At, B1); PG8_BAR;
            PG8_LDB(B0, 1, 0); PG8_SCHED; PG8_LDA(At, 1, 0); PG8_STAGE_A(PG8_SA(0, 1), a2, 1);
            PG8_WAIT_L(8); PG8_BAR; PG8_WAIT_L(0); PG8_MMA(0, 0, At, B0); PG8_BAR; PG8_SCHED;
            PG8_LDB(B1, 1, 1); PG8_STAGE_B(PG8_SB(1, 0), b3);
            PG8_BAR; PG8_WAIT_L(0); PG8_MMA(0, 1, At, B1); PG8_BAR;
            PG8_LDA(At, 1, 1); PG8_STAGE_A(PG8_SA(1, 0), a3, 0);
            PG8_BAR; PG8_WAIT_L(0); PG8_MMA(1, 0, At, B0); PG8_BAR; PG8_SCHED;
            PG8_STAGE_B(PG8_SB(1, 1), b3 + hstepB);
            PG8_WAIT_V(6); PG8_BAR; PG8_MMA(1, 1, At, B1); PG8_BAR;
            }
        }
        if constexpr (ALIGN_EPI) { if (wr == 0) PG8_BAR; }
        if constexpr (FP8) asm volatile("s_nop 15\n\ts_nop 7" ::: "memory");
        E(acc, cur, wr, wc, fr, fq);
        if (!has_next) break;
#pragma unroll
        for (int a = 0; a < 2; ++a)
#pragma unroll
            for (int b = 0; b < 2; ++b)
#pragma unroll
                for (int m = 0; m < 4; ++m)
#pragma unroll
                    for (int n = 0; n < 2; ++n) acc[a][b][m][n] = (f32x4){0.f, 0.f, 0.f, 0.f};
        cur = nxt; cA = nA; cB = nB; ++ui;
        if constexpr (ALIGN_EPI) { if (wr == 1) PG8_BAR; }
    }
    PG8_WAIT_V(0);
    if constexpr (!ALIGN_EPI) { if (wr == 0) PG8_BAR; }
    PG8_BAR;
#undef PG8_SA
#undef PG8_SB
#undef PG8_STAGE_A
#undef PG8_STAGE_B
#undef PG8_LDA
#undef PG8_LDB
#undef PG8_MMA
#undef PG8_CAT
#undef PG8_LO
#undef PG8_HI
#undef PG8_WAIT_V
#undef PG8_WAIT_L
#undef PG8_BAR
#undef PG8_SCHED
}
struct SchedDense {
    const char* A; const char* Bt; int lda, ldb; int nM, nN, nwg, G, c;
    __device__ __forceinline__ void init(const void* A_, int lda_, const void* Bt_, int ldb_, int M, int N, int G_, int c_) { A = (const char*)A_; Bt = (const char*)Bt_; lda = lda_ * 2; ldb = ldb_ * 2; nM = M / BM; nN = N / BM; nwg = nM * nN; G = G_; c = c_; }
    __device__ __forceinline__ bool next(int i, Unit& u) const {
        const long L = (long)i * G + c; if (L >= nwg) return false;
        int wgid = (int)L; { const int q = nwg / 8, r = nwg % 8, xcd = wgid % 8, off = wgid / 8; wgid = (xcd < r ? xcd * (q + 1) : r * (q + 1) + (xcd - r) * q) + off; }
        const int nig = 8 * nN, gid = wgid / nig, fm = gid * 8, gsz = (nM - fm) < 8 ? (nM - fm) : 8;
        u.pm = fm + ((wgid % nig) % gsz); u.pn = (wgid % nig) / gsz; u.kind = 0; return true;
    }
    __device__ __forceinline__ const char* a_base(const Unit& u) const { return A + (size_t)u.pm * BM * lda; }
    __device__ __forceinline__ const char* b_base(const Unit& u) const { return Bt + (size_t)u.pn * BM * ldb; }
    __device__ __forceinline__ unsigned a_rowoff(const Unit&, int r) const { return (unsigned)(r * lda); }
};
struct SchedQKV {
    const char* proj; const char* wuq; const char* wukv; int lda, ldb; int G, vcu;
    __device__ __forceinline__ bool next(int i, Unit& u) const {
        const int L = i * G + vcu; if (L >= (T / BM) * 7) return false;
        u.pm = L / 7; const int j = L % 7; u.kind = j < 3 ? 0 : 1; u.pn = j < 3 ? j : j - 3; return true; }
    __device__ __forceinline__ const char* a_base(const Unit& u) const { return proj + ((size_t)u.pm * BM * NPROJ + (u.kind == 1 ? 256 : 0)) * 2; }
    __device__ __forceinline__ const char* b_base(const Unit& u) const { return (u.kind == 1 ? wukv : wuq) + (size_t)u.pn * BM * 256 * 2; }
    __device__ __forceinline__ unsigned a_rowoff(const Unit&, int r) const { return (unsigned)(r * lda); }
};
__device__ __forceinline__ int be_of_vcu(int vcu) { const int x = vcu >> 5, j = vcu & 31; return (j & 15) * 16 + 2 * x + (j >> 4); }
struct SchedUp {
    const char* u2; const int* idx; const char* wgu; int lda, ldb; int G, vcu;
    __device__ __forceinline__ bool next(int i, Unit& u) const { if (i >= 16 || vcu >= 256) return false; u.pm = be_of_vcu(vcu); u.pn = i; u.kind = 0; return true; }
    __device__ __forceinline__ const char* a_base(const Unit& u) const { return u2 + (size_t)(u.pm >> 4) * SEQ * DM; }
    __device__ __forceinline__ const char* b_base(const Unit& u) const { return wgu + ((size_t)(u.pm & 15) * 4096 + (size_t)u.pn * BM) * DM; }
    __device__ __forceinline__ unsigned a_rowoff(const Unit& u, int r) const { return (unsigned)idx[u.pm * CAP + r] * (unsigned)DM; }
};
struct SchedDown {
    const char* h; const char* wd; int lda, ldb; int G, vcu;
    __device__ __forceinline__ bool next(int i, Unit& u) const { if (i >= 4 || vcu >= 256) return false; u.pm = be_of_vcu(vcu); u.pn = i; u.kind = 0; return true; }
    __device__ __forceinline__ const char* a_base(const Unit& u) const { return h + (size_t)u.pm * BM * FF; }
    __device__ __forceinline__ const char* b_base(const Unit& u) const { return wd + ((size_t)(u.pm & 15) * DM + (size_t)u.pn * BM) * FF; }
    __device__ __forceinline__ unsigned a_rowoff(const Unit&, int r) const { return (unsigned)(r * lda); }
};
}


namespace att {
using f32x16 = __attribute__((ext_vector_type(16))) float;
using s16x4  = __attribute__((ext_vector_type(4))) short;
constexpr int SHM_V = 16384, SHM_K = 16384;
constexpr int L_V = 0, L_K = 2 * SHM_V, L_WS = L_K + 2 * SHM_K, L_KPOS = L_WS + 8 * 64 * 4, L_TAB = L_KPOS + SEQ * 4, L_Q = L_TAB + 272 * 4, L_END = L_Q + 8 * 4096;
#ifndef ATT_SDEPTH
#define ATT_SDEPTH 2
#endif
constexpr float THR2 = 11.5f;
#define ATT_KSWZ(row, colB) ((row) * 256 + ((colB) ^ (((row) & 7) << 4)))
#define ATT_SBAR() __builtin_amdgcn_sched_barrier(0)
__device__ __forceinline__ int crow(int r, int hi) { return (r & 3) + 8 * (r >> 2) + 4 * hi; }
__device__ __forceinline__ unsigned cvtpk(float lo, float hi) { unsigned r; asm volatile("v_cvt_pk_bf16_f32 %0, %1, %2" : "=v"(r) : "v"(lo), "v"(hi)); return r; }
__device__ __forceinline__ int v_st(int k, int c) { const int kk = (k & ~0xC) | ((k & 4) << 1) | ((k & 8) >> 1); return ((kk >> 3) * 4 + (c >> 5)) * 512 + ((kk & 7) * 32 + (c & 31)) * 2; }
__device__ __forceinline__ int v_rd_base(int lane) { return ((lane & 3) << 3) | (((lane >> 2) & 3) << 6) | (((lane >> 4) & 1) << 5) | (((lane >> 5) & 1) << 8); }
constexpr int v_rd_off(int d0, int ks, int half) { return d0 * 512 + ks * 4096 + half * 2048; }
template <int OFF> __device__ __forceinline__ s16x4 tr_read(int vb) { s16x4 r; asm volatile("ds_read_b64_tr_b16 %0, %1 offset:%2" : "=&v"(r) : "v"(vb), "i"(OFF) : "memory"); return r; }
template <int D0> __device__ __forceinline__ void pv_one(f32x16& od, int vb, bf16x8 pa0, bf16x8 pa1, bf16x8 pa2, bf16x8 pa3) {
    const s16x4 l0 = tr_read<v_rd_off(D0, 0, 0)>(vb), h0 = tr_read<v_rd_off(D0, 0, 1)>(vb), l1 = tr_read<v_rd_off(D0, 1, 0)>(vb), h1 = tr_read<v_rd_off(D0, 1, 1)>(vb);
    const s16x4 l2 = tr_read<v_rd_off(D0, 2, 0)>(vb), h2 = tr_read<v_rd_off(D0, 2, 1)>(vb), l3 = tr_read<v_rd_off(D0, 3, 0)>(vb), h3 = tr_read<v_rd_off(D0, 3, 1)>(vb);
    asm volatile("s_waitcnt lgkmcnt(0)" ::: "memory"); ATT_SBAR();
#define ATT_PK(L, H) (bf16x8){L[0], L[1], L[2], L[3], H[0], H[1], H[2], H[3]}
    od = __builtin_amdgcn_mfma_f32_32x32x16_bf16(pa0, ATT_PK(l0, h0), od, 0, 0, 0);
    od = __builtin_amdgcn_mfma_f32_32x32x16_bf16(pa1, ATT_PK(l1, h1), od, 0, 0, 0);
    od = __builtin_amdgcn_mfma_f32_32x32x16_bf16(pa2, ATT_PK(l2, h2), od, 0, 0, 0);
    od = __builtin_amdgcn_mfma_f32_32x32x16_bf16(pa3, ATT_PK(l3, h3), od, 0, 0, 0);
#undef ATT_PK
}
template <int NDV> __device__ __forceinline__ void pv_all(f32x16 (&o)[NDV], int vb, bf16x8 pa0, bf16x8 pa1, bf16x8 pa2, bf16x8 pa3) {
    pv_one<0>(o[0], vb, pa0, pa1, pa2, pa3); pv_one<1>(o[1], vb, pa0, pa1, pa2, pa3);
    if constexpr (NDV == 4) { pv_one<2>(o[2], vb, pa0, pa1, pa2, pa3); pv_one<3>(o[3], vb, pa0, pa1, pa2, pa3); }
}
template <int NDQ, bool QLDS> __device__ __forceinline__ void qkt(f32x16& p0, f32x16& p1, const LAS char* Kl, const bf16x8 (&qr)[NDQ], const LAS char* ql, int r32, int hi, float cinit) {
#pragma unroll
    for (int r = 0; r < 16; ++r) { p0[r] = cinit; p1[r] = cinit; }
#pragma unroll
    for (int d0 = 0; d0 < NDQ; ++d0) { const int cb = (d0 * 16 + hi * 8) * 2;
        const bf16x8 b0 = *(const LAS bf16x8*)(Kl + ATT_KSWZ(r32, cb)), b1 = *(const LAS bf16x8*)(Kl + ATT_KSWZ(32 + r32, cb));
        bf16x8 q; if constexpr (QLDS) q = *(const LAS bf16x8*)(ql + d0 * 1024); else q = qr[d0];
        p0 = __builtin_amdgcn_mfma_f32_32x32x16_bf16(b0, q, p0, 0, 0, 0);
        p1 = __builtin_amdgcn_mfma_f32_32x32x16_bf16(b1, q, p1, 0, 0, 0); }
}
template <bool BAND> __device__ __forceinline__ void partialSM(f32x16& p0, f32x16& p1, float& m_reg, float& alpha, const LAS int* kposl, const LAS float* tabl, int qpos, int hi) {
    if constexpr (BAND) {
#pragma unroll
        for (int r = 0; r < 16; ++r) { const int kc = crow(r, hi); int r0 = kposl[kc] - qpos, r1 = kposl[32 + kc] - qpos;
            r0 = r0 < -128 ? -128 : (r0 > 128 ? 128 : r0); r1 = r1 < -128 ? -128 : (r1 > 128 ? 128 : r1);
            p0[r] += tabl[r0 + 128]; p1[r] += tabl[r1 + 128];
            if ((r & 3) == 3) asm volatile("" ::: "memory"); }
    }
    float pmax = p0[0];
#pragma unroll
    for (int r = 1; r < 16; ++r) pmax = fmaxf(pmax, p0[r]);
#pragma unroll
    for (int r = 0; r < 16; ++r) pmax = fmaxf(pmax, p1[r]);
    { auto rr = __builtin_amdgcn_permlane32_swap(__float_as_uint(pmax), __float_as_uint(pmax), false, false); pmax = fmaxf(__uint_as_float(rr[0]), __uint_as_float(rr[1])); }
    float mn;
    if (__builtin_expect(__all(pmax - m_reg <= THR2), 1)) { mn = m_reg; alpha = 1.f; }
    else { mn = fmaxf(m_reg, pmax); alpha = __builtin_amdgcn_exp2f(m_reg - mn); m_reg = mn; }
#pragma unroll
    for (int r = 0; r < 16; ++r) { p0[r] -= mn; p1[r] -= mn; }
#pragma unroll
    for (int r = 0; r < 16; ++r) p0[r] = __builtin_amdgcn_exp2f(p0[r]);
}
__device__ __forceinline__ void finishSM(f32x16& p0, f32x16& p1, float alpha, float& l_reg, bf16x8& pa0, bf16x8& pa1, bf16x8& pa2, bf16x8& pa3) {
#pragma unroll
    for (int r = 0; r < 16; ++r) p1[r] = __builtin_amdgcn_exp2f(p1[r]);
    float ps = 0;
#pragma unroll
    for (int r = 0; r < 16; ++r) ps += p0[r];
#pragma unroll
    for (int r = 0; r < 16; ++r) ps += p1[r];
    { auto rr = __builtin_amdgcn_permlane32_swap(__float_as_uint(ps), __float_as_uint(ps), false, false); ps = __uint_as_float(rr[0]) + __uint_as_float(rr[1]); }
    l_reg = l_reg * alpha + ps;
#define ATT_PK4(P, BASE, OUT) do { unsigned a0 = cvtpk(P[BASE + 0], P[BASE + 1]), a1 = cvtpk(P[BASE + 2], P[BASE + 3]);   \
    unsigned b0 = cvtpk(P[BASE + 4], P[BASE + 5]), b1 = cvtpk(P[BASE + 6], P[BASE + 7]);                              \
    auto r0 = __builtin_amdgcn_permlane32_swap(a0, b0, false, false); auto r1 = __builtin_amdgcn_permlane32_swap(a1, b1, false, false); \
    u32x4 w = {r0[0], r1[0], r0[1], r1[1]}; OUT = __builtin_bit_cast(bf16x8, w); } while (0)
    ATT_PK4(p0, 0, pa0); ATT_PK4(p0, 8, pa1); ATT_PK4(p1, 0, pa2); ATT_PK4(p1, 8, pa3);
#undef ATT_PK4
}
struct Src { const bf16* kp; int kpitch; const bf16* vp; int vpitch; const int* pos; };

template <int NDQ, int NDV, bool DIFF, bool QLDS>
__device__ __forceinline__ void attn_pass(LAS char* lds, const bf16x8 (&qr)[NDQ], const Src& S, f32x16 (&o)[NDV], float& l_out,
                                          int qpos, int qmn, int qmx, const int* pmm, float cL, float cR) {
    const int tid = threadIdx.x, wid = __builtin_amdgcn_readfirstlane(tid >> 6), lane = tid & 63, r32 = lane & 31, hi = lane >> 5;
    LAS char* V_lds = lds + L_V; LAS char* K_lds = lds + L_K;
    LAS float* al_l = (LAS float*)(lds + L_WS) + wid * 64 + 32;
    LAS int* kposl = (LAS int*)(lds + L_KPOS); const LAS float* tabl = (const LAS float*)(lds + L_TAB);
    const LAS char* ql = lds + L_Q + wid * 4096 + lane * 16;
    float m_reg = -1e30f, l_reg = 0.f;
#pragma unroll
    for (int d = 0; d < NDV; ++d)
#pragma unroll
        for (int r = 0; r < 16; ++r) o[d][r] = 0.f;
    const int sr = tid >> 4, sc = (tid & 15) * 8, vst0 = v_st(sr, sc), vst1 = v_st(32 + sr, sc);
    const int vb0 = (int)(unsigned)(size_t)V_lds + v_rd_base(lane);
    constexpr int SD = ATT_SDEPTH;
    struct { bf16x8 vs0, vs1, ks0, ks1; } sr_[SD];
#define ATT_SLOAD(i, k0) do { sr_[i].vs0 = *(const bf16x8*)(S.vp + (size_t)((k0) + sr) * S.vpitch); sr_[i].vs1 = *(const bf16x8*)(S.vp + (size_t)((k0) + 32 + sr) * S.vpitch); \
    sr_[i].ks0 = *(const bf16x8*)(S.kp + (size_t)((k0) + sr) * S.kpitch); sr_[i].ks1 = *(const bf16x8*)(S.kp + (size_t)((k0) + 32 + sr) * S.kpitch); } while (0)
#define ATT_SWRITE(b, i) do { *(LAS bf16x8*)(V_lds + (b) * SHM_V + vst0) = sr_[i].vs0; *(LAS bf16x8*)(V_lds + (b) * SHM_V + vst1) = sr_[i].vs1; const int kc_ = sc * 2; \
    *(LAS bf16x8*)(K_lds + (b) * SHM_K + ATT_KSWZ(sr, kc_)) = sr_[i].ks0; *(LAS bf16x8*)(K_lds + (b) * SHM_K + ATT_KSWZ(32 + sr, kc_)) = sr_[i].ks1; } while (0)
#define ATT_SWAIT() do { if constexpr (SD == 2) asm volatile("s_waitcnt vmcnt(4)" ::: "memory"); else asm volatile("s_waitcnt vmcnt(0)" ::: "memory"); } while (0)
#define ATT_RESC(a) do { if (__any((a) < 1.f)) { if (hi == 0) al_l[r32] = (a); asm volatile("s_waitcnt lgkmcnt(0)" ::: "memory"); \
    _Pragma("unroll") for (int d = 0; d < NDV; ++d) _Pragma("unroll") for (int r = 0; r < 16; ++r) o[d][r] *= al_l[crow(r, hi)]; } } while (0)
#define ATT_CLASS(j, cinit, band) do { cinit = 0.f; band = false; if constexpr (DIFF) { const int kmn_ = __hip_atomic_load(pmm + 2 * (j), RLX_AGENT), kmx_ = __hip_atomic_load(pmm + 2 * (j) + 1, RLX_AGENT); \
    if (kmn_ - qmx >= 128) cinit = cR; else if (qmn - kmx_ >= 128) cinit = cL; else band = true; } } while (0)
#define ATT_PSM(P0, P1, AL, band, tile) do { if (DIFF && (band)) partialSM<true>(P0, P1, m_reg, AL, kposl + (tile) * 64, tabl, qpos, hi); else partialSM<false>(P0, P1, m_reg, AL, kposl, tabl, qpos, hi); } while (0)
    f32x16 pA0, pA1, pB0, pB1; float alA, alB, ci; bool band; bf16x8 pa0, pa1, pa2, pa3; constexpr int NT = SEQ / 64;
    constexpr int SE = 0, SO = SD - 1;
    ATT_SLOAD(SE, 0); asm volatile("s_waitcnt vmcnt(0)" ::: "memory"); ATT_SWRITE(0, SE); __syncthreads();
    ATT_CLASS(0, ci, band); qkt<NDQ, QLDS>(pA0, pA1, K_lds, qr, ql, r32, hi, ci); ATT_PSM(pA0, pA1, alA, band, 0);
    ATT_SLOAD(SO, 64); if constexpr (SD == 2) ATT_SLOAD(SE, 128);
    ATT_SWAIT(); ATT_SWRITE(1, SO); __syncthreads();
    for (int j = 1; j + 1 < NT; j += 2) {
        ATT_SBAR(); ATT_CLASS(j, ci, band); qkt<NDQ, QLDS>(pB0, pB1, K_lds + SHM_K, qr, ql, r32, hi, ci);
        finishSM(pA0, pA1, alA, l_reg, pa0, pa1, pa2, pa3); ATT_SBAR();
        ATT_SLOAD(SO, (j + SD) * 64); ATT_SBAR();
        pv_all<NDV>(o, vb0, pa0, pa1, pa2, pa3); ATT_PSM(pB0, pB1, alB, band, j);
        __syncthreads(); ATT_SWAIT(); ATT_SWRITE(0, SE);
        ATT_RESC(alB); __syncthreads();
        ATT_SBAR(); ATT_CLASS(j + 1, ci, band); qkt<NDQ, QLDS>(pA0, pA1, K_lds, qr, ql, r32, hi, ci);
        finishSM(pB0, pB1, alB, l_reg, pa0, pa1, pa2, pa3); ATT_SBAR();
        if (SD == 1 || j + 3 < NT) ATT_SLOAD(SE, (j + 1 + SD) * 64); ATT_SBAR();
        pv_all<NDV>(o, vb0 + SHM_V, pa0, pa1, pa2, pa3); ATT_PSM(pA0, pA1, alA, band, j + 1);
        __syncthreads(); ATT_SWAIT(); ATT_SWRITE(1, SO);
        ATT_RESC(alA); __syncthreads();
    }
    ATT_SBAR(); ATT_CLASS(NT - 1, ci, band); qkt<NDQ, QLDS>(pB0, pB1, K_lds + SHM_K, qr, ql, r32, hi, ci);
    finishSM(pA0, pA1, alA, l_reg, pa0, pa1, pa2, pa3); ATT_SBAR();
    pv_all<NDV>(o, vb0, pa0, pa1, pa2, pa3); ATT_PSM(pB0, pB1, alB, band, NT - 1);
    __syncthreads(); ATT_RESC(alB);
    finishSM(pB0, pB1, alB, l_reg, pa0, pa1, pa2, pa3); ATT_SBAR();
    pv_all<NDV>(o, vb0 + SHM_V, pa0, pa1, pa2, pa3);
    l_out = l_reg;
    __syncthreads();
#undef ATT_SLOAD
#undef ATT_SWRITE
#undef ATT_SWAIT
#undef ATT_RESC
#undef ATT_CLASS
#undef ATT_PSM
}
__device__ __forceinline__ void row_recip(LAS float* li_l, float l_reg, int r32, int hi, float (&rli)[16]) {
    if (hi == 0) li_l[r32] = l_reg; asm volatile("s_waitcnt lgkmcnt(0)" ::: "memory");
#pragma unroll
    for (int r = 0; r < 16; ++r) rli[r] = __builtin_amdgcn_rcpf(li_l[crow(r, hi)]);
    asm volatile("s_waitcnt lgkmcnt(0)" ::: "memory");
}
__device__ __forceinline__ void mla_unit(const Ctx& C, int b, int h, int qb) {
    LAS char* lds = (LAS char*)C.lds;
    const int tid = threadIdx.x, wid = __builtin_amdgcn_readfirstlane(tid >> 6), lane = tid & 63, r32 = lane & 31, hi = lane >> 5;
    const int t0 = b * SEQ + qb * 256 + wid * 32;
    bf16x8 qr[6];
    const bf16* qrow = C.Q + (size_t)(t0 + r32) * 768;
#pragma unroll
    for (int d0 = 0; d0 < 4; ++d0) qr[d0] = *(const bf16x8*)(qrow + h * 64 + d0 * 16 + hi * 8);
#pragma unroll
    for (int d0 = 4; d0 < 6; ++d0) { const int fqi = 2 * (d0 - 4) + hi; const u32x4 w = *(const u32x4*)(qrow + 512 + h * 32 + (d0 - 4) * 16 + hi * 8);
        const f32x4 c4 = *(const f32x4*)(C.CS + (size_t)(t0 + r32) * 16 + 4 * fqi), s4 = *(const f32x4*)(C.SN + (size_t)(t0 + r32) * 16 + 4 * fqi);
        const float t1[4] = {bflo(w.x), bfhi(w.x), bflo(w.y), bfhi(w.y)}, t2[4] = {bflo(w.z), bfhi(w.z), bflo(w.w), bfhi(w.w)};
        float a[4], bb[4];
#pragma unroll
        for (int i = 0; i < 4; ++i) { a[i] = t1[i] * c4[i] - t2[i] * s4[i]; bb[i] = t1[i] * s4[i] + t2[i] * c4[i]; }
        u32x4 ww; ww.x = pk2(a[0], a[1]); ww.y = pk2(a[2], a[3]); ww.z = pk2(bb[0], bb[1]); ww.w = pk2(bb[2], bb[3]); qr[d0] = __builtin_bit_cast(bf16x8, ww); }
    const int sc = (tid & 15) * 8;
    Src S; S.kp = sc < 64 ? C.KV + (size_t)b * SEQ * 1024 + h * 64 + sc : C.KR + (size_t)b * SEQ * 32 + ((sc - 64) & 31); S.kpitch = sc < 64 ? 1024 : 32;
    S.vp = C.KV + (size_t)b * SEQ * 1024 + 512 + h * 64 + (sc & 63); S.vpitch = 1024; S.pos = C.pos + b * SEQ;
    f32x16 o[2]; float l;
    attn_pass<6, 2, false, false>(lds, qr, S, o, l, 0, 0, 0, nullptr, 0.f, 0.f);
    float rli[16]; row_recip((LAS float*)(lds + L_WS) + wid * 64, l, r32, hi, rli);
    bf16* ao = C.AO + (size_t)t0 * DM + h * 64; const int loff = hi * 4 * DM + r32;
#pragma unroll
    for (int r = 0; r < 16; ++r) {
#pragma unroll
        for (int d0 = 0; d0 < 2; ++d0) ao[crow(r, 0) * DM + d0 * 32 + loff] = (bf16)f2bf(o[d0][r] * rli[r]); }
}
__device__ __forceinline__ void diff_unit(const Ctx& C, int b, int h, int qb) {
    LAS char* lds = (LAS char*)C.lds;
    int tid = threadIdx.x; asm volatile("" : "+v"(tid));
    const int wid = __builtin_amdgcn_readfirstlane(tid >> 6);
    const int t0 = b * SEQ + qb * 256 + wid * 32;
    LAS float* tabl = (LAS float*)(lds + L_TAB);
    if (tid < 257) tabl[tid] = __hip_atomic_load(C.MISC + 64 + h * 260 + tid, RLX_AGENT);
    { LAS int* kposl = (LAS int*)(lds + L_KPOS);
#pragma unroll
      for (int i = 0; i < SEQ / NTHREADS; ++i) kposl[tid + i * NTHREADS] = C.pos[b * SEQ + tid + i * NTHREADS]; }
    const float cL = __hip_atomic_load(C.MISC + 64 + h * 260 + 0, RLX_AGENT), cR = __hip_atomic_load(C.MISC + 64 + h * 260 + 256, RLX_AGENT);
    const float lam = __hip_atomic_load(C.MISC, RLX_AGENT);
    const int qpos = C.pos[t0 + (tid & 31)]; int qmn = qpos, qmx = qpos;
#pragma unroll
    for (int o_ = 1; o_ < 64; o_ <<= 1) { const int a = __shfl_xor(qmn, o_), c = __shfl_xor(qmx, o_); qmn = a < qmn ? a : qmn; qmx = c > qmx ? c : qmx; }
    qmn = __builtin_amdgcn_readfirstlane(qmn); qmx = __builtin_amdgcn_readfirstlane(qmx);
    __syncthreads();
    float* scr = C.out + (size_t)t0 * DM + h * 128;
    const int* pmm = C.PMM + b * 64;
#pragma unroll
    for (int m = 0; m < 2; ++m) {
        f32x16 o[4]; float l;
        {
            int tl = threadIdx.x; asm volatile("" : "+v"(tl));
            const int lane = tl & 63, r32 = lane & 31, hi = lane >> 5, sc = (tl & 15) * 8;
            bf16x8 qr[4];
            const bf16* qrow = C.PROJ + (size_t)(t0 + r32) * NPROJ + 512 + (h * 2 + m) * 64;
#pragma unroll
            for (int d0 = 0; d0 < 4; ++d0) { qr[d0] = *(const bf16x8*)(qrow + d0 * 16 + hi * 8); *(LAS bf16x8*)(lds + L_Q + wid * 4096 + lane * 16 + d0 * 1024) = qr[d0]; }
            Src S; S.kp = C.PROJ + (size_t)b * SEQ * NPROJ + 1024 + (h * 2 + m) * 64 + (sc & 63); S.kpitch = NPROJ;
            S.vp = C.PROJ + (size_t)b * SEQ * NPROJ + 1536 + h * 128 + sc; S.vpitch = NPROJ; S.pos = C.pos + b * SEQ;
            attn_pass<4, 4, true, true>(lds, qr, S, o, l, qpos, qmn, qmx, pmm, cL, cR);
        }
        int te = threadIdx.x; asm volatile("" : "+v"(te));
        const int r32 = te & 31, hi = (te >> 5) & 1, loff = hi * 4 * DM + r32;
        float rli[16]; row_recip((LAS float*)(lds + L_WS) + wid * 64, l, r32, hi, rli);
        if (m == 0) {
#pragma unroll
            for (int r = 0; r < 16; ++r) {
#pragma unroll
                for (int d0 = 0; d0 < 4; ++d0) scr[crow(r, 0) * DM + d0 * 32 + loff] = o[d0][r] * rli[r]; }
        } else {
#pragma unroll
            for (int r = 0; r < 16; ++r) { float s = 0.f;
#pragma unroll
                for (int d0 = 0; d0 < 4; ++d0) { const float a = scr[crow(r, 0) * DM + d0 * 32 + loff] - lam * (o[d0][r] * rli[r]); o[d0][r] = a; s += a * a; }
                s += __shfl_xor(s, 1); s += __shfl_xor(s, 2); s += __shfl_xor(s, 4); s += __shfl_xor(s, 8); s += __shfl_xor(s, 16);
                const float f = (1.0f - LAMBDA_INIT) / sqrtf(s * (1.f / 128.f) + RMS_EPS);
#pragma unroll
                for (int d0 = 0; d0 < 4; ++d0) o[d0][r] *= f;
                asm volatile("" : "+v"(o[0][r]), "+v"(o[1][r]), "+v"(o[2][r]), "+v"(o[3][r]));
                if (r & 1) asm volatile("" ::: "memory"); }
            bf16* ao = C.AO + (size_t)t0 * DM + 512 + h * 128;
#pragma unroll
            for (int d0 = 0; d0 < 4; ++d0) { const float g = C.subln[d0 * 32 + r32];
#pragma unroll
                for (int r = 0; r < 16; ++r) ao[crow(r, 0) * DM + d0 * 32 + loff] = (bf16)f2bf(o[d0][r] * g); }
        }
    }
}
__device__ __forceinline__ void attn_phase(const Ctx& C) {
#ifndef ATT_SKIP_DIFF
#pragma unroll 1
    for (int U = C.vcu; U < BATCH * 4 * 8; U += C.G) diff_unit(C, U >> 5, (U >> 3) & 3, U & 7);
#endif
#ifndef ATT_SKIP_MLA
#pragma unroll 1
    for (int U = C.vcu; U < BATCH * 8 * 8; U += C.G) mla_unit(C, U >> 6, (U >> 3) & 7, U & 7);
#endif
}
}

struct ARowLd { const bf16* A; int lda; __device__ __forceinline__ const bf16* operator()(int m) const { return A + (size_t)m * lda; } };
struct ARowGather { const bf16* A; const int* idx; __device__ __forceinline__ const bf16* operator()(int m) const { const int be = m >> 8; return A + ((size_t)(be >> 4) * SEQ + idx[m]) * DM; } };
struct BRowLd { const bf16* B; int ldb; __device__ __forceinline__ const bf16* operator()(int n, int) const { return B + (size_t)n * ldb; } };
struct BRowExp { const bf16* B; int rows_per_e, ldb, e; __device__ __forceinline__ const bf16* operator()(int n, int) const { return B + ((size_t)e * rows_per_e + n) * ldb; } };
struct BRowGU { const bf16* B; int e; __device__ __forceinline__ const bf16* operator()(int n, int up) const { return B + ((size_t)e * 4096 + (n >> 7) * 256 + (n & 127) + up * 128) * DM; } };

__global__ void __launch_bounds__(NTHREADS) nk_proj(Args a) {
    __shared__ __attribute__((aligned(16))) float lds[48 * 132]; Ctx C; ctx_init(C, a);
    for (int u = blockIdx.x; u < (T / 128) * (NPROJ / 128); u += gridDim.x) { const int pm = u / (NPROJ / 128), pn = u % (NPROJ / 128);
        naive_gemm_tile<false>(pm * 128, pn * 128, DM, ARowLd{C.U, DM}, BRowLd{C.WIN, DM}, FPlain{C.PROJ, NPROJ}, 0, lds); __syncthreads(); }
}
__global__ void __launch_bounds__(NTHREADS) nk_qkv(Args a) {
    __shared__ __attribute__((aligned(16))) float lds[48 * 132]; Ctx C; ctx_init(C, a);
    const FRowScale f0{C.Q, 768, C.RINVQ}, f1{C.KV, 1024, C.RINVKV};
    for (int u = blockIdx.x; u < (T / 128) * 14; u += gridDim.x) { const int pm = u / 14, j = u % 14;
        if (j < 6) naive_gemm_tile<false>(pm * 128, j * 128, 256, ARowLd{C.PROJ, NPROJ}, BRowLd{C.WUQ, 256}, f0, 0, lds);
        else naive_gemm_tile<false>(pm * 128, (j - 6) * 128, 256, ARowLd{C.PROJ + 256, NPROJ}, BRowLd{C.WUKV, 256}, f1, 1, lds);
        __syncthreads(); }
}
__global__ void __launch_bounds__(NTHREADS) nk_out(Args a) {
    __shared__ __attribute__((aligned(16))) float lds[48 * 132]; Ctx C; ctx_init(C, a);
    for (int u = blockIdx.x; u < (T / 128) * 8; u += gridDim.x) { const int pm = u / 8, pn = u % 8;
        naive_gemm_tile<false>(pm * 128, pn * 128, DM, ARowLd{C.AO, DM}, BRowLd{C.WOUT, DM}, FY{C.Y, C.x, C.MOD}, 0, lds); __syncthreads(); }
}
template <int DQK, int DV, bool DIFF>
__device__ __forceinline__ void naive_attn_block(const Ctx& C, int b, int h, int m, int qb, float* lds) {
    float* Ks = lds; float* Vs = lds + 32 * DQK;
    const int tid = threadIdx.x, t = b * SEQ + qb * 256 + tid;
    float q[DQK], o[DV];
#pragma unroll
    for (int d = 0; d < DV; ++d) o[d] = 0.f;
    if (DIFF) {
#pragma unroll
        for (int d = 0; d < DQK; ++d) q[d] = bf2f(C.PROJ[(size_t)t * NPROJ + 512 + (h * 2 + m) * 64 + d]);
    } else {
#pragma unroll
        for (int d = 0; d < 64; ++d) q[d] = bf2f(C.Q[(size_t)t * 768 + h * 64 + d]);
#pragma unroll
        for (int d = 0; d < 32; ++d) { const int fq = d >> 3, n = (d >> 2) & 1, i = d & 3; const float cs = C.CS[(size_t)t * 16 + 4 * fq + i], sn = C.SN[(size_t)t * 16 + 4 * fq + i];
            const float t1 = bf2f(C.Q[(size_t)t * 768 + 512 + h * 32 + (d & ~4)]), t2 = bf2f(C.Q[(size_t)t * 768 + 512 + h * 32 + (d | 4)]);
            q[64 + d] = bf2f((bf16)f2bf(n == 0 ? t1 * cs - t2 * sn : t1 * sn + t2 * cs)); }
    }
    const int qpos = C.pos[t]; const float* btab = C.MISC + 64 + h * 260 + 128;
    float mx = -1e30f, l = 0.f;
    for (int k0 = 0; k0 < SEQ; k0 += 32) {
        __syncthreads();
        for (int i = tid; i < 32 * DQK; i += 256) { const int kk = i / DQK, d = i % DQK; const size_t kt = (size_t)(b * SEQ + k0 + kk); float v;
            if (DIFF) v = bf2f(C.PROJ[kt * NPROJ + 1024 + (h * 2 + m) * 64 + d]);
            else v = d < 64 ? bf2f(C.KV[kt * 1024 + h * 64 + d]) : bf2f(C.KR[kt * 32 + (d - 64)]);
            Ks[i] = v; }
        for (int i = tid; i < 32 * DV; i += 256) { const int kk = i / DV, d = i % DV; const size_t kt = (size_t)(b * SEQ + k0 + kk);
            Vs[i] = DIFF ? bf2f(C.PROJ[kt * NPROJ + 1536 + h * 128 + d]) : bf2f(C.KV[kt * 1024 + 512 + h * 64 + d]); }
        __syncthreads();
        for (int kk = 0; kk < 32; ++kk) {
            float s = 0.f;
#pragma unroll
            for (int d = 0; d < DQK; d += 4) { const f32x4 kv = *(const f32x4*)(Ks + kk * DQK + d); s += q[d] * kv[0] + q[d + 1] * kv[1] + q[d + 2] * kv[2] + q[d + 3] * kv[3]; }
            if (DIFF) { int rel = C.pos[b * SEQ + k0 + kk] - qpos; rel = rel < -128 ? -128 : (rel > 128 ? 128 : rel); s += btab[rel]; }
            const float mn = fmaxf(mx, s), al = __builtin_amdgcn_exp2f(mx - mn), p = __builtin_amdgcn_exp2f(s - mn);
            mx = mn; l = l * al + p;
#pragma unroll
            for (int d = 0; d < DV; d += 4) { const f32x4 vv = *(const f32x4*)(Vs + kk * DV + d); o[d] = o[d] * al + p * vv[0]; o[d + 1] = o[d + 1] * al + p * vv[1]; o[d + 2] = o[d + 2] * al + p * vv[2]; o[d + 3] = o[d + 3] * al + p * vv[3]; }
        }
    }
    const float rl = 1.0f / l;
    if (DIFF) { float* od = (float*)(C.ws + WS_ODIFF) + ((size_t)m * T + t) * 512 + h * 128;
#pragma unroll
        for (int d = 0; d < DV; d += 4) *(f32x4*)(od + d) = (f32x4){o[d] * rl, o[d + 1] * rl, o[d + 2] * rl, o[d + 3] * rl};
    } else { bf16* ao = C.AO + (size_t)t * DM + h * 64;
#pragma unroll
        for (int d = 0; d < DV; d += 8) { float v[8];
#pragma unroll
            for (int i = 0; i < 8; ++i) v[i] = o[d + i] * rl;
            store8_bf16(ao + d, v); } }
}
__global__ void __launch_bounds__(256) nk_attn_mla(Args a) {
    __shared__ __attribute__((aligned(16))) float lds[32 * 96 + 32 * 64]; Ctx C; ctx_init(C, a);
    const int u = blockIdx.x; naive_attn_block<96, 64, false>(C, u >> 6, (u >> 3) & 7, 0, u & 7, lds);
}
__global__ void __launch_bounds__(256) nk_attn_diff(Args a) {
    __shared__ __attribute__((aligned(16))) float lds[32 * 64 + 32 * 128]; Ctx C; ctx_init(C, a);
    const int u = blockIdx.x; naive_attn_block<64, 128, true>(C, u >> 6, (u >> 4) & 3, (u >> 3) & 1, u & 7, lds);
}
__global__ void __launch_bounds__(256) nk_attn_diff_combine(Args a) {
    Ctx C; ctx_init(C, a); const int lane = threadIdx.x & 63; const float lam = C.MISC[0];
    const float* od = (const float*)(C.ws + WS_ODIFF);
    for (int w = blockIdx.x * 4 + (threadIdx.x >> 6); w < T * 4; w += gridDim.x * 4) { const int t = w >> 2, h = w & 3;
        const f32x2 o0 = *(const f32x2*)(od + (size_t)t * 512 + h * 128 + 2 * lane), o1 = *(const f32x2*)(od + ((size_t)T + t) * 512 + h * 128 + 2 * lane);
        const float a0 = o0[0] - lam * o1[0], a1 = o0[1] - lam * o1[1];
        const float r = 1.0f / sqrtf(wave_sum(a0 * a0 + a1 * a1) * (1.f / 128.f) + RMS_EPS);
        const float v0 = a0 * r * C.subln[2 * lane] * (1.f - LAMBDA_INIT), v1 = a1 * r * C.subln[2 * lane + 1] * (1.f - LAMBDA_INIT);
        *(unsigned*)(C.AO + (size_t)t * DM + 512 + h * 128 + 2 * lane) = pk2(v0, v1); }
}

constexpr int NPHASE = 12;
__global__ void __launch_bounds__(NTHREADS, 2) mega(Args args) {
    extern __shared__ __attribute__((aligned(16))) unsigned char lds[];
    Ctx C; ctx_init(C, args);
    C.lds = (LAS unsigned char*)lds; C.lds_g = lds;
    C.tid = threadIdx.x; C.lane = C.tid & 63; C.wave = __builtin_amdgcn_readfirstlane(C.tid >> 6);
    C.G = gridDim.x; { const int bx = blockIdx.x; C.vcu = (C.G % 8 == 0) ? (bx % 8) * (C.G / 8) + bx / 8 : bx; }
    volatile LAS unsigned* MISCL = (volatile LAS unsigned*)(C.lds + MISC_OFF);
    for (int u = C.tid; u < (LDS_BYTES - LDSCTL_OFF) / 4; u += NTHREADS) ((LAS unsigned*)(C.lds + LDSCTL_OFF))[u] = 0u;
    __syncthreads();
    const int lo = args.ph_lo, hi = args.ph_hi;
    XcdBarrier bar; bar.bar = (unsigned*)(args.ws + WS_CTL) + CW_BAR + args.li * XCD_BAR_WORDS; bar.x = 0; bar.st = nullptr;
    if (hi - lo > 1) bar = xcd_barrier_post((unsigned*)(args.ws + WS_CTL) + CW_BAR + args.li * XCD_BAR_WORDS, MISCL + 8);
#ifndef CFG_DISABLE
#define CFG_DISABLE 0
#endif
#define IN(k) (!((CFG_DISABLE >> (k)) & 1) && lo <= (k) && (k) < hi)
#define SEAM(k) do { if (IN(k) && IN((k) + 1)) xcd_barrier(bar); } while (0)
    if (IN(0)) { phase_prep(C); } SEAM(0);
    if (IN(1)) { phase_u(C); } SEAM(1);
    if (IN(2)) {
        pg8::SchedDense S; S.init(C.U, DM, C.WIN, DM, T, NPROJ, C.G, (int)blockIdx.x);
        pg8::EpiRow8<FPlain> E{FPlain{C.PROJ, NPROJ}};
        pg8::gemm_phase(C.lds, DM * 2, S, E);
    } SEAM(2);
    if (IN(3)) { phase_fix1(C); } SEAM(3);
    if (IN(4)) {
        pg8::SchedQKV S{(const char*)C.PROJ, (const char*)C.WUQ, (const char*)C.WUKV, NPROJ * 2, 256 * 2, C.G, C.vcu};
        pg8::EpiQKV E{FRowScale{C.Q, 768, C.RINVQ}, FRowScale{C.KV, 1024, C.RINVKV}};
        pg8::gemm_phase(C.lds, 256 * 2, S, E);
    } SEAM(4);
    if (IN(5)) { att::attn_phase(C); } SEAM(5);
    if (IN(6)) {
        pg8::SchedDense S; S.init(C.AO, DM, C.WOUT, DM, T, DM, C.G, (int)blockIdx.x);
        pg8::EpiRow8<FY> E{FY{C.Y, C.x, C.MOD}};
        pg8::gemm_phase(C.lds, DM * 2, S, E);
    } SEAM(6);
    if (IN(7)) { phase_ln1(C); } SEAM(7);
    if (IN(8)) { phase_topk(C); phase_wconv(C); } SEAM(8);
    if (IN(9)) {
        pg8::SchedUp S{(const char*)C.U2, C.IDX, (const char*)C.WGU, DM, DM, C.G, C.vcu};
        pg8::EpiPair8<FSwi> E{FSwi{(unsigned char*)C.HLO}};
        pg8::gemm_phase<pg8::EpiPair8<FSwi>, pg8::SchedUp, true>(C.lds, DM, S, E);
    } SEAM(9);
    if (IN(10)) {
        pg8::SchedDown S{(const char*)C.HLO, (const char*)C.WD, FF, FF, C.G, C.vcu};
        pg8::EpiRow8<FGate> E{FGate{C.YE, C.GATE}};
        pg8::gemm_phase<pg8::EpiRow8<FGate>, pg8::SchedDown, true>(C.lds, FF, S, E);
    } SEAM(10);
    if (IN(11)) { phase_final(C); }
#undef IN
#undef SEAM
}

#ifndef CFG_SPLIT
#define CFG_SPLIT 0
#endif
static void launch_mega(const Args& base, int lo, int hi, int li, int grid, hipStream_t stream) {
    Args a = base; a.ph_lo = lo; a.ph_hi = hi; a.li = li;
    hipLaunchKernelGGL(mega, dim3(grid), dim3(NTHREADS), LDS_BYTES, stream, a);
}
static bool phase_in_mega(int p) { const bool has_naive = (p == 2 || p == 4 || p == 5 || p == 6 || p == 9 || p == 10); return has_naive ? (((unsigned)CFG_OPT_MASK >> p) & 1u) != 0u : true; }
extern "C" void kernel_launch(void* const* d_in, const int* in_sizes, int n_in, void* d_out, int out_size, void* d_ws, size_t ws_size, hipStream_t stream) {
    static int grid = 0;
    if (grid == 0) {
        if (n_in != 25 || out_size != T * DM || ws_size < WS_END) { fprintf(stderr, "kernel_launch: unexpected shapes (n_in %d out %d ws %zu, need %zu)\n", n_in, out_size, ws_size, (size_t)WS_END); grid = -1; return; }
        int dev = 0, cus = 0;
        if (hipGetDevice(&dev) != hipSuccess || hipDeviceGetAttribute(&cus, hipDeviceAttributeMultiprocessorCount, dev) != hipSuccess) { grid = -1; return; }
        if (hipFuncSetAttribute((const void*)mega, hipFuncAttributeMaxDynamicSharedMemorySize, LDS_BYTES) != hipSuccess) { fprintf(stderr, "kernel_launch: hipFuncSetAttribute failed\n"); grid = -1; return; }
        int per_cu = 0; (void)hipOccupancyMaxActiveBlocksPerMultiprocessor(&per_cu, (const void*)mega, NTHREADS, LDS_BYTES); (void)hipGetLastError();
        if (per_cu < 1) fprintf(stderr, "kernel_launch: occupancy query reports %d\n", per_cu);
        grid = cus;
        if (grid != 256) fprintf(stderr, "kernel_launch: %d CUs (built for 256)\n", grid);
    }
    if (grid < 0) return;
    (void)hipMemsetAsync((char*)d_ws + WS_CTL, 0, CTL_BYTES, stream);
    Args a{};
    for (int i = 0; i < 25; ++i) a.in[i] = d_in[i];
    a.out = (float*)d_out; a.ws = (unsigned char*)d_ws;
#ifdef CFG_PROBE_PHASE
    launch_mega(a, 0, CFG_PROBE_PHASE + 1, 0, grid, stream); launch_mega(a, CFG_PROBE_PHASE, CFG_PROBE_PHASE + 1, 1, grid, stream);
    if (CFG_PROBE_PHASE + 1 < NPHASE) launch_mega(a, CFG_PROBE_PHASE + 1, NPHASE, 2, grid, stream);
    return;
#endif
    int p = 0, li = 0;
    while (p < NPHASE) {
        if (phase_in_mega(p)) { int q = p + 1; if (!CFG_SPLIT) while (q < NPHASE && phase_in_mega(q)) ++q; launch_mega(a, p, q, li++, grid, stream); p = q; continue; }
        switch (p) {
            case 2: hipLaunchKernelGGL(nk_proj, dim3(1024), dim3(NTHREADS), 0, stream, a); break;
            case 4: hipLaunchKernelGGL(nk_qkv, dim3(1024), dim3(NTHREADS), 0, stream, a); break;
            case 5: hipLaunchKernelGGL(nk_attn_mla, dim3(1024), dim3(256), 0, stream, a);
                    hipLaunchKernelGGL(nk_attn_diff, dim3(1024), dim3(256), 0, stream, a);
                    hipLaunchKernelGGL(nk_attn_diff_combine, dim3(2048), dim3(256), 0, stream, a); break;
            case 6: hipLaunchKernelGGL(nk_out, dim3(1024), dim3(NTHREADS), 0, stream, a); break;
            default: break;
        }
        ++p;
    }
}
```

```cpp
#include <hip/hip_runtime.h>
#include <cstdio>
#include <cstdint>

#ifndef CFG_OPT_MASK
#define CFG_OPT_MASK 1652
#endif
#ifndef CFG_ONE_LAUNCH
#define CFG_ONE_LAUNCH 0
#endif

constexpr int BATCH = 16, SEQ = 2048, DM = 1024, T = BATCH * SEQ;
constexpr int NE = 16, FF = 2048, CAP = 256, NSEL = BATCH * NE * CAP;
constexpr int NPROJ = 2048;
constexpr float LOG2E = 1.4426950408889634f;
constexpr float MLA_SCALE = 0.10206207261596575f;
constexpr float DIFF_SCALE = 0.125f;
constexpr float ALPHA = 1.189207115002721f;
constexpr float LN_EPS = 1e-5f, RMS_EPS = 1e-6f;
constexpr float LAMBDA_INIT = 0.2f;

constexpr size_t MiB = 1u << 20;
constexpr size_t WS_CTL = 0, CTL_BYTES = 1 * MiB;
constexpr size_t WS_MOD = 1 * MiB;
constexpr size_t WS_MISC = 1 * MiB + 512 * 1024;
constexpr size_t WS_PMM = 1 * MiB + 768 * 1024;
constexpr size_t WS_CS = 2 * MiB, WS_SN = 4 * MiB;
constexpr size_t WS_AFF = 6 * MiB;
constexpr size_t WS_IDX = 8 * MiB, WS_GATE = 8 * MiB + 512 * 1024;
constexpr size_t WS_SLOT = 9 * MiB;
constexpr size_t WS_RINVQ = 11 * MiB, WS_RINVKV = 11 * MiB + 256 * 1024;
constexpr size_t WS_KR = 12 * MiB;
constexpr size_t WS_WIN = 14 * MiB, WS_WUQ = 18 * MiB, WS_WUKV = 18 * MiB + 512 * 1024, WS_WOUT = 19 * MiB;
constexpr size_t WS_WD = 22 * MiB;
constexpr size_t WS_WGU = 86 * MiB;
constexpr size_t WS_YE = WS_WGU;
constexpr size_t WS_PROJ = 214 * MiB;
constexpr size_t WS_Y = WS_PROJ, WS_HLO = WS_PROJ;
constexpr size_t WS_Q = 342 * MiB;
constexpr size_t WS_KV = 390 * MiB;
constexpr size_t WS_U2 = 342 * MiB;
constexpr size_t WS_U = 454 * MiB, WS_AO = 454 * MiB;
constexpr size_t WS_HHI = 406 * MiB;
constexpr size_t WS_END = 534 * MiB;
constexpr size_t WS_ODIFF = WS_WGU;

#define GAS __attribute__((address_space(1)))
#define LAS __attribute__((address_space(3)))
typedef unsigned short bf16;
typedef short bf16x8 __attribute__((ext_vector_type(8)));
typedef float f32x4 __attribute__((ext_vector_type(4)));
typedef float f32x2 __attribute__((ext_vector_type(2)));
typedef unsigned u32x4 __attribute__((ext_vector_type(4)));
typedef unsigned u32x2 __attribute__((ext_vector_type(2)));
typedef GAS unsigned gu32;
#define RLX_AGENT __ATOMIC_RELAXED, __HIP_MEMORY_SCOPE_AGENT
#define LDS_WAIT() asm volatile("s_waitcnt lgkmcnt(0)" ::: "memory")
#define VM_WAIT() asm volatile("s_waitcnt vmcnt(0)" ::: "memory")
__device__ __forceinline__ unsigned f2bf(float f) { unsigned u = __builtin_bit_cast(unsigned, f); return (u + 0x7fffu + ((u >> 16) & 1u)) >> 16; }
__device__ __forceinline__ unsigned pk2(float lo, float hi) { return f2bf(lo) | (f2bf(hi) << 16); }
__device__ __forceinline__ float bflo(unsigned w) { return __uint_as_float(w << 16); }
__device__ __forceinline__ float bfhi(unsigned w) { return __uint_as_float(w & 0xffff0000u); }
__device__ __forceinline__ float bf2f(bf16 h) { return __uint_as_float((unsigned)h << 16); }
__device__ __forceinline__ float wave_sum(float v) {
#pragma unroll
    for (int o = 1; o < 64; o <<= 1) v += __shfl_xor(v, o);
    return v;
}
__device__ __forceinline__ float wave_max(float v) {
#pragma unroll
    for (int o = 1; o < 64; o <<= 1) v = fmaxf(v, __shfl_xor(v, o));
    return v;
}
typedef int i32x4 __attribute__((ext_vector_type(4)));
typedef int i32x8 __attribute__((ext_vector_type(8)));
constexpr float FP8_MAX = 448.0f;
constexpr float SC_U2 = 16.0f, SC_WGU = 512.0f, SC_H = 4.0f, SC_WD = 1024.0f;
constexpr float DS_UP = 1.0f / (SC_U2 * SC_WGU), DS_DOWN = 1.0f / (SC_H * SC_WD);
__device__ __forceinline__ unsigned cvt4_fp8(float a, float b, float c, float d) {
    a = __builtin_amdgcn_fmed3f(a, -FP8_MAX, FP8_MAX); b = __builtin_amdgcn_fmed3f(b, -FP8_MAX, FP8_MAX); c = __builtin_amdgcn_fmed3f(c, -FP8_MAX, FP8_MAX); d = __builtin_amdgcn_fmed3f(d, -FP8_MAX, FP8_MAX);
    int w = 0; w = __builtin_amdgcn_cvt_pk_fp8_f32(a, b, w, false); w = __builtin_amdgcn_cvt_pk_fp8_f32(c, d, w, true); return (unsigned)w;
}
__device__ __forceinline__ float silu_f(float g) { return g * __builtin_amdgcn_rcpf(1.0f + __builtin_amdgcn_exp2f(-g * LOG2E)); }

#define XB_TMO      128
#define XB_XCNT(j)  (256  + 64 * (j))
#define XB_XSUB(j)  (1280 + 64 * (j))
#define XB_XGEN(j)  (2304 + 64 * (j))
#define XB_TOP      3328
#define XB_TOPGEN   3392
#define XCD_BAR_WORDS 3456
#define XB_SPIN_CAP (1u << 18)
__device__ __forceinline__ unsigned xb_ld(unsigned* p)              { return __hip_atomic_load(p, __ATOMIC_RELAXED, __HIP_MEMORY_SCOPE_AGENT); }
__device__ __forceinline__ unsigned xb_add(unsigned* p, unsigned v) { return __hip_atomic_fetch_add(p, v, __ATOMIC_RELAXED, __HIP_MEMORY_SCOPE_AGENT); }
__device__ __forceinline__ unsigned xb_xcc_id() { return (unsigned)__builtin_amdgcn_s_getreg((3 << 11) | 20) & 0xFu; }
#define XB_SPIN(cond, bar) do { unsigned _sp = 0; while (cond) { __builtin_amdgcn_s_sleep(1); \
    if ((++_sp & 255u) == 0u) { if (xb_ld(&(bar)[XB_TMO])) break; if (_sp > XB_SPIN_CAP) { atomicAdd(&(bar)[XB_TMO], 1u); break; } } } } while (0)
struct XcdBarrier { unsigned* bar; unsigned x; volatile LAS unsigned* st; };
__device__ __forceinline__ XcdBarrier xcd_barrier_post(unsigned* bar, volatile LAS unsigned* st) {
    XcdBarrier b; b.bar = bar; b.x = xb_xcc_id(); b.st = st;
    if (threadIdx.x == 0) (void)xb_add(&bar[XB_XCNT(b.x)], 1u);
    return b;
}
__device__ __forceinline__ void xcd_barrier_complete(unsigned* bar, unsigned x, unsigned& nloc, unsigned& nx) {
    const unsigned G = gridDim.x * gridDim.y * gridDim.z;
    unsigned sum, cnt, mine, sp = 0u;
    for (;;) {
        sum = 0u; cnt = 0u; mine = 0u;
#pragma unroll
        for (unsigned j = 0; j < 16; ++j) { const unsigned c = xb_ld(&bar[XB_XCNT(j)]); sum += c; cnt += (c > 0u) ? 1u : 0u; mine = (j == x) ? c : mine; }
        if (sum == G) break;
        __builtin_amdgcn_s_sleep(1);
        if ((++sp & 255u) == 0u) { if (xb_ld(&bar[XB_TMO])) break; if (sp > XB_SPIN_CAP) { atomicAdd(&bar[XB_TMO], 1u); break; } }
    }
    nloc = mine > 0u ? mine : 1u; nx = cnt > 0u ? cnt : 1u;
}
__device__ __forceinline__ void xcd_barrier(const XcdBarrier& b) {
    asm volatile("s_waitcnt vmcnt(0)" ::: "memory");
    __syncthreads();
    if (threadIdx.x == 0) {
        unsigned* bar = b.bar;
        __builtin_amdgcn_s_waitcnt(0);
        unsigned nloc = b.st[0], nx = b.st[1];
        if (nloc == 0u) { xcd_barrier_complete(bar, b.x, nloc, nx); b.st[0] = nloc; b.st[1] = nx; }
        const unsigned old = xb_add(&bar[XB_XSUB(b.x)], 1u);
        const unsigned gen = old / nloc;
        if (old + 1u == (gen + 1u) * nloc) {
            __builtin_amdgcn_fence(__ATOMIC_RELEASE, "agent");
            asm volatile("s_waitcnt vmcnt(0)" ::: "memory");
            const unsigned og = xb_add(&bar[XB_TOP], 1u);
            const unsigned tg = og / nx;
            if (og + 1u == (tg + 1u) * nx) xb_add(&bar[XB_TOPGEN], 1u);
            else XB_SPIN(xb_ld(&bar[XB_TOPGEN]) == tg, bar);
            __builtin_amdgcn_fence(__ATOMIC_ACQUIRE, "agent");
            xb_add(&bar[XB_XGEN(b.x)], 1u);
            asm volatile("s_waitcnt vmcnt(0)" ::: "memory");
        } else {
            XB_SPIN(xb_ld(&bar[XB_XGEN(b.x)]) == gen, bar);
            __builtin_amdgcn_fence(__ATOMIC_ACQUIRE, "agent");
            asm volatile("s_waitcnt vmcnt(0)" ::: "memory");
        }
    }
    __syncthreads();
}

constexpr int NWAVES = 8, NTHREADS = 512;
constexpr int RING_BYTES = 147456, LDSCTL_OFF = RING_BYTES, MISC_OFF = LDSCTL_OFF + 320, LDS_BYTES = 148480;
constexpr int CW_BAR = 4096;

struct Args { const void* in[25]; float* out; unsigned char* ws; int ph_lo, ph_hi, li, pad; };

struct Ctx {
    LAS unsigned char* lds; unsigned char* lds_g;
    int wave, vcu, G;
    const float *x, *c, *rel_bias, *w_ada, *b_ada, *w_in, *qnorm, *w_uq, *kvnorm, *w_ukv, *lq1, *lk1, *lq2, *lk2, *subln, *w_out, *ln1g, *ln1b, *w_router, *w_gate, *w_up, *w_down, *ln2g, *ln2b;
    const int* pos;
    float* out; unsigned char* ws;
    float *MOD, *MISC, *CS, *SN, *AFF, *GATE, *RINVQ, *RINVKV, *Y;
    int *PMM, *IDX, *SLOT;
    bf16 *KR, *WIN, *WUQ, *WUKV, *WOUT, *WD, *WGU, *YE, *PROJ, *Q, *KV, *U2, *U, *AO, *HLO, *HHI;
};
__device__ __forceinline__ void ctx_init(Ctx& C, const Args& a) {
    C.x = (const float*)a.in[0]; C.c = (const float*)a.in[1]; C.pos = (const int*)a.in[2]; C.rel_bias = (const float*)a.in[3];
    C.w_ada = (const float*)a.in[4]; C.b_ada = (const float*)a.in[5]; C.w_in = (const float*)a.in[6]; C.qnorm = (const float*)a.in[7];
    C.w_uq = (const float*)a.in[8]; C.kvnorm = (const float*)a.in[9]; C.w_ukv = (const float*)a.in[10];
    C.lq1 = (const float*)a.in[11]; C.lk1 = (const float*)a.in[12]; C.lq2 = (const float*)a.in[13]; C.lk2 = (const float*)a.in[14];
    C.subln = (const float*)a.in[15]; C.w_out = (const float*)a.in[16]; C.ln1g = (const float*)a.in[17]; C.ln1b = (const float*)a.in[18];
    C.w_router = (const float*)a.in[19]; C.w_gate = (const float*)a.in[20]; C.w_up = (const float*)a.in[21]; C.w_down = (const float*)a.in[22];
    C.ln2g = (const float*)a.in[23]; C.ln2b = (const float*)a.in[24];
    C.out = a.out; unsigned char* ws = a.ws; C.ws = ws;
    C.MOD = (float*)(ws + WS_MOD); C.MISC = (float*)(ws + WS_MISC); C.PMM = (int*)(ws + WS_PMM); C.CS = (float*)(ws + WS_CS); C.SN = (float*)(ws + WS_SN);
    C.AFF = (float*)(ws + WS_AFF); C.IDX = (int*)(ws + WS_IDX); C.GATE = (float*)(ws + WS_GATE); C.SLOT = (int*)(ws + WS_SLOT);
    C.RINVQ = (float*)(ws + WS_RINVQ); C.RINVKV = (float*)(ws + WS_RINVKV); C.KR = (bf16*)(ws + WS_KR);
    C.WIN = (bf16*)(ws + WS_WIN); C.WUQ = (bf16*)(ws + WS_WUQ); C.WUKV = (bf16*)(ws + WS_WUKV); C.WOUT = (bf16*)(ws + WS_WOUT);
    C.WD = (bf16*)(ws + WS_WD); C.WGU = (bf16*)(ws + WS_WGU); C.YE = (bf16*)(ws + WS_YE);
    C.PROJ = (bf16*)(ws + WS_PROJ); C.Y = (float*)(ws + WS_Y); C.HLO = (bf16*)(ws + WS_HLO); C.HHI = (bf16*)(ws + WS_HHI);
    C.Q = (bf16*)(ws + WS_Q); C.KV = (bf16*)(ws + WS_KV); C.U2 = (bf16*)(ws + WS_U2); C.U = (bf16*)(ws + WS_U); C.AO = (bf16*)(ws + WS_AO);
}

__device__ __forceinline__ void store8_bf16(bf16* p, const float (&v)[8]) {
    u32x4 w; w.x = pk2(v[0], v[1]); w.y = pk2(v[2], v[3]); w.z = pk2(v[4], v[5]); w.w = pk2(v[6], v[7]); *(u32x4*)p = w;
}
struct FPlain { bf16* O; int ldc;
    __device__ __forceinline__ void row8(int kind, int row, int col, const float (&v)[8]) const { store8_bf16(O + (size_t)row * ldc + col, v); } };
struct FRowScale { bf16* O; int ldc; const float* rs;
    __device__ __forceinline__ void row8(int kind, int row, int col, const float (&v)[8]) const {
        const float s = rs[row]; float o[8];
#pragma unroll
        for (int i = 0; i < 8; ++i) o[i] = v[i] * s;
        store8_bf16(O + (size_t)row * ldc + col, o);
    } };
struct FY { float* Y; const float* x; const float* mod;
    __device__ __forceinline__ void row8(int kind, int row, int col, const float (&v)[8]) const {
        const int b = row >> 11; const float* ga = mod + b * 6144 + 2048 + col; const float* xr = x + (size_t)row * DM + col; float* yo = Y + (size_t)row * DM + col;
        const f32x4 g0 = *(const f32x4*)ga, g1 = *(const f32x4*)(ga + 4), x0 = *(const f32x4*)xr, x1 = *(const f32x4*)(xr + 4);
        f32x4 y0, y1;
#pragma unroll
        for (int i = 0; i < 4; ++i) { y0[i] = ALPHA * x0[i] + g0[i] * v[i]; y1[i] = ALPHA * x1[i] + g1[i] * v[4 + i]; }
        *(f32x4*)yo = y0; *(f32x4*)(yo + 4) = y1;
    } };
struct FSwi { unsigned char* H;
    __device__ __forceinline__ void pair8(int row, int col, const float (&g)[8], const float (&u)[8]) const {
        float o[8];
#pragma unroll
        for (int i = 0; i < 8; ++i) o[i] = silu_f(g[i] * DS_UP) * (u[i] * (DS_UP * SC_H));
        u32x2 w; w.x = cvt4_fp8(o[0], o[1], o[2], o[3]); w.y = cvt4_fp8(o[4], o[5], o[6], o[7]);
        *(u32x2*)(H + (size_t)row * FF + col) = w;
    } };
struct FGate { bf16* YE; const float* gate;
    __device__ __forceinline__ void row8(int kind, int row, int col, const float (&v)[8]) const {
        const float s = gate[row] * DS_DOWN; float o[8];
#pragma unroll
        for (int i = 0; i < 8; ++i) o[i] = v[i] * s;
        store8_bf16(YE + (size_t)row * DM + col, o);
    } };

template <bool DUAL, class ARow, class BRow, class Epi>
__device__ __forceinline__ void naive_gemm_tile(int m0, int n0, int K, const ARow& arow, const BRow& brow, const Epi& epi, int kind, float* lds) {
    const int tid = threadIdx.x, ty = tid >> 4, tx = tid & 15;
    float* As = lds;
    float* Bs = lds + 16 * 132;
    float* Cs = lds + 32 * 132;
    float acc[4][8], acc2[4][8];
#pragma unroll
    for (int i = 0; i < 4; ++i)
#pragma unroll
        for (int j = 0; j < 8; ++j) { acc[i][j] = 0.f; acc2[i][j] = 0.f; }
    const int lr = tid >> 2, lk = (tid & 3) * 4;
    const bf16* ap = arow(m0 + lr); const bf16* bp = brow(n0 + lr, 0); const bf16* cp = DUAL ? brow(n0 + lr, 1) : bp;
    for (int k0 = 0; k0 < K; k0 += 16) {
        const u32x2 av = *(const u32x2*)(ap + k0 + lk), bv = *(const u32x2*)(bp + k0 + lk);
        u32x2 cv = bv; if (DUAL) cv = *(const u32x2*)(cp + k0 + lk);
        __syncthreads();
        As[(lk + 0) * 132 + lr] = bflo(av.x); As[(lk + 1) * 132 + lr] = bfhi(av.x); As[(lk + 2) * 132 + lr] = bflo(av.y); As[(lk + 3) * 132 + lr] = bfhi(av.y);
        Bs[(lk + 0) * 132 + lr] = bflo(bv.x); Bs[(lk + 1) * 132 + lr] = bfhi(bv.x); Bs[(lk + 2) * 132 + lr] = bflo(bv.y); Bs[(lk + 3) * 132 + lr] = bfhi(bv.y);
        if (DUAL) { Cs[(lk + 0) * 132 + lr] = bflo(cv.x); Cs[(lk + 1) * 132 + lr] = bfhi(cv.x); Cs[(lk + 2) * 132 + lr] = bflo(cv.y); Cs[(lk + 3) * 132 + lr] = bfhi(cv.y); }
        __syncthreads();
#pragma unroll
        for (int kk = 0; kk < 16; ++kk) {
            const f32x4 a = *(const f32x4*)(As + kk * 132 + ty * 4);
            const f32x4 b0 = *(const f32x4*)(Bs + kk * 132 + tx * 8), b1 = *(const f32x4*)(Bs + kk * 132 + tx * 8 + 4);
#pragma unroll
            for (int i = 0; i < 4; ++i)
#pragma unroll
                for (int j = 0; j < 4; ++j) { acc[i][j] += a[i] * b0[j]; acc[i][4 + j] += a[i] * b1[j]; }
            if (DUAL) {
                const f32x4 c0 = *(const f32x4*)(Cs + kk * 132 + tx * 8), c1 = *(const f32x4*)(Cs + kk * 132 + tx * 8 + 4);
#pragma unroll
                for (int i = 0; i < 4; ++i)
#pragma unroll
                    for (int j = 0; j < 4; ++j) { acc2[i][j] += a[i] * c0[j]; acc2[i][4 + j] += a[i] * c1[j]; }
            }
        }
    }
#pragma unroll
    for (int i = 0; i < 4; ++i) {
        if constexpr (DUAL) epi.pair8(m0 + ty * 4 + i, n0 + tx * 8, acc[i], acc2[i]);
        else epi.row8(kind, m0 + ty * 4 + i, n0 + tx * 8, acc[i]);
    }
}

__device__ __forceinline__ void tr_item(const float* W, int ldw, int kb, int srccol0, bool perm, float scale, const float* kgain, int kvalid,
                                        bf16* WT, int ldt, int n0, LAS float* scr, int lane) {
    const int k0 = 64 * kb, cl = lane & 31;
    const int sc = perm ? (16 * ((cl >> 2) & 1) + 4 * (cl >> 3) + (cl & 3)) : cl;
#pragma unroll 8
    for (int i = 0; i < 32; ++i) { const int kk = 2 * i + (lane >> 5), k = k0 + kk; float v = 0.f;
        if (srccol0 >= 0 && k < kvalid) { v = W[(size_t)k * ldw + srccol0 + sc] * scale; if (kgain) v *= kgain[k]; }
        scr[kk * 33 + cl] = v; }
    LDS_WAIT(); asm volatile("" ::: "memory");
    const int c = lane & 7;
#pragma unroll
    for (int j = 0; j < 4; ++j) { const int n = (lane >> 3) + 8 * j; const LAS float* s = scr + (8 * c) * 33 + n;
        u32x4 o; o.x = pk2(s[0 * 33], s[1 * 33]); o.y = pk2(s[2 * 33], s[3 * 33]); o.z = pk2(s[4 * 33], s[5 * 33]); o.w = pk2(s[6 * 33], s[7 * 33]);
        *(GAS u32x4*)(WT + (size_t)(n0 + n) * ldt + k0 + 8 * c) = o; }
    LDS_WAIT(); asm volatile("" ::: "memory");
}
__device__ __forceinline__ int t5_bucket(int rel) {
    const int nb = 16, max_exact = 8; int ret = rel > 0 ? nb : 0; const int n = rel < 0 ? -rel : rel;
    const float nf = (float)(n > 1 ? n : 1);
    int large = max_exact + (int)(logf(nf / 8.0f) / 2.772588722239781f * 8.0f);
    large = large < nb - 1 ? large : nb - 1;
    return ret + (n < max_exact ? n : large);
}

#define PHASE_IDS int tid_l_ = threadIdx.x; asm volatile("" : "+v"(tid_l_)); const int tid = tid_l_, lane = tid & 63; (void)lane
__device__ __forceinline__ void phase_prep(const Ctx& C) {
    PHASE_IDS;
    LAS float* scr = (LAS float*)(C.lds + C.wave * 8448);
    const int gw = C.vcu * NWAVES + C.wave, NGW = C.G * NWAVES;
    constexpr int I_IN = 16 * 64, I_UQ = 4 * 24, I_UKV = 4 * 32, I_OUT = 16 * 32, NIT = I_IN + I_UQ + I_UKV + I_OUT;
    for (int it = gw; it < NIT; it += NGW) {
        int r = it;
        if (r < I_IN) { const int kb = r / 64, nb = r % 64, n0 = 32 * nb; int src; bool perm = false; float sc = 1.f;
            if (nb < 12) src = n0; else if (nb == 12) { src = 384; perm = true; } else if (nb < 16) src = -1; else { src = 416 + (n0 - 512); if (n0 < 1024) sc = DIFF_SCALE * LOG2E; }
            tr_item(C.w_in, 1952, kb, src, perm, sc, nullptr, 1024, C.WIN, 1024, n0, scr, lane); continue; }
        r -= I_IN;
        if (r < I_UQ) { const int kb = r / 24, nb = r % 24, n0 = 32 * nb; int src; bool perm = false;
            if (nb < 16) { src = 96 * (n0 >> 6) + (n0 & 63); } else { src = 96 * (nb - 16) + 64; perm = true; }
            tr_item(C.w_uq, 768, kb, src, perm, MLA_SCALE * LOG2E, C.qnorm, 256, C.WUQ, 256, n0, scr, lane); continue; }
        r -= I_UQ;
        if (r < I_UKV) { const int kb = r / 32, nb = r % 32, n0 = 32 * nb; int src;
            if (nb < 16) src = 128 * (n0 >> 6) + (n0 & 63); else { const int n1 = n0 - 512; src = 128 * (n1 >> 6) + 64 + (n1 & 63); }
            tr_item(C.w_ukv, 1024, kb, src, false, 1.f, C.kvnorm, 128, C.WUKV, 256, n0, scr, lane); continue; }
        r -= I_UKV;
        { const int kb = r / 32, nb = r % 32; tr_item(C.w_out, 1024, kb, 32 * nb, false, 1.f, nullptr, 1024, C.WOUT, 1024, 32 * nb, scr, lane); }
    }
    for (int i = (C.vcu * NTHREADS + tid); i < T * 16; i += C.G * NTHREADS) { const int t = i >> 4, j = i & 15;
        const float freq = (float)pow(10000.0, -(double)j / 16.0); const float ang = (float)C.pos[t] * freq; float s, c; sincosf(ang, &s, &c);
        C.CS[i] = c; C.SN[i] = s; }
    for (int i = (C.vcu * NTHREADS + tid); i < BATCH * 32; i += C.G * NTHREADS) { int mn = 0x7fffffff, mx = -0x7fffffff - 1;
        for (int k = 0; k < 64; ++k) { const int p = C.pos[i * 64 + k]; mn = p < mn ? p : mn; mx = p > mx ? p : mx; }
        C.PMM[2 * i] = mn; C.PMM[2 * i + 1] = mx; }
    if (C.vcu == 255 % C.G) {
        for (int i = tid; i < 4 * 257; i += NTHREADS) { const int h = i / 257, r = i % 257 - 128; C.MISC[64 + h * 260 + (r + 128)] = C.rel_bias[t5_bucket(r) * 4 + h] * LOG2E; }
        if (C.wave == 0) { const float a = wave_sum(C.lq1[lane] * C.lk1[lane]), b = wave_sum(C.lq2[lane] * C.lk2[lane]);
            if (lane == 0) C.MISC[0] = expf(a) - expf(b) + LAMBDA_INIT; }
    }
    __syncthreads();
    LAS float* cact = (LAS float*)C.lds;
    LAS float* red = (LAS float*)(C.lds + 65536);
    bool have = false;
    for (int u = C.vcu; u < 192; u += C.G) {
        if (!have) { for (int i = tid; i < 16 * 1024; i += NTHREADS) { const int b = i >> 10, d = i & 1023; const float v = C.c[i]; cact[d * 16 + b] = v / (1.0f + expf(-v)); } have = true; __syncthreads(); }
        const int nl = tid & 31, kc = tid >> 5, n = 32 * u + nl;
        float acc[16];
#pragma unroll
        for (int b = 0; b < 16; ++b) acc[b] = 0.f;
#pragma unroll 8
        for (int i = 0; i < 64; ++i) { const int d = kc * 64 + i; const float w = C.w_ada[(size_t)d * 6144 + n];
#pragma unroll
            for (int q = 0; q < 4; ++q) { const f32x4 ca = *(const LAS f32x4*)(cact + d * 16 + 4 * q); acc[4 * q] += w * ca[0]; acc[4 * q + 1] += w * ca[1]; acc[4 * q + 2] += w * ca[2]; acc[4 * q + 3] += w * ca[3]; } }
#pragma unroll
        for (int b = 0; b < 16; ++b) red[(kc * 16 + b) * 32 + nl] = acc[b];
        __syncthreads();
        { const int b = tid >> 5; float s = C.b_ada[n];
#pragma unroll
            for (int k = 0; k < 16; ++k) s += red[(k * 16 + b) * 32 + nl];
            C.MOD[b * 6144 + n] = s; }
        __syncthreads();
    }
}
__device__ __forceinline__ void phase_u(const Ctx& C) {
    PHASE_IDS;
    for (size_t i = (size_t)C.vcu * NTHREADS + tid; i < (size_t)T * DM / 8; i += (size_t)C.G * NTHREADS) {
        const size_t e = i * 8; const int row = (int)(e >> 10), col = (int)(e & 1023), b = row >> 11;
        const f32x4 x0 = *(const f32x4*)(C.x + e), x1 = *(const f32x4*)(C.x + e + 4);
        const float* sh = C.MOD + b * 6144 + col; const float* sc = sh + 1024;
        const f32x4 h0 = *(const f32x4*)sh, h1 = *(const f32x4*)(sh + 4), c0 = *(const f32x4*)sc, c1 = *(const f32x4*)(sc + 4);
        u32x4 w; w.x = pk2(x0[0] * (1.f + c0[0]) + h0[0], x0[1] * (1.f + c0[1]) + h0[1]); w.y = pk2(x0[2] * (1.f + c0[2]) + h0[2], x0[3] * (1.f + c0[3]) + h0[3]);
        w.z = pk2(x1[0] * (1.f + c1[0]) + h1[0], x1[1] * (1.f + c1[1]) + h1[1]); w.w = pk2(x1[2] * (1.f + c1[2]) + h1[2], x1[3] * (1.f + c1[3]) + h1[3]);
        *(u32x4*)(C.U + e) = w;
    }
}
__device__ __forceinline__ void phase_fix1(const Ctx& C) {
    PHASE_IDS;
    const int gw = C.vcu * NWAVES + C.wave, NGW = C.G * NWAVES;
    for (int t = gw; t < T; t += NGW) {
        const bf16* pr = C.PROJ + (size_t)t * NPROJ;
        const u32x2 q = *(const u32x2*)(pr + 4 * lane); const unsigned kv = *(const unsigned*)(pr + 256 + 2 * lane);
        float sq = bflo(q.x) * bflo(q.x) + bfhi(q.x) * bfhi(q.x) + bflo(q.y) * bflo(q.y) + bfhi(q.y) * bfhi(q.y);
        float sk = bflo(kv) * bflo(kv) + bfhi(kv) * bfhi(kv);
        sq = wave_sum(sq); sk = wave_sum(sk);
        if (lane == 0) { C.RINVQ[t] = 1.0f / sqrtf(sq * (1.f / 256.f) + RMS_EPS); C.RINVKV[t] = 1.0f / sqrtf(sk * (1.f / 128.f) + RMS_EPS); }
        if (lane < 4) { const int fq = lane; const u32x4 w = *(const u32x4*)(pr + 384 + 8 * fq);
            const f32x4 c4 = *(const f32x4*)(C.CS + (size_t)t * 16 + 4 * fq), s4 = *(const f32x4*)(C.SN + (size_t)t * 16 + 4 * fq);
            const float t1[4] = {bflo(w.x), bfhi(w.x), bflo(w.y), bfhi(w.y)}, t2[4] = {bflo(w.z), bfhi(w.z), bflo(w.w), bfhi(w.w)};
            float o[8];
#pragma unroll
            for (int i = 0; i < 4; ++i) { o[i] = t1[i] * c4[i] - t2[i] * s4[i]; o[4 + i] = t1[i] * s4[i] + t2[i] * c4[i]; }
            store8_bf16(C.KR + (size_t)t * 32 + 8 * fq, o); }
    }
}
__device__ __forceinline__ void phase_ln1(const Ctx& C) {
    PHASE_IDS;
    LAS float* wr = (LAS float*)C.lds;
    LAS float* urow = (LAS float*)(C.lds + 65536) + C.wave * 1024;
    for (int i = tid; i < 1024 * 4; i += NTHREADS) { const int d = i >> 2, ch = i & 3; const f32x4 v = *(const f32x4*)(C.w_router + d * 16 + 4 * ch);
        *(LAS f32x4*)(wr + d * 16 + 4 * (ch ^ ((d >> 2) & 3))) = v; }
    __syncthreads();
    const int gw = C.vcu * NWAVES + C.wave, NGW = C.G * NWAVES;
    for (int t = gw; t < T; t += NGW) {
        const int b = t >> 11, s = t & 2047;
        const f32x4* yr = (const f32x4*)(C.Y + (size_t)t * DM) + lane;
        f32x4 v[4]; float sum = 0.f;
#pragma unroll
        for (int j = 0; j < 4; ++j) { v[j] = yr[64 * j]; sum += (v[j][0] + v[j][1]) + (v[j][2] + v[j][3]); }
        const float mean = wave_sum(sum) * (1.f / DM); float s2 = 0.f;
#pragma unroll
        for (int j = 0; j < 4; ++j) { v[j] = v[j] - mean; s2 += (v[j][0] * v[j][0] + v[j][1] * v[j][1]) + (v[j][2] * v[j][2] + v[j][3] * v[j][3]); }
        const float rstd = 1.0f / sqrtf(wave_sum(s2) * (1.f / DM) + LN_EPS);
        const float* mod = C.MOD + b * 6144;
#pragma unroll
        for (int j = 0; j < 4; ++j) { const int col = 4 * lane + 256 * j;
            const f32x4 g = *(const f32x4*)(C.ln1g + col), be = *(const f32x4*)(C.ln1b + col), sh = *(const f32x4*)(mod + 3072 + col), sc = *(const f32x4*)(mod + 4096 + col);
            f32x4 x1, u2;
#pragma unroll
            for (int i = 0; i < 4; ++i) { x1[i] = v[j][i] * rstd * g[i] + be[i]; u2[i] = x1[i] * (1.f + sc[i]) + sh[i]; }
            *(f32x4*)(C.out + (size_t)t * DM + col) = x1;
            *(unsigned*)((unsigned char*)C.U2 + (size_t)t * DM + col) = cvt4_fp8(u2[0] * SC_U2, u2[1] * SC_U2, u2[2] * SC_U2, u2[3] * SC_U2);
            *(LAS f32x4*)(urow + col) = u2; }
        LDS_WAIT(); asm volatile("" ::: "memory");
        float lg[16];
#pragma unroll
        for (int e = 0; e < 16; ++e) lg[e] = 0.f;
#pragma unroll 4
        for (int k = 0; k < 16; ++k) { const int d = lane + 64 * k; const float uv = urow[d]; const int sw = (d >> 2) & 3;
#pragma unroll
            for (int ch = 0; ch < 4; ++ch) { const f32x4 w = *(const LAS f32x4*)(wr + d * 16 + 4 * (ch ^ sw)); lg[4 * ch] += uv * w[0]; lg[4 * ch + 1] += uv * w[1]; lg[4 * ch + 2] += uv * w[2]; lg[4 * ch + 3] += uv * w[3]; } }
        float mx = -1e30f;
#pragma unroll
        for (int e = 0; e < 16; ++e) { lg[e] = wave_sum(lg[e]); mx = fmaxf(mx, lg[e]); }
        float den = 0.f;
#pragma unroll
        for (int e = 0; e < 16; ++e) { lg[e] = expf(lg[e] - mx); den += lg[e]; }
        const float rden = 1.0f / den; float mine = 0.f;
#pragma unroll
        for (int e = 0; e < 16; ++e) mine = (lane == e) ? lg[e] * rden : mine;
        if (lane < 16) C.AFF[((size_t)b * 16 + lane) * SEQ + s] = mine;
        LDS_WAIT(); asm volatile("" ::: "memory");
    }
}
__device__ __forceinline__ unsigned block_count(LAS unsigned* cnt, int wave, int lane, unsigned c) {
    c += __shfl_xor(c, 1); c += __shfl_xor(c, 2); c += __shfl_xor(c, 4); c += __shfl_xor(c, 8); c += __shfl_xor(c, 16); c += __shfl_xor(c, 32);
    __syncthreads();
    if (lane == 0) cnt[wave] = c;
    __syncthreads();
    unsigned s = 0;
#pragma unroll
    for (int w = 0; w < NWAVES; ++w) s += cnt[w];
    return s;
}
__device__ __forceinline__ unsigned block_excl_scan(LAS unsigned* cnt, int wave, int lane, unsigned c) {
    unsigned inc = c;
#pragma unroll
    for (int o = 1; o < 64; o <<= 1) { const unsigned n = __shfl_up(inc, o); if (lane >= o) inc += n; }
    __syncthreads();
    if (lane == 63) cnt[wave] = inc;
    __syncthreads();
    unsigned base = 0;
#pragma unroll
    for (int w = 0; w < NWAVES; ++w) base += (w < wave) ? cnt[w] : 0u;
    return base + inc - c;
}
__device__ __forceinline__ void phase_topk(const Ctx& C) {
    PHASE_IDS;
    LAS unsigned* cnt = (LAS unsigned*)(C.lds + 4096);
    for (int be = C.vcu; be < BATCH * NE; be += C.G) {
        const int b = be >> 4, e = be & 15;
        const float* aff = C.AFF + ((size_t)b * 16 + e) * SEQ;
        const u32x4 kv = *(const u32x4*)(aff + 4 * tid);
        const unsigned key[4] = {kv.x, kv.y, kv.z, kv.w};
        unsigned prefix = 0;
        for (int bit = 30; bit >= 0; --bit) { const unsigned cand = prefix | (1u << bit);
            unsigned c = 0;
#pragma unroll
            for (int i = 0; i < 4; ++i) c += key[i] >= cand ? 1u : 0u;
            if (block_count(cnt, C.wave, lane, c) >= (unsigned)CAP) prefix = cand; }
        unsigned cg = 0, ce = 0;
#pragma unroll
        for (int i = 0; i < 4; ++i) { cg += key[i] > prefix ? 1u : 0u; ce += key[i] == prefix ? 1u : 0u; }
        const unsigned ngt = block_count(cnt, C.wave, lane, cg);
        const unsigned need = (unsigned)CAP - ngt;
        unsigned tb = block_excl_scan(cnt, C.wave, lane, ce);
        unsigned sel[4], cs = 0;
#pragma unroll
        for (int i = 0; i < 4; ++i) { const bool eq = key[i] == prefix; sel[i] = (key[i] > prefix || (eq && tb < need)) ? 1u : 0u; tb += eq ? 1u : 0u; cs += sel[i]; }
        unsigned p = block_excl_scan(cnt, C.wave, lane, cs);
#pragma unroll
        for (int i = 0; i < 4; ++i) { const int s = 4 * tid + i; int slot = -1;
            if (sel[i]) { slot = (int)p; C.IDX[be * CAP + p] = s; C.GATE[be * CAP + p] = __uint_as_float(key[i]); ++p; }
            C.SLOT[((size_t)b * 16 + e) * SEQ + s] = slot; }
        __syncthreads();
    }
}
typedef short s16x4_t __attribute__((ext_vector_type(4)));
__device__ __forceinline__ void tr64_item(const float* W, int ldw, int k0, int n0, float scale, unsigned char* WT, int ldt, int nt0, LAS unsigned char* img, int lane) {
    const int kr = lane >> 4, c4 = lane & 15;
    f32x4 v[16];
    const float* src = W + (size_t)(k0 + kr) * ldw + n0 + 4 * c4;
#pragma unroll
    for (int i = 0; i < 16; ++i) v[i] = *(const f32x4*)(src + (size_t)(4 * i) * ldw);
    asm volatile("" : "+v"(v[0]), "+v"(v[1]), "+v"(v[2]), "+v"(v[3]), "+v"(v[4]), "+v"(v[5]), "+v"(v[6]), "+v"(v[7]));
    asm volatile("" : "+v"(v[8]), "+v"(v[9]), "+v"(v[10]), "+v"(v[11]), "+v"(v[12]), "+v"(v[13]), "+v"(v[14]), "+v"(v[15]));
#pragma unroll
    for (int i = 0; i < 16; ++i) { u32x2 w; w.x = pk2(v[i][0] * scale, v[i][1] * scale); w.y = pk2(v[i][2] * scale, v[i][3] * scale); *(LAS u32x2*)(img + (4 * i + kr) * 192 + 8 * c4) = w; }
    LDS_WAIT(); asm volatile("" ::: "memory");
    const int g = lane >> 4, q = (lane >> 2) & 3, p = lane & 3, i16 = lane & 15;
    const int rdbase = (int)(unsigned)(size_t)img + (8 * (g >> 1) + q) * 192 + (16 * (g & 1) + 4 * p) * 2;
#pragma unroll
    for (int s = 0; s < 8; ++s) { const int jj = s >> 1, nn = s & 1;
        s16x4_t lo, hi;
        asm volatile("ds_read_b64_tr_b16 %0, %1 offset:%2" : "=&v"(lo) : "v"(rdbase), "i"((16 * jj) * 192 + 64 * nn) : "memory");
        asm volatile("ds_read_b64_tr_b16 %0, %1 offset:%2" : "=&v"(hi) : "v"(rdbase), "i"((16 * jj + 4) * 192 + 64 * nn) : "memory");
        asm volatile("s_waitcnt lgkmcnt(0)" : "+v"(lo), "+v"(hi) :: "memory");
        const int kc = 2 * jj + (g >> 1), n = 16 * (2 * nn + (g & 1)) + i16;
        const u32x2 l2 = __builtin_bit_cast(u32x2, lo), h2 = __builtin_bit_cast(u32x2, hi);
        u32x2 o; o.x = cvt4_fp8(bflo(l2.x), bfhi(l2.x), bflo(l2.y), bfhi(l2.y)); o.y = cvt4_fp8(bflo(h2.x), bfhi(h2.x), bflo(h2.y), bfhi(h2.y));
        *(GAS u32x2*)(WT + (size_t)(nt0 + n) * ldt + k0 + 8 * kc) = o; }
    LDS_WAIT(); asm volatile("" ::: "memory");
}
__device__ __forceinline__ void wconv_slice(const Ctx& C, int s, int NSL) {
    LAS unsigned char* img = C.lds + 8192 + C.wave * 12288;
    int lane = threadIdx.x & 63; asm volatile("" : "+v"(lane));
    const int gw = C.vcu * NWAVES + C.wave, NGW = C.G * NWAVES;
    constexpr int I_GU = 2 * 16 * 32, I_D = 32 * 16, I_E = I_GU + I_D;
    int k = 0;
    for (int it = gw; it < NE * I_E; it += NGW, ++k) {
        if (k % NSL != s) continue;
        const int e = it / I_E; int r = it % I_E;
        if (r < I_GU) { const int up = r >> 9, kb = (r >> 5) & 15, nb = r & 31, n0 = 64 * nb;
            const float* W = (up ? C.w_up : C.w_gate) + (size_t)e * DM * FF;
            tr64_item(W, FF, 64 * kb, n0, SC_WGU, (unsigned char*)C.WGU + (size_t)e * 4096 * DM, DM, (n0 >> 7) * 256 + (n0 & 127) + up * 128, img, lane); }
        else { r -= I_GU; const int kb = r >> 4, nb = r & 15;
            tr64_item(C.w_down + (size_t)e * FF * DM, DM, 64 * kb, 64 * nb, SC_WD, (unsigned char*)C.WD + (size_t)e * DM * FF, FF, 64 * nb, img, lane); }
    }
}
__device__ __forceinline__ void phase_final(const Ctx& C) {
    PHASE_IDS;
    const int gw = C.vcu * NWAVES + C.wave, NGW = C.G * NWAVES;
    for (int t = gw; t < T; t += NGW) {
        const int b = t >> 11, s = t & 2047;
        f32x4 a[4];
#pragma unroll
        for (int j = 0; j < 4; ++j) a[j] = (f32x4){0.f, 0.f, 0.f, 0.f};
        const int myslot = lane < 16 ? C.SLOT[((size_t)b * 16 + lane) * SEQ + s] : -1;
        for (int e = 0; e < 16; ++e) { const int p = __shfl(myslot, e);
            if (p >= 0) { const bf16* yr = C.YE + ((size_t)(b * 16 + e) * CAP + p) * DM;
#pragma unroll
                for (int j = 0; j < 4; ++j) { const u32x2 w = *(const u32x2*)(yr + 4 * lane + 256 * j); a[j][0] += bflo(w.x); a[j][1] += bfhi(w.x); a[j][2] += bflo(w.y); a[j][3] += bfhi(w.y); } } }
        const float* mod = C.MOD + b * 6144 + 5120;
        f32x4 v[4]; float sum = 0.f;
#pragma unroll
        for (int j = 0; j < 4; ++j) { const int col = 4 * lane + 256 * j; const f32x4 x1 = *(const f32x4*)(C.out + (size_t)t * DM + col), g = *(const f32x4*)(mod + col);
#pragma unroll
            for (int i = 0; i < 4; ++i) v[j][i] = ALPHA * x1[i] + g[i] * a[j][i];
            sum += (v[j][0] + v[j][1]) + (v[j][2] + v[j][3]); }
        const float mean = wave_sum(sum) * (1.f / DM); float s2 = 0.f;
#pragma unroll
        for (int j = 0; j < 4; ++j) { v[j] = v[j] - mean; s2 += (v[j][0] * v[j][0] + v[j][1] * v[j][1]) + (v[j][2] * v[j][2] + v[j][3] * v[j][3]); }
        const float rstd = 1.0f / sqrtf(wave_sum(s2) * (1.f / DM) + LN_EPS);
#pragma unroll
        for (int j = 0; j < 4; ++j) { const int col = 4 * lane + 256 * j; const f32x4 g = *(const f32x4*)(C.ln2g + col), be = *(const f32x4*)(C.ln2b + col); f32x4 o;
#pragma unroll
            for (int i = 0; i < 4; ++i) o[i] = v[j][i] * rstd * g[i] + be[i];
            *(f32x4*)(C.out + (size_t)t * DM + col) = o; }
    }
}


namespace pg8 {
#define PG8_LAS __attribute__((address_space(3)))
constexpr int BM = 256, BK = 64, HALF = 128, HTB = HALF * BK * 2, STAGE_BYTES = 8 * HTB;
__host__ __device__ __forceinline__ int lds_byte(int r, int c) { const int st = (r >> 4) * 2 + (c >> 5), rr = r & 15, cc = c & 31, ob = rr * 64 + cc * 2; return st * 1024 + (ob ^ (((ob >> 9) & 1) << 5)); }
__host__ __device__ __forceinline__ void stage_rc(int b, int& R, int& C) { const int st = b / 1024, sb = b % 1024, swz = sb ^ (((sb >> 9) & 1) << 5); R = (st >> 1) * 16 + swz / 64; C = (st & 1) * 32 + (swz % 64) / 2; }
__host__ __device__ __forceinline__ int perm32(int rho) { const int n = rho >> 4, i = rho & 15; return 8 * (i >> 2) + 4 * n + (i & 3); }
struct Unit { int pm, pn, kind; };

template <class F> struct EpiRow8 { static constexpr bool PERM = true; F f;
    __device__ __forceinline__ void operator()(const f32x4 (&acc)[2][2][4][2], const Unit& u, int wr, int wc, int fr, int fq) const {
        const int row0 = u.pm * BM + wr * 64 + fr, col0 = u.pn * BM + wc * 32 + 8 * fq;
#pragma unroll
        for (int ai = 0; ai < 2; ++ai)
#pragma unroll
            for (int m = 0; m < 4; ++m)
#pragma unroll
                for (int bj = 0; bj < 2; ++bj) { const f32x4 a = acc[ai][bj][m][0], b = acc[ai][bj][m][1]; const float v[8] = {a[0], a[1], a[2], a[3], b[0], b[1], b[2], b[3]};
                    f.row8(u.kind, row0 + ai * HALF + m * 16, col0 + bj * HALF, v); }
    } };
struct EpiQKV { static constexpr bool PERM = true; FRowScale fq, fkv;
    __device__ __forceinline__ void operator()(const f32x4 (&acc)[2][2][4][2], const Unit& u, int wr, int wc, int fr, int fq_) const {
        EpiRow8<FRowScale> e{u.kind ? fkv : fq}; e(acc, u, wr, wc, fr, fq_);
    } };
template <class F> struct EpiPair8 { static constexpr bool PERM = true; F f;
    __device__ __forceinline__ void operator()(const f32x4 (&acc)[2][2][4][2], const Unit& u, int wr, int wc, int fr, int fq) const {
        const int row0 = u.pm * BM + wr * 64 + fr, col0 = u.pn * HALF + wc * 32 + 8 * fq;
#pragma unroll
        for (int ai = 0; ai < 2; ++ai)
#pragma unroll
            for (int m = 0; m < 4; ++m) { const f32x4 a = acc[ai][0][m][0], b = acc[ai][0][m][1], c = acc[ai][1][m][0], d = acc[ai][1][m][1];
                const float g[8] = {a[0], a[1], a[2], a[3], b[0], b[1], b[2], b[3]}, up[8] = {c[0], c[1], c[2], c[3], d[0], d[1], d[2], d[3]};
                f.pair8(row0 + ai * HALF + m * 16, col0, g, up); }
    } };

template <class Epi, class Sched, bool FP8 = false, bool ALIGN_EPI = true, bool SP2 = true>
__device__ __forceinline__ void gemm_phase(PG8_LAS unsigned char* lds, const int KB  , const Sched& S, const Epi& E) {
    const int tid = threadIdx.x, wid = __builtin_amdgcn_readfirstlane(tid >> 6), lane = tid & 63, wr = wid >> 2, wc = wid & 3, fr = lane & 15, fq = lane >> 4;
    const int nt = KB / (BK * 2);
    Unit cur, nxt; int ui = 0;
    if (!S.next(0, cur)) return;
    unsigned voffA[2][2], voffB[2];
#pragma unroll
    for (int i = 0; i < 2; ++i) { int R, C; stage_rc(tid * 16 + i * 8192, R, C); const int Rb = Epi::PERM ? ((R & ~31) + perm32(R & 31)) : R;
        voffB[i] = (unsigned)(Rb * S.ldb) + (unsigned)C * 2u;
#pragma unroll
        for (int h = 0; h < 2; ++h) voffA[h][i] = S.a_rowoff(cur, h * HALF + R) + (unsigned)C * 2u; }
    const size_t kstep = (size_t)(BK * 2);
    const size_t hstepB = (size_t)HALF * S.ldb;
    const unsigned ldsw = (unsigned)wid * 1024u;
    const int aoff = lds_byte(wr * 64 + fr, fq * 8), boff = lds_byte(wc * 32 + fr, fq * 8);
#define PG8_SA(b, h) (((b) * 2 + (h)) * HTB)
#define PG8_SB(b, h) ((4 + (b) * 2 + (h)) * HTB)
#define PG8_STAGE_A(bufoff, gbase, h) do { _Pragma("unroll") for (int _i = 0; _i < 2; ++_i) \
        __builtin_amdgcn_global_load_lds((const unsigned*)((const char*)(gbase) + voffA[h][_i]), (PG8_LAS unsigned*)(lds + (bufoff) + ldsw + _i * 8192), 16, 0, 0); } while (0)
#define PG8_STAGE_B(bufoff, gbase) do { _Pragma("unroll") for (int _i = 0; _i < 2; ++_i) \
        __builtin_amdgcn_global_load_lds((const unsigned*)((const char*)(gbase) + voffB[_i]), (PG8_LAS unsigned*)(lds + (bufoff) + ldsw + _i * 8192), 16, 0, 0); } while (0)
#define PG8_LDA(dst, b, h) do { _Pragma("unroll") for (int m = 0; m < 4; ++m) dst[m] = PG8_CAT(*(const PG8_LAS i32x4*)(lds + PG8_SA(b, h) + aoff + m * 2048), *(const PG8_LAS i32x4*)(lds + PG8_SA(b, h) + aoff + m * 2048 + 1024)); } while (0)
#define PG8_LDB(dst, b, h) do { _Pragma("unroll") for (int n = 0; n < 2; ++n) dst[n] = PG8_CAT(*(const PG8_LAS i32x4*)(lds + PG8_SB(b, h) + boff + n * 2048), *(const PG8_LAS i32x4*)(lds + PG8_SB(b, h) + boff + n * 2048 + 1024)); } while (0)
#define PG8_CAT(x, y) __builtin_shufflevector(x, y, 0, 1, 2, 3, 4, 5, 6, 7)
#define PG8_LO(x) __builtin_bit_cast(bf16x8, __builtin_shufflevector(x, x, 0, 1, 2, 3))
#define PG8_HI(x) __builtin_bit_cast(bf16x8, __builtin_shufflevector(x, x, 4, 5, 6, 7))
#define PG8_MMA(ai, bj, At, Bt) do { __builtin_amdgcn_s_setprio(1); _Pragma("unroll") for (int m = 0; m < 4; ++m) _Pragma("unroll") for (int n = 0; n < 2; ++n) { \
        if constexpr (FP8) asm volatile("v_mfma_f32_16x16x128_f8f6f4 %0, %1, %2, %0" : "+v"(acc[ai][bj][m][n]) : "v"(Bt[n]), "v"(At[m]));   \
        else { acc[ai][bj][m][n] = __builtin_amdgcn_mfma_f32_16x16x32_bf16(PG8_LO(Bt[n]), PG8_LO(At[m]), acc[ai][bj][m][n], 0, 0, 0); \
               acc[ai][bj][m][n] = __builtin_amdgcn_mfma_f32_16x16x32_bf16(PG8_HI(Bt[n]), PG8_HI(At[m]), acc[ai][bj][m][n], 0, 0, 0); } } \
        __builtin_amdgcn_s_setprio(0); } while (0)
#define PG8_WAIT_V(n) asm volatile("s_waitcnt vmcnt(" #n ")" ::: "memory")
#define PG8_WAIT_L(n) asm volatile("s_waitcnt lgkmcnt(" #n ")" ::: "memory")
#define PG8_BAR __builtin_amdgcn_s_barrier()
#define PG8_SCHED __builtin_amdgcn_sched_barrier(0)
    f32x4 acc[2][2][4][2];
#pragma unroll
    for (int a = 0; a < 2; ++a)
#pragma unroll
        for (int b = 0; b < 2; ++b)
#pragma unroll
            for (int m = 0; m < 4; ++m)
#pragma unroll
                for (int n = 0; n < 2; ++n) acc[a][b][m][n] = (f32x4){0.f, 0.f, 0.f, 0.f};
    i32x8 At[4], B0[2], B1[2];
    const char* cA = S.a_base(cur); const char* cB = S.b_base(cur);
    if constexpr (SP2) {
        PG8_STAGE_B(PG8_SB(0, 0), cB); PG8_STAGE_B(PG8_SB(0, 1), cB + hstepB); PG8_STAGE_A(PG8_SA(0, 0), cA, 0); PG8_STAGE_A(PG8_SA(0, 1), cA, 1);
        if (wr == 1) PG8_BAR;
        PG8_WAIT_V(2); PG8_BAR;
        PG8_STAGE_B(PG8_SB(1, 0), cB + kstep); PG8_STAGE_A(PG8_SA(1, 0), cA + kstep, 0); PG8_STAGE_B(PG8_SB(1, 1), cB + hstepB + kstep);
        PG8_WAIT_V(6); PG8_BAR;
    } else {
        PG8_STAGE_B(PG8_SB(0, 0), cB); PG8_STAGE_A(PG8_SA(0, 0), cA, 0); PG8_STAGE_B(PG8_SB(0, 1), cB + hstepB); PG8_STAGE_A(PG8_SA(0, 1), cA, 1);
        if (wr == 1) PG8_BAR;
        PG8_WAIT_V(4); PG8_BAR;
        PG8_STAGE_B(PG8_SB(1, 0), cB + kstep); PG8_STAGE_A(PG8_SA(1, 0), cA + kstep, 0); PG8_STAGE_B(PG8_SB(1, 1), cB + hstepB + kstep);
        PG8_WAIT_V(6); PG8_BAR;
    }
    for (;;) {
        const bool has_next = S.next(ui + 1, nxt);
        const char* nA = has_next ? S.a_base(nxt) : cA; const char* nB = has_next ? S.b_base(nxt) : cB;
#pragma unroll 1
        for (int t = 0; t < nt; t += 2) {
            const bool last = (t == nt - 2);
            const char* a1 = cA + (size_t)(t + 1) * kstep;
            const char* a2 = last ? nA : cA + (size_t)(t + 2) * kstep; const char* b2 = last ? nB : cB + (size_t)(t + 2) * kstep;
            const char* a3 = a2 + kstep; const char* b3 = b2 + kstep;
            if constexpr (SP2) {
            PG8_LDB(B0, 0, 0); PG8_LDB(B1, 0, 1); PG8_SCHED; PG8_LDA(At, 0, 0); PG8_STAGE_A(PG8_SA(1, 1), a1, 1);
            PG8_WAIT_V(8); PG8_WAIT_L(0); PG8_BAR; PG8_MMA(0, 0, At, B0); PG8_MMA(0, 1, At, B1); PG8_BAR; PG8_SCHED;
            PG8_LDA(At, 0, 1); PG8_STAGE_B(PG8_SB(0, 0), b2); PG8_STAGE_B(PG8_SB(0, 1), b2 + hstepB); PG8_STAGE_A(PG8_SA(0, 0), a2, 0);
            PG8_WAIT_V(8); PG8_WAIT_L(0); PG8_BAR; PG8_MMA(1, 0, At, B0); PG8_MMA(1, 1, At, B1); PG8_BAR; PG8_SCHED;
            PG8_LDB(B0, 1, 0); PG8_LDB(B1, 1, 1); PG8_SCHED; PG8_LDA(At, 1, 0); PG8_STAGE_A(PG8_SA(0, 1), a2, 1);
            PG8_WAIT_V(8); PG8_WAIT_L(0); PG8_BAR; PG8_MMA(0, 0, At, B0); PG8_MMA(0, 1, At, B1); PG8_BAR; PG8_SCHED;
            PG8_LDA(At, 1, 1); PG8_STAGE_B(PG8_SB(1, 0), b3); PG8_STAGE_B(PG8_SB(1, 1), b3 + hstepB); PG8_STAGE_A(PG8_SA(1, 0), a3, 0);
            PG8_WAIT_V(8); PG8_WAIT_L(0); PG8_BAR; PG8_MMA(1, 0, At, B0); PG8_MMA(1, 1, At, B1); PG8_BAR; PG8_SCHED;
            } else {
            PG8_LDB(B0, 0, 0); PG8_SCHED; PG8_LDA(At, 0, 0); PG8_STAGE_A(PG8_SA(1, 1), a1, 1);
            PG8_WAIT_L(8); PG8_BAR; PG8_WAIT_L(0); PG8_MMA(0, 0, At, B0); PG8_BAR; PG8_SCHED;
            PG8_LDB(B1, 0, 1); PG8_STAGE_B(PG8_SB(0, 0), b2);
            PG8_BAR; PG8_WAIT_L(0); PG8_MMA(0, 1, At, B1); PG8_BAR;
            PG8_LDA(At, 0, 1); PG8_STAGE_A(PG8_SA(0, 0), a2, 0);
            PG8_BAR; PG8_WAIT_L(0); PG8_MMA(1, 0, At, B0); PG8_BAR; PG8_SCHED;
            PG8_STAGE_B(PG8_SB(0, 1), b2 + hstepB);
            PG8_WAIT_V(6); PG8_BAR; PG8_MMA(1, 1, At, B1); PG8_BAR;
            PG8_LDB(B0, 1, 0); PG8_SCHED; PG8_LDA(At, 1, 0); PG8_STAGE_A(PG8_SA(0, 1), a2, 1);
            PG8_WAIT_L(8); PG8_BAR; PG8_WAIT_L(0); PG8_MMA(0, 0, At, B0); PG8_BAR; PG8_SCHED;
            PG8_LDB(B1, 1, 1); PG8_STAGE_B(PG8_SB(1, 0), b3);
            PG8_BAR; PG8_WAIT_L(0); PG8_MMA(0, 1, At, B1); PG8_BAR;
            PG8_LDA(At, 1, 1); PG8_STAGE_A(PG8_SA(1, 0), a3, 0);
            PG8_BAR; PG8_WAIT_L(0); PG8_MMA(1, 0, At, B0); PG8_BAR; PG8_SCHED;
            PG8_STAGE_B(PG8_SB(1, 1), b3 + hstepB);
            PG8_WAIT_V(6); PG8_BAR; PG8_MMA(1, 1, At, B1); PG8_BAR;
            }
        }
        if constexpr (ALIGN_EPI) { if (wr == 0) PG8_BAR; }
        if constexpr (FP8) asm volatile("s_nop 15\n\ts_nop 7" ::: "memory");
        E(acc, cur, wr, wc, fr, fq);
        if (!has_next) break;
#pragma unroll
        for (int a = 0; a < 2; ++a)
#pragma unroll
            for (int b = 0; b < 2; ++b)
#pragma unroll
                for (int m = 0; m < 4; ++m)
#pragma unroll
                    for (int n = 0; n < 2; ++n) acc[a][b][m][n] = (f32x4){0.f, 0.f, 0.f, 0.f};
        cur = nxt; cA = nA; cB = nB; ++ui;
        if constexpr (ALIGN_EPI) { if (wr == 1) PG8_BAR; }
    }
    PG8_WAIT_V(0);
    if constexpr (!ALIGN_EPI) { if (wr == 0) PG8_BAR; }
    PG8_BAR;
#undef PG8_SA
#undef PG8_SB
#undef PG8_STAGE_A
#undef PG8_STAGE_B
#undef PG8_LDA
#undef PG8_LDB
#undef PG8_MMA
#undef PG8_CAT
#undef PG8_LO
#undef PG8_HI
#undef PG8_WAIT_V
#undef PG8_WAIT_L
#undef PG8_BAR
#undef PG8_SCHED
}
struct SchedDense {
    const char* A; const char* Bt; int lda, ldb; int nM, nN, nwg, G, c;
    __device__ __forceinline__ void init(const void* A_, int lda_, const void* Bt_, int ldb_, int M, int N, int G_, int c_) { A = (const char*)A_; Bt = (const char*)Bt_; lda = lda_ * 2; ldb = ldb_ * 2; nM = M / BM; nN = N / BM; nwg = nM * nN; G = G_; c = c_; }
    __device__ __forceinline__ bool next(int i, Unit& u) const {
        const long L = (long)i * G + c; if (L >= nwg) return false;
        int wgid = (int)L; { const int q = nwg / 8, r = nwg % 8, xcd = wgid % 8, off = wgid / 8; wgid = (xcd < r ? xcd * (q + 1) : r * (q + 1) + (xcd - r) * q) + off; }
        const int nig = 8 * nN, gid = wgid / nig, fm = gid * 8, gsz = (nM - fm) < 8 ? (nM - fm) : 8;
        u.pm = fm + ((wgid % nig) % gsz); u.pn = (wgid % nig) / gsz; u.kind = 0; return true;
    }
    __device__ __forceinline__ const char* a_base(const Unit& u) const { return A + (size_t)u.pm * BM * lda; }
    __device__ __forceinline__ const char* b_base(const Unit& u) const { return Bt + (size_t)u.pn * BM * ldb; }
    __device__ __forceinline__ unsigned a_rowoff(const Unit&, int r) const { return (unsigned)(r * lda); }
};
struct SchedQKV {
    const char* proj; const char* wuq; const char* wukv; int lda, ldb; int G, vcu;
    __device__ __forceinline__ bool next(int i, Unit& u) const {
        const int L = i * G + vcu; if (L >= (T / BM) * 7) return false;
        u.pm = L / 7; const int j = L % 7; u.kind = j < 3 ? 0 : 1; u.pn = j < 3 ? j : j - 3; return true; }
    __device__ __forceinline__ const char* a_base(const Unit& u) const { return proj + ((size_t)u.pm * BM * NPROJ + (u.kind == 1 ? 256 : 0)) * 2; }
    __device__ __forceinline__ const char* b_base(const Unit& u) const { return (u.kind == 1 ? wukv : wuq) + (size_t)u.pn * BM * 256 * 2; }
    __device__ __forceinline__ unsigned a_rowoff(const Unit&, int r) const { return (unsigned)(r * lda); }
};
__device__ __forceinline__ int be_of_vcu(int vcu) { const int x = vcu >> 5, j = vcu & 31; return (j & 15) * 16 + 2 * x + (j >> 4); }
struct SchedUp {
    const char* u2; const int* idx; const char* wgu; int lda, ldb; int G, vcu;
    __device__ __forceinline__ bool next(int i, Unit& u) const { if (i >= 16 || vcu >= 256) return false; u.pm = be_of_vcu(vcu); u.pn = i; u.kind = 0; return true; }
    __device__ __forceinline__ const char* a_base(const Unit& u) const { return u2 + (size_t)(u.pm >> 4) * SEQ * DM; }
    __device__ __forceinline__ const char* b_base(const Unit& u) const { return wgu + ((size_t)(u.pm & 15) * 4096 + (size_t)u.pn * BM) * DM; }
    __device__ __forceinline__ unsigned a_rowoff(const Unit& u, int r) const { return (unsigned)idx[u.pm * CAP + r] * (unsigned)DM; }
};
struct SchedDown {
    const char* h; const char* wd; int lda, ldb; int G, vcu;
    __device__ __forceinline__ bool next(int i, Unit& u) const { if (i >= 4 || vcu >= 256) return false; u.pm = be_of_vcu(vcu); u.pn = i; u.kind = 0; return true; }
    __device__ __forceinline__ const char* a_base(const Unit& u) const { return h + (size_t)u.pm * BM * FF; }
    __device__ __forceinline__ const char* b_base(const Unit& u) const { return wd + ((size_t)(u.pm & 15) * DM + (size_t)u.pn * BM) * FF; }
    __device__ __forceinline__ unsigned a_rowoff(const Unit&, int r) const { return (unsigned)(r * lda); }
};
}


namespace att {
using f32x16 = __attribute__((ext_vector_type(16))) float;
using s16x4  = __attribute__((ext_vector_type(4))) short;
constexpr int SHM_V = 16384, SHM_K = 16384;
constexpr int NSLOT = 3;
constexpr int L_V = 0, L_K = NSLOT * SHM_V, L_WS = L_K + NSLOT * SHM_K, L_KPOS = L_WS + 8 * 64 * 4, L_TAB = L_KPOS + SEQ * 4, L_Q = L_TAB + 272 * 4, L_END = L_Q + 8 * 4096;
#ifndef ATT_SDEPTH
#define ATT_SDEPTH 2
#endif
constexpr float THR2 = 11.5f;
#define ATT_KSWZ(row, colB) ((row) * 256 + ((colB) ^ (((row) & 15) << 4)))
#define ATT_SBAR() __builtin_amdgcn_sched_barrier(0)
__device__ __forceinline__ int crow(int r, int hi) { return (r & 3) + 8 * (r >> 2) + 4 * hi; }
__device__ __forceinline__ unsigned cvtpk(float lo, float hi) { unsigned r; asm volatile("v_cvt_pk_bf16_f32 %0, %1, %2" : "=v"(r) : "v"(lo), "v"(hi)); return r; }
__device__ __forceinline__ int v_st(int k, int c) { const int kk = (k & ~0xC) | ((k & 4) << 1) | ((k & 8) >> 1); return ((kk >> 3) * 4 + (c >> 5)) * 512 + ((kk & 7) * 32 + (c & 31)) * 2; }
__device__ __forceinline__ int v_rd_base(int lane) { return ((lane & 3) << 3) | (((lane >> 2) & 3) << 6) | (((lane >> 4) & 1) << 5) | (((lane >> 5) & 1) << 11); }
constexpr int v_rd_off(int d0, int ks, int half) { return d0 * 512 + ks * 4096 + half * 256; }
typedef short v4i16_t __attribute__((ext_vector_type(4)));
template <int OFF> __device__ __forceinline__ s16x4 tr_read(const LAS char* vp) { return __builtin_bit_cast(s16x4, __builtin_amdgcn_ds_read_tr16_b64_v4i16((LAS v4i16_t*)(vp + OFF))); }
struct VFrag { s16x4 l0, h0, l1, h1, l2, h2, l3, h3; };
template <int OFF> __device__ __forceinline__ s16x4 tr_read_asm(int vb) { s16x4 r; asm volatile("ds_read_b64_tr_b16 %0, %1 offset:%2" : "=v"(r) : "v"(vb), "i"(OFF) : "memory"); return r; }
template <int D0> __device__ __forceinline__ void v_rd(VFrag& f, int vb) {
    f.l0 = tr_read_asm<v_rd_off(D0, 0, 0)>(vb); f.h0 = tr_read_asm<v_rd_off(D0, 0, 1)>(vb); f.l1 = tr_read_asm<v_rd_off(D0, 1, 0)>(vb); f.h1 = tr_read_asm<v_rd_off(D0, 1, 1)>(vb);
    f.l2 = tr_read_asm<v_rd_off(D0, 2, 0)>(vb); f.h2 = tr_read_asm<v_rd_off(D0, 2, 1)>(vb); f.l3 = tr_read_asm<v_rd_off(D0, 3, 0)>(vb); f.h3 = tr_read_asm<v_rd_off(D0, 3, 1)>(vb);
}
#define ATT_VWAIT(n, f) asm volatile("s_waitcnt lgkmcnt(" #n ")" : "+v"(f.l0), "+v"(f.h0), "+v"(f.l1), "+v"(f.h1), "+v"(f.l2), "+v"(f.h2), "+v"(f.l3), "+v"(f.h3) :: "memory")
__device__ __forceinline__ void v_mm(f32x16& od, const VFrag& f, bf16x8 pa0, bf16x8 pa1, bf16x8 pa2, bf16x8 pa3) {
#define ATT_PK(L, H) (bf16x8){L[0], L[1], L[2], L[3], H[0], H[1], H[2], H[3]}
    od = __builtin_amdgcn_mfma_f32_32x32x16_bf16(pa0, ATT_PK(f.l0, f.h0), od, 0, 0, 0);
    od = __builtin_amdgcn_mfma_f32_32x32x16_bf16(pa1, ATT_PK(f.l1, f.h1), od, 0, 0, 0);
    od = __builtin_amdgcn_mfma_f32_32x32x16_bf16(pa2, ATT_PK(f.l2, f.h2), od, 0, 0, 0);
    od = __builtin_amdgcn_mfma_f32_32x32x16_bf16(pa3, ATT_PK(f.l3, f.h3), od, 0, 0, 0);
#undef ATT_PK
}
template <int NDV> __device__ __forceinline__ void pv_all(f32x16 (&o)[NDV], const LAS char* vbp, bf16x8 pa0, bf16x8 pa1, bf16x8 pa2, bf16x8 pa3) {
    const int vb = (int)(unsigned)(size_t)vbp;
    VFrag fa, fb;
    v_rd<0>(fa, vb); v_rd<1>(fb, vb);
    ATT_VWAIT(8, fa); v_mm(o[0], fa, pa0, pa1, pa2, pa3);
    if constexpr (NDV == 4) {
        v_rd<2>(fa, vb); ATT_VWAIT(8, fb); v_mm(o[1], fb, pa0, pa1, pa2, pa3);
        v_rd<3>(fb, vb); ATT_VWAIT(8, fa); v_mm(o[2], fa, pa0, pa1, pa2, pa3);
        ATT_VWAIT(0, fb); v_mm(o[3], fb, pa0, pa1, pa2, pa3);
    } else {
        ATT_VWAIT(0, fb); v_mm(o[1], fb, pa0, pa1, pa2, pa3);
    }
}
template <int NDQ, bool QLDS> __device__ __forceinline__ void qkt(f32x16& p0, f32x16& p1, const LAS char* Kl, const bf16x8 (&qr)[NDQ], const LAS char* ql, int r32, int hi, const f32x16& negm) {
#pragma unroll
    for (int d0 = 0; d0 < NDQ; ++d0) { const int cb = (d0 * 16 + hi * 8) * 2;
        const bf16x8 b0 = *(const LAS bf16x8*)(Kl + ATT_KSWZ(r32, cb)), b1 = *(const LAS bf16x8*)(Kl + ATT_KSWZ(32 + r32, cb));
        bf16x8 q; if constexpr (QLDS) q = *(const LAS bf16x8*)(ql + d0 * 1024); else q = qr[d0];
        if (d0 == 0) { p0 = __builtin_amdgcn_mfma_f32_32x32x16_bf16(b0, q, negm, 0, 0, 0); p1 = __builtin_amdgcn_mfma_f32_32x32x16_bf16(b1, q, negm, 0, 0, 0); }
        else { p0 = __builtin_amdgcn_mfma_f32_32x32x16_bf16(b0, q, p0, 0, 0, 0); p1 = __builtin_amdgcn_mfma_f32_32x32x16_bf16(b1, q, p1, 0, 0, 0); } }
}
#define ATT_MX3(a, b, c) __builtin_fmaxf(__builtin_fmaxf((a), (b)), (c))
template <bool BAND, bool FIRST> __device__ __forceinline__ void partialSM(f32x16& p0, f32x16& p1, float& mhat, f32x16& negm, float ccur, float& alpha, const LAS int* kposl, const LAS float* tabl, int qpos, int hi) {
    if constexpr (BAND) {
#pragma unroll
        for (int r = 0; r < 16; ++r) { const int kc = crow(r, hi); int r0 = kposl[kc] - qpos, r1 = kposl[32 + kc] - qpos;
            r0 = r0 < -128 ? -128 : (r0 > 128 ? 128 : r0); r1 = r1 < -128 ? -128 : (r1 > 128 ? 128 : r1);
            p0[r] += tabl[r0 + 128]; p1[r] += tabl[r1 + 128];
            if ((r & 3) == 3) asm volatile("" ::: "memory"); }
    }
    float a = ATT_MX3(p0[0], p0[1], p1[0]), b = ATT_MX3(p0[2], p0[3], p1[1]); a = ATT_MX3(a, p1[2], p1[3]);
#pragma unroll
    for (int r = 4; r < 16; r += 4) { a = ATT_MX3(a, p0[r], p0[r + 1]); b = ATT_MX3(b, p0[r + 2], p0[r + 3]); a = ATT_MX3(a, p1[r], p1[r + 1]); b = ATT_MX3(b, p1[r + 2], p1[r + 3]); }
    float rm = __builtin_fmaxf(a, b);
    { auto rr = __builtin_amdgcn_permlane32_swap(__float_as_uint(rm), __float_as_uint(rm), false, false); rm = __builtin_fmaxf(__uint_as_float(rr[0]), __uint_as_float(rr[1])); }
    alpha = 1.f;
    if (FIRST || __builtin_expect(__any(rm > THR2), 0)) {
        const float dl = FIRST ? rm : __builtin_fmaxf(rm, 0.f);
        mhat += dl;
#pragma unroll
        for (int r = 0; r < 16; ++r) { p0[r] -= dl; p1[r] -= dl; }
        const float nm = ccur - mhat;
#pragma unroll
        for (int r = 0; r < 16; ++r) negm[r] = nm;
        asm volatile("" : "+v"(negm));
        if (!FIRST) alpha = __builtin_amdgcn_exp2f(-dl);
    }
#pragma unroll
    for (int r = 0; r < 16; ++r) p0[r] = __builtin_amdgcn_exp2f(p0[r]);
}
__device__ __forceinline__ void finishSM(f32x16& p0, f32x16& p1, float alpha, float& l_reg, bf16x8& pa0, bf16x8& pa1, bf16x8& pa2, bf16x8& pa3) {
#pragma unroll
    for (int r = 0; r < 16; ++r) p1[r] = __builtin_amdgcn_exp2f(p1[r]);
    float ps = 0, ps2 = 0;
#pragma unroll
    for (int r = 0; r < 16; ++r) { ps += p0[r]; ps2 += p1[r]; }
    ps += ps2;
    { auto rr = __builtin_amdgcn_permlane32_swap(__float_as_uint(ps), __float_as_uint(ps), false, false); ps = __uint_as_float(rr[0]) + __uint_as_float(rr[1]); }
    l_reg = l_reg * alpha + ps;
#define ATT_PK8(P, BASE, OUT) do { u32x4 w = {cvtpk(P[BASE + 0], P[BASE + 1]), cvtpk(P[BASE + 2], P[BASE + 3]), cvtpk(P[BASE + 4], P[BASE + 5]), cvtpk(P[BASE + 6], P[BASE + 7])}; OUT = __builtin_bit_cast(bf16x8, w); } while (0)
    ATT_PK8(p0, 0, pa0); ATT_PK8(p0, 8, pa1); ATT_PK8(p1, 0, pa2); ATT_PK8(p1, 8, pa3);
#undef ATT_PK8
}
struct Src { const bf16* kp; int kpitch; const bf16* vp; int vpitch; const int* pos; };

template <int NDQ, int NDV, bool DIFF, bool QLDS, int SD>
__device__ __forceinline__ void attn_pass(LAS char* lds, const int tid  , const bf16x8 (&qr)[NDQ], const Src& S, f32x16 (&o)[NDV], float& l_out,
                                          int qpos, int qmn, int qmx, const int* pmm, float cL, float cR) {
    const int wid = __builtin_amdgcn_readfirstlane(tid >> 6), lane = tid & 63, r32 = lane & 31, hi = lane >> 5;
    LAS char* V_lds = lds + L_V; LAS char* K_lds = lds + L_K;
    LAS float* al_l = (LAS float*)(lds + L_WS) + wid * 64 + 32;
    LAS int* kposl = (LAS int*)(lds + L_KPOS); const LAS float* tabl = (const LAS float*)(lds + L_TAB);
    const LAS char* ql = lds + L_Q + wid * 4096 + lane * 16;
    float mhat = 0.f, l_reg = 0.f, ccur = 0.f; f32x16 negm;
#pragma unroll
    for (int r = 0; r < 16; ++r) negm[r] = 0.f;
    asm volatile("" : "+v"(negm));
#pragma unroll
    for (int d = 0; d < NDV; ++d)
#pragma unroll
        for (int r = 0; r < 16; ++r) o[d][r] = 0.f;
    const int sr = tid >> 4, sc = (tid & 15) * 8, vst0 = v_st(sr, sc), vst1 = v_st(32 + sr, sc);
    const LAS char* vb0 = V_lds + v_rd_base(lane);
    struct { bf16x8 vs0, vs1, ks0, ks1; } sr_[SD];
#define ATT_SLOAD(i, k0) do { sr_[i].vs0 = *(const bf16x8*)(S.vp + (size_t)((k0) + sr) * S.vpitch); sr_[i].vs1 = *(const bf16x8*)(S.vp + (size_t)((k0) + 32 + sr) * S.vpitch); \
    sr_[i].ks0 = *(const bf16x8*)(S.kp + (size_t)((k0) + sr) * S.kpitch); sr_[i].ks1 = *(const bf16x8*)(S.kp + (size_t)((k0) + 32 + sr) * S.kpitch); } while (0)
#define ATT_SWRITE(b, i) do { *(LAS bf16x8*)(V_lds + (b) * SHM_V + vst0) = sr_[i].vs0; *(LAS bf16x8*)(V_lds + (b) * SHM_V + vst1) = sr_[i].vs1; const int kc_ = sc * 2; \
    *(LAS bf16x8*)(K_lds + (b) * SHM_K + ATT_KSWZ(sr, kc_)) = sr_[i].ks0; *(LAS bf16x8*)(K_lds + (b) * SHM_K + ATT_KSWZ(32 + sr, kc_)) = sr_[i].ks1; } while (0)
#define ATT_SWAIT() do { if constexpr (SD == 2) asm volatile("s_waitcnt vmcnt(4)" ::: "memory"); else asm volatile("s_waitcnt vmcnt(0)" ::: "memory"); } while (0)
#define ATT_RESC(a) do { if (__any((a) < 1.f)) { if (hi == 0) al_l[r32] = (a); asm volatile("s_waitcnt lgkmcnt(0)" ::: "memory"); \
    _Pragma("unroll") for (int d = 0; d < NDV; ++d) _Pragma("unroll") for (int r = 0; r < 16; ++r) o[d][r] *= al_l[crow(r, hi)]; } } while (0)
#define ATT_CLASS(j, band) do { band = false; if constexpr (DIFF) { float ci_ = 0.f; \
    if ((mask_r >> (j)) & 1u) ci_ = cR; else if ((mask_l >> (j)) & 1u) ci_ = cL; else band = true; \
    if (ci_ != ccur) { ccur = ci_; const float nm_ = ccur - mhat; _Pragma("unroll") for (int r = 0; r < 16; ++r) negm[r] = nm_; asm volatile("" : "+v"(negm)); } } } while (0)
#define ATT_PSM(P0, P1, AL, band, tile, FIRST) do { if (DIFF && (band)) partialSM<true, FIRST>(P0, P1, mhat, negm, ccur, AL, kposl + (tile) * 64, tabl, qpos, hi); else partialSM<false, FIRST>(P0, P1, mhat, negm, ccur, AL, kposl, tabl, qpos, hi); } while (0)
    f32x16 pA0, pA1, pB0, pB1; float alA, alB; bool band; bf16x8 pa0, pa1, pa2, pa3; constexpr int NT = SEQ / 64;
    unsigned mask_r = 0u, mask_l = 0u;
    if constexpr (DIFF) { const int kmn_ = __hip_atomic_load(pmm + 2 * (lane & 31), RLX_AGENT), kmx_ = __hip_atomic_load(pmm + 2 * (lane & 31) + 1, RLX_AGENT);
        mask_r = (unsigned)__ballot(kmn_ - qmx >= 128); mask_l = (unsigned)__ballot(qmn - kmx_ >= 128); }
    constexpr int SE = 0, SO = SD - 1;
    ATT_SLOAD(SE, 0); asm volatile("s_waitcnt vmcnt(0)" ::: "memory"); ATT_SWRITE(0, SE); __syncthreads();
    ATT_CLASS(0, band); qkt<NDQ, QLDS>(pA0, pA1, K_lds, qr, ql, r32, hi, negm); ATT_PSM(pA0, pA1, alA, band, 0, true);
    ATT_SLOAD(SO, 64); if constexpr (SD == 2) ATT_SLOAD(SE, 128);
    ATT_SWAIT(); ATT_SWRITE(1, SO); __syncthreads();
#pragma unroll 1
    for (int j = 1; j + 1 < NT; j += 2) {
        ATT_SBAR(); ATT_CLASS(j, band); qkt<NDQ, QLDS>(pB0, pB1, K_lds + SHM_K, qr, ql, r32, hi, negm);
        finishSM(pA0, pA1, alA, l_reg, pa0, pa1, pa2, pa3); ATT_SBAR();
        ATT_SLOAD(SO, (j + SD) * 64); ATT_SBAR();
        pv_all<NDV>(o, vb0, pa0, pa1, pa2, pa3); ATT_PSM(pB0, pB1, alB, band, j, false);
        __syncthreads(); ATT_SWAIT(); ATT_SWRITE(0, SE);
        ATT_RESC(alB); __syncthreads();
        ATT_SBAR(); ATT_CLASS(j + 1, band); qkt<NDQ, QLDS>(pA0, pA1, K_lds, qr, ql, r32, hi, negm);
        finishSM(pB0, pB1, alB, l_reg, pa0, pa1, pa2, pa3); ATT_SBAR();
        if (SD == 1 || j + 3 < NT) ATT_SLOAD(SE, (j + 1 + SD) * 64); ATT_SBAR();
        pv_all<NDV>(o, vb0 + SHM_V, pa0, pa1, pa2, pa3); ATT_PSM(pA0, pA1, alA, band, j + 1, false);
        __syncthreads(); ATT_SWAIT(); ATT_SWRITE(1, SO);
        ATT_RESC(alA); __syncthreads();
    }
    ATT_SBAR(); ATT_CLASS(NT - 1, band); qkt<NDQ, QLDS>(pB0, pB1, K_lds + SHM_K, qr, ql, r32, hi, negm);
    finishSM(pA0, pA1, alA, l_reg, pa0, pa1, pa2, pa3); ATT_SBAR();
    pv_all<NDV>(o, vb0, pa0, pa1, pa2, pa3); ATT_PSM(pB0, pB1, alB, band, NT - 1, false);
    __syncthreads(); ATT_RESC(alB);
    finishSM(pB0, pB1, alB, l_reg, pa0, pa1, pa2, pa3); ATT_SBAR();
    pv_all<NDV>(o, vb0 + SHM_V, pa0, pa1, pa2, pa3);
    l_out = l_reg;
    __syncthreads();
#undef ATT_SLOAD
#undef ATT_SWRITE
#undef ATT_SWAIT
#undef ATT_RESC
#undef ATT_CLASS
#undef ATT_PSM
}

struct DmaSrc { const bf16* k0; const bf16* k1; const bf16* v0; const bf16* v1; int kp0, kp1, vp; };
template <int NDQ, int NDV, bool DIFF>
__device__ __forceinline__ void attn_pass_dma(LAS char* lds, const int tid, const bf16x8 (&qr)[NDQ], const DmaSrc& S, f32x16 (&o)[NDV], float& l_out,
                                              int qpos, int qmn, int qmx, const int* pmm, float cL, float cR) {
    const int wid = __builtin_amdgcn_readfirstlane(tid >> 6), lane = tid & 63, r32 = lane & 31, hi = lane >> 5;
    LAS char* V_lds = lds + L_V; LAS char* K_lds = lds + L_K;
    LAS float* al_l = (LAS float*)(lds + L_WS) + wid * 64 + 32;
    LAS int* kposl = (LAS int*)(lds + L_KPOS); const LAS float* tabl = (const LAS float*)(lds + L_TAB);
    float mhat = 0.f, l_reg = 0.f, ccur = 0.f; f32x16 negm;
#pragma unroll
    for (int r = 0; r < 16; ++r) negm[r] = 0.f;
#pragma unroll
    for (int d = 0; d < NDV; ++d)
#pragma unroll
        for (int r = 0; r < 16; ++r) o[d][r] = 0.f;
    const LAS char* vb0 = V_lds + v_rd_base(lane);
    LAS char* kdst = K_lds + wid * 2048;
    LAS char* vdst = V_lds + wid * 2048;
#define DMA_K(t, so) do { __builtin_amdgcn_global_load_lds((const unsigned*)(S.k0 + (size_t)(t) * 64 * S.kp0), (LAS unsigned*)(kdst + (so)), 16, 0, 0); \
                          __builtin_amdgcn_global_load_lds((const unsigned*)(S.k1 + (size_t)(t) * 64 * S.kp1), (LAS unsigned*)(kdst + (so) + 1024), 16, 0, 0); } while (0)
#define DMA_V(t, so) do { __builtin_amdgcn_global_load_lds((const unsigned*)(S.v0 + (size_t)(t) * 64 * S.vp), (LAS unsigned*)(vdst + (so)), 16, 0, 0); \
                          if constexpr (NDV == 4) __builtin_amdgcn_global_load_lds((const unsigned*)(S.v1 + (size_t)(t) * 64 * S.vp), (LAS unsigned*)(vdst + (so) + 1024), 16, 0, 0); } while (0)
#define DMA_WAIT_BAR(n) asm volatile("s_waitcnt vmcnt(" #n ") lgkmcnt(0)\n\ts_barrier" ::: "memory")
#define ATT_RESC(a) do { if (__any((a) < 1.f)) { if (hi == 0) al_l[r32] = (a); asm volatile("s_waitcnt lgkmcnt(0)" ::: "memory"); \
    _Pragma("unroll") for (int d = 0; d < NDV; ++d) _Pragma("unroll") for (int r = 0; r < 16; ++r) o[d][r] *= al_l[crow(r, hi)]; } } while (0)
#define ATT_CLASS(j, band) do { band = false; if constexpr (DIFF) { float ci_ = 0.f; \
    if ((mask_r >> (j)) & 1u) ci_ = cR; else if ((mask_l >> (j)) & 1u) ci_ = cL; else band = true; \
    if (ci_ != ccur) { ccur = ci_; const float nm_ = ccur - mhat; _Pragma("unroll") for (int r = 0; r < 16; ++r) negm[r] = nm_; asm volatile("" : "+v"(negm)); } } } while (0)
#define ATT_PSM(P0, P1, AL, band, tile, FIRST) do { if (DIFF && (band)) partialSM<true, FIRST>(P0, P1, mhat, negm, ccur, AL, kposl + (tile) * 64, tabl, qpos, hi); else partialSM<false, FIRST>(P0, P1, mhat, negm, ccur, AL, kposl, tabl, qpos, hi); } while (0)
    f32x16 pA0, pA1, pB0, pB1; float alA, alB; bool band; bf16x8 pa0, pa1, pa2, pa3; constexpr int NT = SEQ / 64;
    unsigned mask_r = 0u, mask_l = 0u;
    if constexpr (DIFF) { const int kmn_ = __hip_atomic_load(pmm + 2 * (lane & 31), RLX_AGENT), kmx_ = __hip_atomic_load(pmm + 2 * (lane & 31) + 1, RLX_AGENT);
        mask_r = (unsigned)__ballot(kmn_ - qmx >= 128); mask_l = (unsigned)__ballot(qmn - kmx_ >= 128); }
    asm volatile("s_waitcnt vmcnt(0)" ::: "memory");
    int s0 = 0, s1 = SHM_K, s2 = 2 * SHM_K;
#define ATT_ROT() do { const int t_ = s0; s0 = s1; s1 = s2; s2 = t_; } while (0)
    DMA_K(0, 0); DMA_V(0, 0); DMA_K(1, SHM_K);
    DMA_WAIT_BAR(0);
    DMA_K(2, s2); DMA_V(1, s1);
    ATT_CLASS(0, band); qkt<NDQ, false>(pA0, pA1, K_lds + s0, qr, nullptr, r32, hi, negm); ATT_PSM(pA0, pA1, alA, band, 0, true);
    if constexpr (NDV == 4) DMA_WAIT_BAR(4); else DMA_WAIT_BAR(3);
    ATT_ROT();
    int sv = 0;
#define ATT_STEP(C0, C1, ALC, P0, P1, ALP, j, HASK, HASV, NW) do { \
        if (HASK) DMA_K((j) + 2, s2); \
        if (HASV) DMA_V((j) + 1, s1); \
        ATT_SBAR(); ATT_CLASS(j, band); qkt<NDQ, false>(C0, C1, K_lds + s0, qr, nullptr, r32, hi, negm); \
        finishSM(P0, P1, ALP, l_reg, pa0, pa1, pa2, pa3); ATT_SBAR(); \
        pv_all<NDV>(o, vb0 + sv, pa0, pa1, pa2, pa3); ATT_PSM(C0, C1, ALC, band, j, false); \
        ATT_RESC(ALC); \
        DMA_WAIT_BAR(NW); sv = s0; ATT_ROT(); } while (0)
    constexpr int NW_ = (NDV == 4) ? 4 : 3;
#pragma unroll 1
    for (int j = 1; j + 3 < NT; j += 2) {
        if constexpr (NDV == 4) { ATT_STEP(pB0, pB1, alB, pA0, pA1, alA, j, true, true, 4); ATT_STEP(pA0, pA1, alA, pB0, pB1, alB, j + 1, true, true, 4); }
        else { ATT_STEP(pB0, pB1, alB, pA0, pA1, alA, j, true, true, 3); ATT_STEP(pA0, pA1, alA, pB0, pB1, alB, j + 1, true, true, 3); }
    }
    ATT_STEP(pB0, pB1, alB, pA0, pA1, alA, NT - 3, true, true, 0);
    ATT_STEP(pA0, pA1, alA, pB0, pB1, alB, NT - 2, false, true, 0);
    ATT_STEP(pB0, pB1, alB, pA0, pA1, alA, NT - 1, false, false, 0);
    finishSM(pB0, pB1, alB, l_reg, pa0, pa1, pa2, pa3); ATT_SBAR();
    pv_all<NDV>(o, vb0 + sv, pa0, pa1, pa2, pa3);
    l_out = l_reg;
    (void)NW_;
    __syncthreads();
#undef DMA_K
#undef DMA_V
#undef DMA_WAIT_BAR
#undef ATT_RESC
#undef ATT_CLASS
#undef ATT_PSM
#undef ATT_STEP
#undef ATT_ROT
}
__device__ __forceinline__ void row_recip(LAS float* li_l, float l_reg, int r32, int hi, float (&rli)[16]) {
    if (hi == 0) li_l[r32] = l_reg; asm volatile("s_waitcnt lgkmcnt(0)" ::: "memory");
#pragma unroll
    for (int r = 0; r < 16; ++r) rli[r] = __builtin_amdgcn_rcpf(li_l[crow(r, hi)]);
    asm volatile("s_waitcnt lgkmcnt(0)" ::: "memory");
}
__device__ __forceinline__ void mla_unit(const Ctx& C, int b, int h, int qb) {
    LAS char* lds = (LAS char*)C.lds;
    int tid = threadIdx.x; asm volatile("" : "+v"(tid));
    const int wid = __builtin_amdgcn_readfirstlane(tid >> 6), lane = tid & 63, r32 = lane & 31, hi = lane >> 5;
    const int t0 = b * SEQ + qb * 256 + wid * 32;
    bf16x8 qr[6];
    const bf16* qrow = C.Q + (size_t)(t0 + r32) * 768;
#pragma unroll
    for (int d0 = 0; d0 < 4; ++d0) qr[d0] = *(const bf16x8*)(qrow + h * 64 + d0 * 16 + hi * 8);
#pragma unroll
    for (int d0 = 4; d0 < 6; ++d0) { const int fqi = 2 * (d0 - 4) + hi; const u32x4 w = *(const u32x4*)(qrow + 512 + h * 32 + (d0 - 4) * 16 + hi * 8);
        const f32x4 c4 = *(const f32x4*)(C.CS + (size_t)(t0 + r32) * 16 + 4 * fqi), s4 = *(const f32x4*)(C.SN + (size_t)(t0 + r32) * 16 + 4 * fqi);
        const float t1[4] = {bflo(w.x), bfhi(w.x), bflo(w.y), bfhi(w.y)}, t2[4] = {bflo(w.z), bfhi(w.z), bflo(w.w), bfhi(w.w)};
        float a[4], bb[4];
#pragma unroll
        for (int i = 0; i < 4; ++i) { a[i] = t1[i] * c4[i] - t2[i] * s4[i]; bb[i] = t1[i] * s4[i] + t2[i] * c4[i]; }
        u32x4 ww; ww.x = pk2(a[0], a[1]); ww.y = pk2(a[2], a[3]); ww.z = pk2(bb[0], bb[1]); ww.w = pk2(bb[2], bb[3]); qr[d0] = __builtin_bit_cast(bf16x8, ww); }
    DmaSrc S;
    {   const size_t kb = (size_t)b * SEQ;
#pragma unroll
        for (int i = 0; i < 2; ++i) { const int row = 8 * wid + 4 * i + (lane >> 4), c = (lane & 15) ^ (row & 15); const bf16* p; int pitch;
            if (c < 8) { p = C.KV + (kb + row) * 1024 + h * 64 + 8 * c; pitch = 1024; } else { p = C.KR + (kb + row) * 32 + 8 * (c & 3); pitch = 32; }
            if (i == 0) { S.k0 = p; S.kp0 = pitch; } else { S.k1 = p; S.kp1 = pitch; } }
        const int rin = (lane >> 2) & 7, key = 16 * (wid >> 1) + 8 * (rin >> 2) + 4 * (wid & 1) + (rin & 3);
        S.v0 = C.KV + (kb + key) * 1024 + 512 + h * 64 + 32 * (lane >> 5) + 8 * (lane & 3); S.v1 = S.v0; S.vp = 1024; }
    f32x16 o[2]; float l;
    attn_pass_dma<6, 2, false>(lds, tid, qr, S, o, l, 0, 0, 0, nullptr, 0.f, 0.f);
    float rli[16]; row_recip((LAS float*)(lds + L_WS) + wid * 64, l, r32, hi, rli);
    bf16* ao = C.AO + (size_t)t0 * DM + h * 64; const int loff = hi * 4 * DM + r32;
#pragma unroll
    for (int r = 0; r < 16; ++r) {
#pragma unroll
        for (int d0 = 0; d0 < 2; ++d0) ao[crow(r, 0) * DM + d0 * 32 + loff] = (bf16)f2bf(o[d0][r] * rli[r]); }
}
__device__ __forceinline__ void diff_unit(const Ctx& C, int b, int h, int qb) {
    LAS char* lds = (LAS char*)C.lds;
    int tid = threadIdx.x; asm volatile("" : "+v"(tid));
    const int wid = __builtin_amdgcn_readfirstlane(tid >> 6);
    const int t0 = b * SEQ + qb * 256 + wid * 32;
    LAS float* tabl = (LAS float*)(lds + L_TAB);
    if (tid < 257) tabl[tid] = __hip_atomic_load(C.MISC + 64 + h * 260 + tid, RLX_AGENT);
    { LAS int* kposl = (LAS int*)(lds + L_KPOS);
#pragma unroll
      for (int i = 0; i < SEQ / NTHREADS; ++i) kposl[tid + i * NTHREADS] = C.pos[b * SEQ + tid + i * NTHREADS]; }
    const float cL = __hip_atomic_load(C.MISC + 64 + h * 260 + 0, RLX_AGENT), cR = __hip_atomic_load(C.MISC + 64 + h * 260 + 256, RLX_AGENT);
    const float lam = __hip_atomic_load(C.MISC, RLX_AGENT);
    const int qpos = C.pos[t0 + (tid & 31)]; int qmn = qpos, qmx = qpos;
#pragma unroll
    for (int o_ = 1; o_ < 64; o_ <<= 1) { const int a = __shfl_xor(qmn, o_), c = __shfl_xor(qmx, o_); qmn = a < qmn ? a : qmn; qmx = c > qmx ? c : qmx; }
    qmn = __builtin_amdgcn_readfirstlane(qmn); qmx = __builtin_amdgcn_readfirstlane(qmx);
    __syncthreads();
    float* scr = C.out + (size_t)t0 * DM + h * 128;
    const int* pmm = C.PMM + b * 64;
#pragma unroll
    for (int m = 0; m < 2; ++m) {
        f32x16 o[4]; float l;
        {
            int tl = threadIdx.x; asm volatile("" : "+v"(tl));
            const int lane = tl & 63, r32 = lane & 31, hi = lane >> 5, sc = (tl & 15) * 8;
            bf16x8 qr[4];
            const bf16* qrow = C.PROJ + (size_t)(t0 + r32) * NPROJ + 512 + (h * 2 + m) * 64;
#pragma unroll
            for (int d0 = 0; d0 < 4; ++d0) qr[d0] = *(const bf16x8*)(qrow + d0 * 16 + hi * 8);
            DmaSrc S;
            {   const size_t kb = (size_t)b * SEQ;
#pragma unroll
                for (int i = 0; i < 2; ++i) { const int row = 8 * wid + 4 * i + (lane >> 4), c = (lane & 15) ^ (row & 15);
                    const bf16* p = C.PROJ + (kb + row) * NPROJ + 1024 + (h * 2 + m) * 64 + 8 * (c & 7);
                    if (i == 0) { S.k0 = p; S.kp0 = NPROJ; } else { S.k1 = p; S.kp1 = NPROJ; } }
                const int rin = (lane >> 2) & 7, key = 16 * (wid >> 1) + 8 * (rin >> 2) + 4 * (wid & 1) + (rin & 3);
                S.v0 = C.PROJ + (kb + key) * NPROJ + 1536 + h * 128 + 32 * (lane >> 5) + 8 * (lane & 3); S.v1 = S.v0 + 64; S.vp = NPROJ; }
            attn_pass_dma<4, 4, true>(lds, tl, qr, S, o, l, qpos, qmn, qmx, pmm, cL, cR);
        }
        int te = threadIdx.x; asm volatile("" : "+v"(te));
        const int r32 = te & 31, hi = (te >> 5) & 1, loff = hi * 4 * DM + r32;
        float rli[16]; row_recip((LAS float*)(lds + L_WS) + wid * 64, l, r32, hi, rli);
        if (m == 0) {
#pragma unroll
            for (int r = 0; r < 16; ++r) {
#pragma unroll
                for (int d0 = 0; d0 < 4; ++d0) scr[crow(r, 0) * DM + d0 * 32 + loff] = o[d0][r] * rli[r]; }
        } else {
#pragma unroll
            for (int r = 0; r < 16; ++r) { float s = 0.f;
#pragma unroll
                for (int d0 = 0; d0 < 4; ++d0) { const float a = scr[crow(r, 0) * DM + d0 * 32 + loff] - lam * (o[d0][r] * rli[r]); o[d0][r] = a; s += a * a; }
                s += __shfl_xor(s, 1); s += __shfl_xor(s, 2); s += __shfl_xor(s, 4); s += __shfl_xor(s, 8); s += __shfl_xor(s, 16);
                const float f = (1.0f - LAMBDA_INIT) / sqrtf(s * (1.f / 128.f) + RMS_EPS);
#pragma unroll
                for (int d0 = 0; d0 < 4; ++d0) o[d0][r] *= f;
                asm volatile("" : "+v"(o[0][r]), "+v"(o[1][r]), "+v"(o[2][r]), "+v"(o[3][r]));
                if (r & 1) asm volatile("" ::: "memory"); }
            bf16* ao = C.AO + (size_t)t0 * DM + 512 + h * 128;
#pragma unroll
            for (int d0 = 0; d0 < 4; ++d0) { const float g = C.subln[d0 * 32 + r32];
#pragma unroll
                for (int r = 0; r < 16; ++r) ao[crow(r, 0) * DM + d0 * 32 + loff] = (bf16)f2bf(o[d0][r] * g); }
        }
    }
}
__device__ __forceinline__ void attn_phase(const Ctx& C) {
    const int slot = C.vcu % 7; int nu = 0;
    if (slot == 0) { wconv_slice(C, 0, 1); __syncthreads(); }
#ifndef ATT_SKIP_DIFF
#pragma unroll 1
    for (int U = C.vcu; U < BATCH * 4 * 8; U += C.G) { diff_unit(C, U >> 5, (U >> 3) & 3, U & 7); ++nu; if (nu == slot) { __syncthreads(); wconv_slice(C, 0, 1); __syncthreads(); } }
#endif
#ifndef ATT_SKIP_MLA
#pragma unroll 1
    for (int U = C.vcu; U < BATCH * 8 * 8; U += C.G) { mla_unit(C, U >> 6, (U >> 3) & 7, U & 7); ++nu; if (nu == slot) { __syncthreads(); wconv_slice(C, 0, 1); __syncthreads(); } }
#endif
    if (slot > nu) { __syncthreads(); wconv_slice(C, 0, 1); __syncthreads(); }
}
}

struct ARowLd { const bf16* A; int lda; __device__ __forceinline__ const bf16* operator()(int m) const { return A + (size_t)m * lda; } };
struct ARowGather { const bf16* A; const int* idx; __device__ __forceinline__ const bf16* operator()(int m) const { const int be = m >> 8; return A + ((size_t)(be >> 4) * SEQ + idx[m]) * DM; } };
struct BRowLd { const bf16* B; int ldb; __device__ __forceinline__ const bf16* operator()(int n, int) const { return B + (size_t)n * ldb; } };
struct BRowExp { const bf16* B; int rows_per_e, ldb, e; __device__ __forceinline__ const bf16* operator()(int n, int) const { return B + ((size_t)e * rows_per_e + n) * ldb; } };
struct BRowGU { const bf16* B; int e; __device__ __forceinline__ const bf16* operator()(int n, int up) const { return B + ((size_t)e * 4096 + (n >> 7) * 256 + (n & 127) + up * 128) * DM; } };

__global__ void __launch_bounds__(NTHREADS) nk_proj(Args a) {
    __shared__ __attribute__((aligned(16))) float lds[48 * 132]; Ctx C; ctx_init(C, a);
    for (int u = blockIdx.x; u < (T / 128) * (NPROJ / 128); u += gridDim.x) { const int pm = u / (NPROJ / 128), pn = u % (NPROJ / 128);
        naive_gemm_tile<false>(pm * 128, pn * 128, DM, ARowLd{C.U, DM}, BRowLd{C.WIN, DM}, FPlain{C.PROJ, NPROJ}, 0, lds); __syncthreads(); }
}
__global__ void __launch_bounds__(NTHREADS) nk_qkv(Args a) {
    __shared__ __attribute__((aligned(16))) float lds[48 * 132]; Ctx C; ctx_init(C, a);
    const FRowScale f0{C.Q, 768, C.RINVQ}, f1{C.KV, 1024, C.RINVKV};
    for (int u = blockIdx.x; u < (T / 128) * 14; u += gridDim.x) { const int pm = u / 14, j = u % 14;
        if (j < 6) naive_gemm_tile<false>(pm * 128, j * 128, 256, ARowLd{C.PROJ, NPROJ}, BRowLd{C.WUQ, 256}, f0, 0, lds);
        else naive_gemm_tile<false>(pm * 128, (j - 6) * 128, 256, ARowLd{C.PROJ + 256, NPROJ}, BRowLd{C.WUKV, 256}, f1, 1, lds);
        __syncthreads(); }
}
__global__ void __launch_bounds__(NTHREADS) nk_out(Args a) {
    __shared__ __attribute__((aligned(16))) float lds[48 * 132]; Ctx C; ctx_init(C, a);
    for (int u = blockIdx.x; u < (T / 128) * 8; u += gridDim.x) { const int pm = u / 8, pn = u % 8;
        naive_gemm_tile<false>(pm * 128, pn * 128, DM, ARowLd{C.AO, DM}, BRowLd{C.WOUT, DM}, FY{C.Y, C.x, C.MOD}, 0, lds); __syncthreads(); }
}
template <int DQK, int DV, bool DIFF>
__device__ __forceinline__ void naive_attn_block(const Ctx& C, int b, int h, int m, int qb, float* lds) {
    float* Ks = lds; float* Vs = lds + 32 * DQK;
    const int tid = threadIdx.x, t = b * SEQ + qb * 256 + tid;
    float q[DQK], o[DV];
#pragma unroll
    for (int d = 0; d < DV; ++d) o[d] = 0.f;
    if (DIFF) {
#pragma unroll
        for (int d = 0; d < DQK; ++d) q[d] = bf2f(C.PROJ[(size_t)t * NPROJ + 512 + (h * 2 + m) * 64 + d]);
    } else {
#pragma unroll
        for (int d = 0; d < 64; ++d) q[d] = bf2f(C.Q[(size_t)t * 768 + h * 64 + d]);
#pragma unroll
        for (int d = 0; d < 32; ++d) { const int fq = d >> 3, n = (d >> 2) & 1, i = d & 3; const float cs = C.CS[(size_t)t * 16 + 4 * fq + i], sn = C.SN[(size_t)t * 16 + 4 * fq + i];
            const float t1 = bf2f(C.Q[(size_t)t * 768 + 512 + h * 32 + (d & ~4)]), t2 = bf2f(C.Q[(size_t)t * 768 + 512 + h * 32 + (d | 4)]);
            q[64 + d] = bf2f((bf16)f2bf(n == 0 ? t1 * cs - t2 * sn : t1 * sn + t2 * cs)); }
    }
    const int qpos = C.pos[t]; const float* btab = C.MISC + 64 + h * 260 + 128;
    float mx = -1e30f, l = 0.f;
    for (int k0 = 0; k0 < SEQ; k0 += 32) {
        __syncthreads();
        for (int i = tid; i < 32 * DQK; i += 256) { const int kk = i / DQK, d = i % DQK; const size_t kt = (size_t)(b * SEQ + k0 + kk); float v;
            if (DIFF) v = bf2f(C.PROJ[kt * NPROJ + 1024 + (h * 2 + m) * 64 + d]);
            else v = d < 64 ? bf2f(C.KV[kt * 1024 + h * 64 + d]) : bf2f(C.KR[kt * 32 + (d - 64)]);
            Ks[i] = v; }
        for (int i = tid; i < 32 * DV; i += 256) { const int kk = i / DV, d = i % DV; const size_t kt = (size_t)(b * SEQ + k0 + kk);
            Vs[i] = DIFF ? bf2f(C.PROJ[kt * NPROJ + 1536 + h * 128 + d]) : bf2f(C.KV[kt * 1024 + 512 + h * 64 + d]); }
        __syncthreads();
        for (int kk = 0; kk < 32; ++kk) {
            float s = 0.f;
#pragma unroll
            for (int d = 0; d < DQK; d += 4) { const f32x4 kv = *(const f32x4*)(Ks + kk * DQK + d); s += q[d] * kv[0] + q[d + 1] * kv[1] + q[d + 2] * kv[2] + q[d + 3] * kv[3]; }
            if (DIFF) { int rel = C.pos[b * SEQ + k0 + kk] - qpos; rel = rel < -128 ? -128 : (rel > 128 ? 128 : rel); s += btab[rel]; }
            const float mn = fmaxf(mx, s), al = __builtin_amdgcn_exp2f(mx - mn), p = __builtin_amdgcn_exp2f(s - mn);
            mx = mn; l = l * al + p;
#pragma unroll
            for (int d = 0; d < DV; d += 4) { const f32x4 vv = *(const f32x4*)(Vs + kk * DV + d); o[d] = o[d] * al + p * vv[0]; o[d + 1] = o[d + 1] * al + p * vv[1]; o[d + 2] = o[d + 2] * al + p * vv[2]; o[d + 3] = o[d + 3] * al + p * vv[3]; }
        }
    }
    const float rl = 1.0f / l;
    if (DIFF) { float* od = (float*)(C.ws + WS_ODIFF) + ((size_t)m * T + t) * 512 + h * 128;
#pragma unroll
        for (int d = 0; d < DV; d += 4) *(f32x4*)(od + d) = (f32x4){o[d] * rl, o[d + 1] * rl, o[d + 2] * rl, o[d + 3] * rl};
    } else { bf16* ao = C.AO + (size_t)t * DM + h * 64;
#pragma unroll
        for (int d = 0; d < DV; d += 8) { float v[8];
#pragma unroll
            for (int i = 0; i < 8; ++i) v[i] = o[d + i] * rl;
            store8_bf16(ao + d, v); } }
}
__global__ void __launch_bounds__(256) nk_attn_mla(Args a) {
    __shared__ __attribute__((aligned(16))) float lds[32 * 96 + 32 * 64]; Ctx C; ctx_init(C, a);
    const int u = blockIdx.x; naive_attn_block<96, 64, false>(C, u >> 6, (u >> 3) & 7, 0, u & 7, lds);
}
__global__ void __launch_bounds__(256) nk_attn_diff(Args a) {
    __shared__ __attribute__((aligned(16))) float lds[32 * 64 + 32 * 128]; Ctx C; ctx_init(C, a);
    const int u = blockIdx.x; naive_attn_block<64, 128, true>(C, u >> 6, (u >> 4) & 3, (u >> 3) & 1, u & 7, lds);
}
__global__ void __launch_bounds__(256) nk_attn_diff_combine(Args a) {
    Ctx C; ctx_init(C, a); const int lane = threadIdx.x & 63; const float lam = C.MISC[0];
    const float* od = (const float*)(C.ws + WS_ODIFF);
    for (int w = blockIdx.x * 4 + (threadIdx.x >> 6); w < T * 4; w += gridDim.x * 4) { const int t = w >> 2, h = w & 3;
        const f32x2 o0 = *(const f32x2*)(od + (size_t)t * 512 + h * 128 + 2 * lane), o1 = *(const f32x2*)(od + ((size_t)T + t) * 512 + h * 128 + 2 * lane);
        const float a0 = o0[0] - lam * o1[0], a1 = o0[1] - lam * o1[1];
        const float r = 1.0f / sqrtf(wave_sum(a0 * a0 + a1 * a1) * (1.f / 128.f) + RMS_EPS);
        const float v0 = a0 * r * C.subln[2 * lane] * (1.f - LAMBDA_INIT), v1 = a1 * r * C.subln[2 * lane + 1] * (1.f - LAMBDA_INIT);
        *(unsigned*)(C.AO + (size_t)t * DM + 512 + h * 128 + 2 * lane) = pk2(v0, v1); }
}

constexpr int NPHASE = 12;
__global__ void __launch_bounds__(NTHREADS, 2) mega(Args args) {
    extern __shared__ __attribute__((aligned(16))) unsigned char lds[];
    Ctx C; ctx_init(C, args);
    C.lds = (LAS unsigned char*)lds; C.lds_g = lds;
    C.wave = __builtin_amdgcn_readfirstlane((int)threadIdx.x >> 6);
    C.G = gridDim.x; { const int bx = blockIdx.x; C.vcu = (C.G % 8 == 0) ? (bx % 8) * (C.G / 8) + bx / 8 : bx; }
    volatile LAS unsigned* MISCL = (volatile LAS unsigned*)(C.lds + MISC_OFF);
    for (int u = threadIdx.x; u < (LDS_BYTES - LDSCTL_OFF) / 4; u += NTHREADS) ((LAS unsigned*)(C.lds + LDSCTL_OFF))[u] = 0u;
    __syncthreads();
    const int lo = args.ph_lo, hi = args.ph_hi;
    XcdBarrier bar; bar.bar = (unsigned*)(args.ws + WS_CTL) + CW_BAR + args.li * XCD_BAR_WORDS; bar.x = 0; bar.st = nullptr;
    if (hi - lo > 1) bar = xcd_barrier_post((unsigned*)(args.ws + WS_CTL) + CW_BAR + args.li * XCD_BAR_WORDS, MISCL + 8);
#ifndef CFG_DISABLE
#define CFG_DISABLE 0
#endif
#define IN(k) (!((CFG_DISABLE >> (k)) & 1) && lo <= (k) && (k) < hi)
#define SEAM(k) do { if (IN(k) && IN((k) + 1)) xcd_barrier(bar); } while (0)
    if (IN(0)) { phase_prep(C); } SEAM(0);
    if (IN(1)) { phase_u(C); } SEAM(1);
    if (IN(2)) {
        pg8::SchedDense S; S.init(C.U, DM, C.WIN, DM, T, NPROJ, C.G, (int)blockIdx.x);
        pg8::EpiRow8<FPlain> E{FPlain{C.PROJ, NPROJ}};
        pg8::gemm_phase(C.lds, DM * 2, S, E);
    } SEAM(2);
    if (IN(3)) { phase_fix1(C); } SEAM(3);
    if (IN(4)) {
        pg8::SchedQKV S{(const char*)C.PROJ, (const char*)C.WUQ, (const char*)C.WUKV, NPROJ * 2, 256 * 2, C.G, C.vcu};
        pg8::EpiQKV E{FRowScale{C.Q, 768, C.RINVQ}, FRowScale{C.KV, 1024, C.RINVKV}};
        pg8::gemm_phase(C.lds, 256 * 2, S, E);
    } SEAM(4);
    if (IN(5)) { att::attn_phase(C); } SEAM(5);
    if (IN(6)) {
        pg8::SchedDense S; S.init(C.AO, DM, C.WOUT, DM, T, DM, C.G, (int)blockIdx.x);
        pg8::EpiRow8<FY> E{FY{C.Y, C.x, C.MOD}};
        pg8::gemm_phase(C.lds, DM * 2, S, E);
    } SEAM(6);
    if (IN(7)) { phase_ln1(C); } SEAM(7);
    if (IN(8)) { phase_topk(C); } SEAM(8);
    if (IN(9)) {
        pg8::SchedUp S{(const char*)C.U2, C.IDX, (const char*)C.WGU, DM, DM, C.G, C.vcu};
        pg8::EpiPair8<FSwi> E{FSwi{(unsigned char*)C.HLO}};
        pg8::gemm_phase<pg8::EpiPair8<FSwi>, pg8::SchedUp, true>(C.lds, DM, S, E);
    } SEAM(9);
    if (IN(10)) {
        pg8::SchedDown S{(const char*)C.HLO, (const char*)C.WD, FF, FF, C.G, C.vcu};
        pg8::EpiRow8<FGate> E{FGate{C.YE, C.GATE}};
        pg8::gemm_phase<pg8::EpiRow8<FGate>, pg8::SchedDown, true>(C.lds, FF, S, E);
    } SEAM(10);
    if (IN(11)) { phase_final(C); }
#undef IN
#undef SEAM
}

#ifndef CFG_SPLIT
#define CFG_SPLIT 0
#endif
static void launch_mega(const Args& base, int lo, int hi, int li, int grid, hipStream_t stream) {
    Args a = base; a.ph_lo = lo; a.ph_hi = hi; a.li = li;
    hipLaunchKernelGGL(mega, dim3(grid), dim3(NTHREADS), LDS_BYTES, stream, a);
}
static bool phase_in_mega(int p) { const bool has_naive = (p == 2 || p == 4 || p == 5 || p == 6 || p == 9 || p == 10); return has_naive ? (((unsigned)CFG_OPT_MASK >> p) & 1u) != 0u : true; }
extern "C" void kernel_launch(void* const* d_in, const int* in_sizes, int n_in, void* d_out, int out_size, void* d_ws, size_t ws_size, hipStream_t stream) {
    static int grid = 0;
    if (grid == 0) {
        if (n_in != 25 || out_size != T * DM || ws_size < WS_END) { fprintf(stderr, "kernel_launch: unexpected shapes (n_in %d out %d ws %zu, need %zu)\n", n_in, out_size, ws_size, (size_t)WS_END); grid = -1; return; }
        int dev = 0, cus = 0;
        if (hipGetDevice(&dev) != hipSuccess || hipDeviceGetAttribute(&cus, hipDeviceAttributeMultiprocessorCount, dev) != hipSuccess) { grid = -1; return; }
        if (hipFuncSetAttribute((const void*)mega, hipFuncAttributeMaxDynamicSharedMemorySize, LDS_BYTES) != hipSuccess) { fprintf(stderr, "kernel_launch: hipFuncSetAttribute failed\n"); grid = -1; return; }
        int per_cu = 0; (void)hipOccupancyMaxActiveBlocksPerMultiprocessor(&per_cu, (const void*)mega, NTHREADS, LDS_BYTES); (void)hipGetLastError();
        if (per_cu < 1) fprintf(stderr, "kernel_launch: occupancy query reports %d\n", per_cu);
        grid = cus;
        if (grid != 256) fprintf(stderr, "kernel_launch: %d CUs (built for 256)\n", grid);
    }
    if (grid < 0) return;
    (void)hipMemsetAsync((char*)d_ws + WS_CTL, 0, CTL_BYTES, stream);
    Args a{};
    for (int i = 0; i < 25; ++i) a.in[i] = d_in[i];
    a.out = (float*)d_out; a.ws = (unsigned char*)d_ws;
#ifdef CFG_PROBE_PHASE
    launch_mega(a, 0, CFG_PROBE_PHASE + 1, 0, grid, stream); launch_mega(a, CFG_PROBE_PHASE, CFG_PROBE_PHASE + 1, 1, grid, stream);
    if (CFG_PROBE_PHASE + 1 < NPHASE) launch_mega(a, CFG_PROBE_PHASE + 1, NPHASE, 2, grid, stream);
    return;
#endif
    int p = 0, li = 0;
    while (p < NPHASE) {
        if (phase_in_mega(p)) { int q = p + 1; if (!CFG_SPLIT) while (q < NPHASE && phase_in_mega(q)) ++q; launch_mega(a, p, q, li++, grid, stream); p = q; continue; }
        switch (p) {
            case 2: hipLaunchKernelGGL(nk_proj, dim3(1024), dim3(NTHREADS), 0, stream, a); break;
            case 4: hipLaunchKernelGGL(nk_qkv, dim3(1024), dim3(NTHREADS), 0, stream, a); break;
            case 5: hipLaunchKernelGGL(nk_attn_mla, dim3(1024), dim3(256), 0, stream, a);
                    hipLaunchKernelGGL(nk_attn_diff, dim3(1024), dim3(256), 0, stream, a);
                    hipLaunchKernelGGL(nk_attn_diff_combine, dim3(2048), dim3(256), 0, stream, a); break;
            case 6: hipLaunchKernelGGL(nk_out, dim3(1024), dim3(NTHREADS), 0, stream, a); break;
            default: break;
        }
        ++p;
    }
}
```

```cpp
#include <hip/hip_runtime.h>
#include <cstdio>
#include <cstdint>

constexpr int BATCH = 16, SEQ = 2048, DM = 1024, T = BATCH * SEQ;
constexpr int NE = 16, FF = 2048, CAP = 256, NSEL = BATCH * NE * CAP;
constexpr int NPROJ = 2048;
constexpr float LOG2E = 1.4426950408889634f;
constexpr float MLA_SCALE = 0.10206207261596575f;
constexpr float DIFF_SCALE = 0.125f;
constexpr float ALPHA = 1.189207115002721f;
constexpr float LN_EPS = 1e-5f, RMS_EPS = 1e-6f;
constexpr float LAMBDA_INIT = 0.2f;

constexpr size_t MiB = 1u << 20;
constexpr size_t WS_CTL = 0, CTL_BYTES = 32768;
constexpr size_t WS_MOD = 1 * MiB;
constexpr size_t WS_MISC = 1 * MiB + 512 * 1024;
constexpr size_t WS_PMM = 1 * MiB + 768 * 1024;
constexpr size_t WS_CS = 2 * MiB, WS_SN = 4 * MiB;
constexpr size_t WS_AFF = 6 * MiB;
constexpr size_t WS_IDX = 8 * MiB, WS_GATE = 8 * MiB + 512 * 1024;
constexpr size_t WS_SLOT = 9 * MiB;
constexpr size_t WS_RINVQ = 11 * MiB, WS_RINVKV = 11 * MiB + 512 * 1024;
constexpr size_t WS_KR = 12 * MiB;
constexpr size_t WS_WIN = 14 * MiB, WS_WUQ = 18 * MiB, WS_WUKV = 18 * MiB + 512 * 1024, WS_WOUT = 19 * MiB;
constexpr size_t WS_WD = 22 * MiB;
constexpr size_t WS_WGU = 86 * MiB;
constexpr size_t WS_YE = WS_WGU;
constexpr size_t WS_PROJ = 214 * MiB;
constexpr size_t WS_Y = WS_PROJ, WS_HLO = WS_PROJ;
constexpr size_t WS_Q = 342 * MiB;
constexpr size_t WS_KV = 390 * MiB;
constexpr size_t WS_U2 = 342 * MiB;
constexpr size_t WS_U = 454 * MiB, WS_AO = 454 * MiB;
constexpr size_t WS_HHI = 406 * MiB;
constexpr size_t WS_END = 534 * MiB;
constexpr size_t WS_ODIFF = WS_WGU;

#define GAS __attribute__((address_space(1)))
#define LAS __attribute__((address_space(3)))
typedef unsigned short bf16;
typedef short bf16x8 __attribute__((ext_vector_type(8)));
typedef float f32x4 __attribute__((ext_vector_type(4)));
typedef float f32x2 __attribute__((ext_vector_type(2)));
typedef unsigned u32x4 __attribute__((ext_vector_type(4)));
typedef unsigned u32x2 __attribute__((ext_vector_type(2)));
typedef GAS unsigned gu32;
#define RLX_AGENT __ATOMIC_RELAXED, __HIP_MEMORY_SCOPE_AGENT
#define LDS_WAIT() asm volatile("s_waitcnt lgkmcnt(0)" ::: "memory")
#define VM_WAIT() asm volatile("s_waitcnt vmcnt(0)" ::: "memory")
__device__ __forceinline__ unsigned f2bf(float f) { unsigned u = __builtin_bit_cast(unsigned, f); return (u + 0x7fffu + ((u >> 16) & 1u)) >> 16; }
__device__ __forceinline__ unsigned pk2(float lo, float hi) { return f2bf(lo) | (f2bf(hi) << 16); }
__device__ __forceinline__ float bflo(unsigned w) { return __uint_as_float(w << 16); }
__device__ __forceinline__ float bfhi(unsigned w) { return __uint_as_float(w & 0xffff0000u); }
__device__ __forceinline__ float bf2f(bf16 h) { return __uint_as_float((unsigned)h << 16); }
__device__ __forceinline__ float wave_sum(float v) {
#pragma unroll
    for (int o = 1; o < 64; o <<= 1) v += __shfl_xor(v, o);
    return v;
}
__device__ __forceinline__ float wave_max(float v) {
#pragma unroll
    for (int o = 1; o < 64; o <<= 1) v = fmaxf(v, __shfl_xor(v, o));
    return v;
}
typedef int i32x4 __attribute__((ext_vector_type(4)));
typedef int i32x8 __attribute__((ext_vector_type(8)));
constexpr float FP8_MAX = 448.0f;
constexpr float SC_U2 = 16.0f, SC_WGU = 512.0f, SC_H = 4.0f, SC_WD = 1024.0f;
constexpr float SC_YE = 64.0f;
constexpr float DS_UP = 1.0f / (SC_U2 * SC_WGU), DS_DOWN = 1.0f / (SC_H * SC_WD);
__device__ __forceinline__ unsigned cvt4_fp8(float a, float b, float c, float d) {
    a = __builtin_amdgcn_fmed3f(a, -FP8_MAX, FP8_MAX); b = __builtin_amdgcn_fmed3f(b, -FP8_MAX, FP8_MAX); c = __builtin_amdgcn_fmed3f(c, -FP8_MAX, FP8_MAX); d = __builtin_amdgcn_fmed3f(d, -FP8_MAX, FP8_MAX);
    int w = 0; w = __builtin_amdgcn_cvt_pk_fp8_f32(a, b, w, false); w = __builtin_amdgcn_cvt_pk_fp8_f32(c, d, w, true); return (unsigned)w;
}
__device__ __forceinline__ float silu_f(float g) { return g * __builtin_amdgcn_rcpf(1.0f + __builtin_amdgcn_exp2f(-g * LOG2E)); }

#define XB_TMO      128
#define XB_XCNT(j)  (256  + 64 * (j))
#define XB_XSUB(j)  (1280 + 64 * (j))
#define XB_XGEN(j)  (2304 + 64 * (j))
#define XB_TOP      3328
#define XB_TOPGEN   3392
#define XCD_BAR_WORDS 3456
#define XB_SPIN_CAP (1u << 18)
__device__ __forceinline__ unsigned xb_ld(unsigned* p)              { return __hip_atomic_load(p, __ATOMIC_RELAXED, __HIP_MEMORY_SCOPE_AGENT); }
__device__ __forceinline__ unsigned xb_add(unsigned* p, unsigned v) { return __hip_atomic_fetch_add(p, v, __ATOMIC_RELAXED, __HIP_MEMORY_SCOPE_AGENT); }
__device__ __forceinline__ unsigned xb_xcc_id() { return (unsigned)__builtin_amdgcn_s_getreg((3 << 11) | 20) & 0xFu; }
#define XB_SPIN(cond, bar) do { unsigned _sp = 0; while (cond) { __builtin_amdgcn_s_sleep(1); \
    if ((++_sp & 255u) == 0u) { if (xb_ld(&(bar)[XB_TMO])) break; if (_sp > XB_SPIN_CAP) { atomicAdd(&(bar)[XB_TMO], 1u); break; } } } } while (0)
struct XcdBarrier { unsigned* bar; unsigned x; volatile LAS unsigned* st; };
__device__ __forceinline__ XcdBarrier xcd_barrier_post(unsigned* bar, volatile LAS unsigned* st) {
    XcdBarrier b; b.bar = bar; b.x = xb_xcc_id(); b.st = st;
    if (threadIdx.x == 0) (void)xb_add(&bar[XB_XCNT(b.x)], 1u);
    return b;
}
__device__ __forceinline__ void xcd_barrier_complete(unsigned* bar, unsigned x, unsigned& nloc, unsigned& nx) {
    const unsigned G = gridDim.x * gridDim.y * gridDim.z;
    unsigned sum, cnt, mine, sp = 0u;
    for (;;) {
        sum = 0u; cnt = 0u; mine = 0u;
#pragma unroll
        for (unsigned j = 0; j < 16; ++j) { const unsigned c = xb_ld(&bar[XB_XCNT(j)]); sum += c; cnt += (c > 0u) ? 1u : 0u; mine = (j == x) ? c : mine; }
        if (sum == G) break;
        __builtin_amdgcn_s_sleep(1);
        if ((++sp & 255u) == 0u) { if (xb_ld(&bar[XB_TMO])) break; if (sp > XB_SPIN_CAP) { atomicAdd(&bar[XB_TMO], 1u); break; } }
    }
    nloc = mine > 0u ? mine : 1u; nx = cnt > 0u ? cnt : 1u;
}
__device__ __forceinline__ void xcd_barrier(const XcdBarrier& b) {
    asm volatile("s_waitcnt vmcnt(0)" ::: "memory");
    __syncthreads();
    if (threadIdx.x == 0) {
        unsigned* bar = b.bar;
        __builtin_amdgcn_s_waitcnt(0);
        unsigned nloc = b.st[0], nx = b.st[1];
        if (nloc == 0u) { xcd_barrier_complete(bar, b.x, nloc, nx); b.st[0] = nloc; b.st[1] = nx; }
        const unsigned old = xb_add(&bar[XB_XSUB(b.x)], 1u);
        const unsigned gen = old / nloc;
        if (old + 1u == (gen + 1u) * nloc) {
            __builtin_amdgcn_fence(__ATOMIC_RELEASE, "agent");
            asm volatile("s_waitcnt vmcnt(0)" ::: "memory");
            const unsigned og = xb_add(&bar[XB_TOP], 1u);
            const unsigned tg = og / nx;
            if (og + 1u == (tg + 1u) * nx) xb_add(&bar[XB_TOPGEN], 1u);
            else XB_SPIN(xb_ld(&bar[XB_TOPGEN]) == tg, bar);
            __builtin_amdgcn_fence(__ATOMIC_ACQUIRE, "agent");
            xb_add(&bar[XB_XGEN(b.x)], 1u);
            asm volatile("s_waitcnt vmcnt(0)" ::: "memory");
        } else {
            XB_SPIN(xb_ld(&bar[XB_XGEN(b.x)]) == gen, bar);
            __builtin_amdgcn_fence(__ATOMIC_ACQUIRE, "agent");
            asm volatile("s_waitcnt vmcnt(0)" ::: "memory");
        }
    }
    __syncthreads();
}

constexpr int NWAVES = 8, NTHREADS = 512;
constexpr int RING_BYTES = 147456, LDSCTL_OFF = RING_BYTES, MISC_OFF = LDSCTL_OFF + 320, LDS_BYTES = 148480;
constexpr int CW_BAR = 4096;

struct Args { const void* in[25]; float* out; unsigned char* ws; int ph_lo, ph_hi, li, pad; };

struct Ctx {
    LAS unsigned char* lds; unsigned char* lds_g;
    int wave, vcu, G;
    const float *x, *c, *rel_bias, *w_ada, *b_ada, *w_in, *qnorm, *w_uq, *kvnorm, *w_ukv, *lq1, *lk1, *lq2, *lk2, *subln, *w_out, *ln1g, *ln1b, *w_router, *w_gate, *w_up, *w_down, *ln2g, *ln2b;
    const int* pos;
    float* out; unsigned char* ws;
    float *MOD, *MISC, *CS, *SN, *AFF, *GATE, *RINVQ, *RINVKV, *Y;
    int *PMM, *IDX, *SLOT;
    bf16 *KR, *WIN, *WUQ, *WUKV, *WOUT, *WD, *WGU, *YE, *PROJ, *Q, *KV, *U2, *U, *AO, *HLO, *HHI;
};
__device__ __forceinline__ void ctx_init(Ctx& C, const Args& a) {
    C.x = (const float*)a.in[0]; C.c = (const float*)a.in[1]; C.pos = (const int*)a.in[2]; C.rel_bias = (const float*)a.in[3];
    C.w_ada = (const float*)a.in[4]; C.b_ada = (const float*)a.in[5]; C.w_in = (const float*)a.in[6]; C.qnorm = (const float*)a.in[7];
    C.w_uq = (const float*)a.in[8]; C.kvnorm = (const float*)a.in[9]; C.w_ukv = (const float*)a.in[10];
    C.lq1 = (const float*)a.in[11]; C.lk1 = (const float*)a.in[12]; C.lq2 = (const float*)a.in[13]; C.lk2 = (const float*)a.in[14];
    C.subln = (const float*)a.in[15]; C.w_out = (const float*)a.in[16]; C.ln1g = (const float*)a.in[17]; C.ln1b = (const float*)a.in[18];
    C.w_router = (const float*)a.in[19]; C.w_gate = (const float*)a.in[20]; C.w_up = (const float*)a.in[21]; C.w_down = (const float*)a.in[22];
    C.ln2g = (const float*)a.in[23]; C.ln2b = (const float*)a.in[24];
    C.out = a.out; unsigned char* ws = a.ws; C.ws = ws;
    C.MOD = (float*)(ws + WS_MOD); C.MISC = (float*)(ws + WS_MISC); C.PMM = (int*)(ws + WS_PMM); C.CS = (float*)(ws + WS_CS); C.SN = (float*)(ws + WS_SN);
    C.AFF = (float*)(ws + WS_AFF); C.IDX = (int*)(ws + WS_IDX); C.GATE = (float*)(ws + WS_GATE); C.SLOT = (int*)(ws + WS_SLOT);
    C.RINVQ = (float*)(ws + WS_RINVQ); C.RINVKV = (float*)(ws + WS_RINVKV); C.KR = (bf16*)(ws + WS_KR);
    C.WIN = (bf16*)(ws + WS_WIN); C.WUQ = (bf16*)(ws + WS_WUQ); C.WUKV = (bf16*)(ws + WS_WUKV); C.WOUT = (bf16*)(ws + WS_WOUT);
    C.WD = (bf16*)(ws + WS_WD); C.WGU = (bf16*)(ws + WS_WGU); C.YE = (bf16*)(ws + WS_YE);
    C.PROJ = (bf16*)(ws + WS_PROJ); C.Y = (float*)(ws + WS_Y); C.HLO = (bf16*)(ws + WS_HLO); C.HHI = (bf16*)(ws + WS_HHI);
    C.Q = (bf16*)(ws + WS_Q); C.KV = (bf16*)(ws + WS_KV); C.U2 = (bf16*)(ws + WS_U2); C.U = (bf16*)(ws + WS_U); C.AO = (bf16*)(ws + WS_AO);
}

__device__ __forceinline__ void store8_bf16(bf16* p, const float (&v)[8]) {
    u32x4 w; w.x = pk2(v[0], v[1]); w.y = pk2(v[2], v[3]); w.z = pk2(v[4], v[5]); w.w = pk2(v[6], v[7]); *(u32x4*)p = w;
}
struct FRowScale { bf16* O; int ldc; const float* ssq; float inv_n;
    __device__ __forceinline__ void row8(int kind, int row, int col, const float (&v)[8]) const {
        const f32x4 p = *(const f32x4*)(ssq + (size_t)row * 4); const float s = 1.0f / sqrtf(((p[0] + p[1]) + (p[2] + p[3])) * inv_n + RMS_EPS); float o[8];
#pragma unroll
        for (int i = 0; i < 8; ++i) o[i] = v[i] * s;
        store8_bf16(O + (size_t)row * ldc + col, o);
    } };
struct FSwi { unsigned char* H;
    __device__ __forceinline__ void pair8(int row, int col, const float (&g)[8], const float (&u)[8]) const {
        float o[8];
#pragma unroll
        for (int i = 0; i < 8; ++i) o[i] = silu_f(g[i] * DS_UP) * (u[i] * (DS_UP * SC_H));
        u32x2 w; w.x = cvt4_fp8(o[0], o[1], o[2], o[3]); w.y = cvt4_fp8(o[4], o[5], o[6], o[7]);
        *(u32x2*)(H + (size_t)row * FF + col) = w;
    } };
struct FGate { bf16* YE; const float* gate;
    __device__ __forceinline__ void row8(int kind, int row, int col, const float (&v)[8]) const {
        const float s = gate[row] * DS_DOWN; float o[8];
#pragma unroll
        for (int i = 0; i < 8; ++i) o[i] = v[i] * s;
        store8_bf16(YE + (size_t)row * DM + col, o);
    } };

__device__ __forceinline__ void tr_item(const float* W, int ldw, int kb, int srccol0, bool perm, float scale, const float* kgain, int kvalid,
                                        bf16* WT, int ldt, int n0, LAS float* scr, int lane) {
    const int k0 = 64 * kb, cl = lane & 31;
    const int sc = perm ? (16 * ((cl >> 2) & 1) + 4 * (cl >> 3) + (cl & 3)) : cl;
#pragma unroll 8
    for (int i = 0; i < 32; ++i) { const int kk = 2 * i + (lane >> 5), k = k0 + kk; float v = 0.f;
        if (srccol0 >= 0 && k < kvalid) { v = W[(size_t)k * ldw + srccol0 + sc] * scale; if (kgain) v *= kgain[k]; }
        scr[kk * 33 + cl] = v; }
    LDS_WAIT(); asm volatile("" ::: "memory");
    const int c = lane & 7;
#pragma unroll
    for (int j = 0; j < 4; ++j) { const int n = (lane >> 3) + 8 * j; const LAS float* s = scr + (8 * c) * 33 + n;
        u32x4 o; o.x = pk2(s[0 * 33], s[1 * 33]); o.y = pk2(s[2 * 33], s[3 * 33]); o.z = pk2(s[4 * 33], s[5 * 33]); o.w = pk2(s[6 * 33], s[7 * 33]);
        *(GAS u32x4*)(WT + (size_t)(n0 + n) * ldt + k0 + 8 * c) = o; }
    LDS_WAIT(); asm volatile("" ::: "memory");
}
__device__ __forceinline__ int t5_bucket(int rel) {
    const int nb = 16, max_exact = 8; int ret = rel > 0 ? nb : 0; const int n = rel < 0 ? -rel : rel;
    const float nf = (float)(n > 1 ? n : 1);
    int large = max_exact + (int)(logf(nf / 8.0f) / 2.772588722239781f * 8.0f);
    large = large < nb - 1 ? large : nb - 1;
    return ret + (n < max_exact ? n : large);
}

#define PHASE_IDS int tid_l_ = threadIdx.x; asm volatile("" : "+v"(tid_l_)); const int tid = tid_l_, lane = tid & 63; (void)lane
__device__ __forceinline__ void phase_prep(const Ctx& C) {
    PHASE_IDS;
    LAS float* scr = (LAS float*)(C.lds + C.wave * 8448);
    const int gw = C.vcu * NWAVES + C.wave, NGW = C.G * NWAVES;
    constexpr int I_IN = 16 * 64, I_UQ = 4 * 24, I_UKV = 4 * 32, I_OUT = 16 * 32, NIT = I_IN + I_UQ + I_UKV + I_OUT;
    for (int it = gw; it < NIT; it += NGW) {
        int r = it;
        if (r < I_IN) { const int kb = r / 64, nb = r % 64, n0 = 32 * nb; int src; bool perm = false; float sc = 1.f;
            if (nb < 12) src = n0; else if (nb == 12) { src = 384; perm = true; } else if (nb < 16) src = -1; else { src = 416 + (n0 - 512); if (n0 < 1024) sc = DIFF_SCALE * LOG2E; }
            tr_item(C.w_in, 1952, kb, src, perm, sc, nullptr, 1024, C.WIN, 1024, n0, scr, lane); continue; }
        r -= I_IN;
        if (r < I_UQ) { const int kb = r / 24, nb = r % 24, n0 = 32 * nb; int src; bool perm = false;
            if (nb < 16) { src = 96 * (n0 >> 6) + (n0 & 63); } else { src = 96 * (nb - 16) + 64; perm = true; }
            tr_item(C.w_uq, 768, kb, src, perm, MLA_SCALE * LOG2E, C.qnorm, 256, C.WUQ, 256, n0, scr, lane); continue; }
        r -= I_UQ;
        if (r < I_UKV) { const int kb = r / 32, nb = r % 32, n0 = 32 * nb; int src;
            if (nb < 16) src = 128 * (n0 >> 6) + (n0 & 63); else { const int n1 = n0 - 512; src = 128 * (n1 >> 6) + 64 + (n1 & 63); }
            tr_item(C.w_ukv, 1024, kb, src, false, 1.f, C.kvnorm, 128, C.WUKV, 256, n0, scr, lane); continue; }
        r -= I_UKV;
        { const int kb = r / 32, nb = r % 32; tr_item(C.w_out, 1024, kb, 32 * nb, false, 1.f, nullptr, 1024, C.WOUT, 1024, 32 * nb, scr, lane); }
    }
    for (int i = (C.vcu * NTHREADS + tid); i < T * 16; i += C.G * NTHREADS) { const int t = i >> 4, j = i & 15;
        const float freq = (float)pow(10000.0, -(double)j / 16.0); const float ang = (float)C.pos[t] * freq; float s, c; sincosf(ang, &s, &c);
        C.CS[i] = c; C.SN[i] = s; }
    for (int i = (C.vcu * NTHREADS + tid); i < BATCH * 32; i += C.G * NTHREADS) { int mn = 0x7fffffff, mx = -0x7fffffff - 1;
        for (int k = 0; k < 64; ++k) { const int p = C.pos[i * 64 + k]; mn = p < mn ? p : mn; mx = p > mx ? p : mx; }
        C.PMM[2 * i] = mn; C.PMM[2 * i + 1] = mx; }
    if (C.vcu == 255 % C.G) {
        for (int i = tid; i < 4 * 257; i += NTHREADS) { const int h = i / 257, r = i % 257 - 128; C.MISC[64 + h * 260 + (r + 128)] = C.rel_bias[t5_bucket(r) * 4 + h] * LOG2E; }
        if (C.wave == 0) { const float a = wave_sum(C.lq1[lane] * C.lk1[lane]), b = wave_sum(C.lq2[lane] * C.lk2[lane]);
            if (lane == 0) C.MISC[0] = expf(a) - expf(b) + LAMBDA_INIT; }
    }
    __syncthreads();
    LAS float* cact = (LAS float*)C.lds;
    LAS float* red = (LAS float*)(C.lds + 65536);
    bool have = false;
    for (int u = C.vcu; u < 192; u += C.G) {
        if (!have) { for (int i = tid; i < 16 * 1024; i += NTHREADS) { const int b = i >> 10, d = i & 1023; const float v = C.c[i]; cact[d * 16 + b] = v / (1.0f + expf(-v)); } have = true; __syncthreads(); }
        const int nl = tid & 31, kc = tid >> 5, n = 32 * u + nl;
        float acc[16];
#pragma unroll
        for (int b = 0; b < 16; ++b) acc[b] = 0.f;
#pragma unroll 8
        for (int i = 0; i < 64; ++i) { const int d = kc * 64 + i; const float w = C.w_ada[(size_t)d * 6144 + n];
#pragma unroll
            for (int q = 0; q < 4; ++q) { const f32x4 ca = *(const LAS f32x4*)(cact + d * 16 + 4 * q); acc[4 * q] += w * ca[0]; acc[4 * q + 1] += w * ca[1]; acc[4 * q + 2] += w * ca[2]; acc[4 * q + 3] += w * ca[3]; } }
#pragma unroll
        for (int b = 0; b < 16; ++b) red[(kc * 16 + b) * 32 + nl] = acc[b];
        __syncthreads();
        { const int b = tid >> 5; float s = C.b_ada[n];
#pragma unroll
            for (int k = 0; k < 16; ++k) s += red[(k * 16 + b) * 32 + nl];
            C.MOD[b * 6144 + n] = s; }
        __syncthreads();
    }
}
__device__ __forceinline__ void phase_u(const Ctx& C) {
    PHASE_IDS;
    for (size_t i = (size_t)C.vcu * NTHREADS + tid; i < (size_t)T * DM / 8; i += (size_t)C.G * NTHREADS) {
        const size_t e = i * 8; const int row = (int)(e >> 10), col = (int)(e & 1023), b = row >> 11;
        const f32x4 x0 = *(const f32x4*)(C.x + e), x1 = *(const f32x4*)(C.x + e + 4);
        const float* sh = C.MOD + b * 6144 + col; const float* sc = sh + 1024;
        const f32x4 h0 = *(const f32x4*)sh, h1 = *(const f32x4*)(sh + 4), c0 = *(const f32x4*)sc, c1 = *(const f32x4*)(sc + 4);
        u32x4 w; w.x = pk2(x0[0] * (1.f + c0[0]) + h0[0], x0[1] * (1.f + c0[1]) + h0[1]); w.y = pk2(x0[2] * (1.f + c0[2]) + h0[2], x0[3] * (1.f + c0[3]) + h0[3]);
        w.z = pk2(x1[0] * (1.f + c1[0]) + h1[0], x1[1] * (1.f + c1[1]) + h1[1]); w.w = pk2(x1[2] * (1.f + c1[2]) + h1[2], x1[3] * (1.f + c1[3]) + h1[3]);
        *(u32x4*)(C.U + e) = w;
    }
}
__device__ __forceinline__ void phase_ln1(const Ctx& C) {
    PHASE_IDS;
    LAS float* wr = (LAS float*)C.lds;
    LAS float* urow = (LAS float*)(C.lds + 65536) + C.wave * 2048;
    for (int i = tid; i < 1024 * 4; i += NTHREADS) { const int d = i >> 2, ch = i & 3; const f32x4 v = *(const f32x4*)(C.w_router + d * 16 + 4 * ch);
        *(LAS f32x4*)(wr + d * 16 + 4 * (ch ^ ((d >> 2) & 3))) = v; }
    __syncthreads();
    const int gw = C.vcu * NWAVES + C.wave, NGW = C.G * NWAVES;
    for (int t0 = gw; t0 + NGW < T; t0 += 2 * NGW) {
        f32x4 v[2][4]; float sum[2] = {0.f, 0.f};
#pragma unroll
        for (int r = 0; r < 2; ++r) { const f32x4* yr = (const f32x4*)(C.Y + (size_t)(t0 + r * NGW) * DM) + lane;
#pragma unroll
            for (int j = 0; j < 4; ++j) v[r][j] = yr[64 * j]; }
#pragma unroll
        for (int r = 0; r < 2; ++r)
#pragma unroll
            for (int j = 0; j < 4; ++j) sum[r] += (v[r][j][0] + v[r][j][1]) + (v[r][j][2] + v[r][j][3]);
        float mean[2], rstd[2];
#pragma unroll
        for (int r = 0; r < 2; ++r) { mean[r] = wave_sum(sum[r]) * (1.f / DM); float s2 = 0.f;
#pragma unroll
            for (int j = 0; j < 4; ++j) { v[r][j] = v[r][j] - mean[r]; s2 += (v[r][j][0] * v[r][j][0] + v[r][j][1] * v[r][j][1]) + (v[r][j][2] * v[r][j][2] + v[r][j][3] * v[r][j][3]); }
            rstd[r] = 1.0f / sqrtf(wave_sum(s2) * (1.f / DM) + LN_EPS); }
#pragma unroll
        for (int r = 0; r < 2; ++r) { const int t = t0 + r * NGW, b = t >> 11; const float* mod = C.MOD + b * 6144;
#pragma unroll
            for (int j = 0; j < 4; ++j) { const int col = 4 * lane + 256 * j;
                const f32x4 g = *(const f32x4*)(C.ln1g + col), be = *(const f32x4*)(C.ln1b + col), sh = *(const f32x4*)(mod + 3072 + col), sc = *(const f32x4*)(mod + 4096 + col);
                f32x4 x1, u2;
#pragma unroll
                for (int i = 0; i < 4; ++i) { x1[i] = v[r][j][i] * rstd[r] * g[i] + be[i]; u2[i] = x1[i] * (1.f + sc[i]) + sh[i]; }
                *(f32x4*)(C.out + (size_t)t * DM + col) = x1;
                *(unsigned*)((unsigned char*)C.U2 + (size_t)t * DM + col) = cvt4_fp8(u2[0] * SC_U2, u2[1] * SC_U2, u2[2] * SC_U2, u2[3] * SC_U2);
                *(LAS f32x4*)(urow + r * 1024 + col) = u2; } }
        LDS_WAIT(); asm volatile("" ::: "memory");
        float lg[32];
#pragma unroll
        for (int e = 0; e < 32; ++e) lg[e] = 0.f;
#pragma unroll 4
        for (int k = 0; k < 16; ++k) { const int d = lane + 64 * k; const float u0 = urow[d], u1 = urow[1024 + d]; const int sw = (d >> 2) & 3;
#pragma unroll
            for (int ch = 0; ch < 4; ++ch) { const f32x4 w = *(const LAS f32x4*)(wr + d * 16 + 4 * (ch ^ sw));
#pragma unroll
                for (int i = 0; i < 4; ++i) { lg[4 * ch + i] += u0 * w[i]; lg[16 + 4 * ch + i] += u1 * w[i]; } } }
        float h16[16];
        { const bool up = (lane & 32) != 0;
#pragma unroll
          for (int i = 0; i < 16; ++i) { const float keep = up ? lg[16 + i] : lg[i], send = up ? lg[i] : lg[16 + i]; h16[i] = keep + __shfl_xor(send, 32); } }
        float h8[8];
        { const bool up = (lane & 16) != 0;
#pragma unroll
          for (int i = 0; i < 8; ++i) { const float keep = up ? h16[8 + i] : h16[i], send = up ? h16[i] : h16[8 + i]; h8[i] = keep + __shfl_xor(send, 16); } }
        float h4[4];
        { const bool up = (lane & 8) != 0;
#pragma unroll
          for (int i = 0; i < 4; ++i) { const float keep = up ? h8[4 + i] : h8[i], send = up ? h8[i] : h8[4 + i]; h4[i] = keep + __shfl_xor(send, 8); } }
        float h2[2];
        { const bool up = (lane & 4) != 0;
#pragma unroll
          for (int i = 0; i < 2; ++i) { const float keep = up ? h4[2 + i] : h4[i], send = up ? h4[i] : h4[2 + i]; h2[i] = keep + __shfl_xor(send, 4); } }
        float lgt;
        { const bool up = (lane & 2) != 0; const float keep = up ? h2[1] : h2[0], send = up ? h2[0] : h2[1]; lgt = keep + __shfl_xor(send, 2); }
        lgt += __shfl_xor(lgt, 1);
        float mx = lgt;
        mx = fmaxf(mx, __shfl_xor(mx, 2)); mx = fmaxf(mx, __shfl_xor(mx, 4)); mx = fmaxf(mx, __shfl_xor(mx, 8)); mx = fmaxf(mx, __shfl_xor(mx, 16));
        const float ex = __builtin_amdgcn_exp2f((lgt - mx) * LOG2E);
        float den = ex;
        den += __shfl_xor(den, 2); den += __shfl_xor(den, 4); den += __shfl_xor(den, 8); den += __shfl_xor(den, 16);
        if ((lane & 1) == 0) { const int r = lane >> 5, e = (((lane >> 4) & 1) << 3) | (((lane >> 3) & 1) << 2) | (((lane >> 2) & 1) << 1) | ((lane >> 1) & 1);
            const int t = t0 + r * NGW, b = t >> 11, s = t & 2047; C.AFF[((size_t)b * 16 + e) * SEQ + s] = ex / den; }
        LDS_WAIT(); asm volatile("" ::: "memory");
    }
}
__device__ __forceinline__ unsigned block_count(LAS unsigned* cnt, int wave, int lane, unsigned c) {
    c += __shfl_xor(c, 1); c += __shfl_xor(c, 2); c += __shfl_xor(c, 4); c += __shfl_xor(c, 8); c += __shfl_xor(c, 16); c += __shfl_xor(c, 32);
    __syncthreads();
    if (lane == 0) cnt[wave] = c;
    __syncthreads();
    unsigned s = 0;
#pragma unroll
    for (int w = 0; w < NWAVES; ++w) s += cnt[w];
    return s;
}
__device__ __forceinline__ unsigned block_excl_scan(LAS unsigned* cnt, int wave, int lane, unsigned c) {
    unsigned inc = c;
#pragma unroll
    for (int o = 1; o < 64; o <<= 1) { const unsigned n = __shfl_up(inc, o); if (lane >= o) inc += n; }
    __syncthreads();
    if (lane == 63) cnt[wave] = inc;
    __syncthreads();
    unsigned base = 0;
#pragma unroll
    for (int w = 0; w < NWAVES; ++w) base += (w < wave) ? cnt[w] : 0u;
    return base + inc - c;
}
__device__ __forceinline__ void phase_topk(const Ctx& C, int be_first, int be_step) {
    PHASE_IDS;
    LAS unsigned* cnt = (LAS unsigned*)(C.lds + 4096);
    for (int be = be_first; be < BATCH * NE; be += be_step) {
        const int b = be >> 4, e = be & 15;
        const float* aff = C.AFF + ((size_t)b * 16 + e) * SEQ;
        const u32x4 kv = *(const u32x4*)(aff + 4 * tid);
        const unsigned key[4] = {kv.x, kv.y, kv.z, kv.w};
        unsigned prefix = 0;
        for (int bit = 30; bit >= 0; --bit) { const unsigned cand = prefix | (1u << bit);
            unsigned c = 0;
#pragma unroll
            for (int i = 0; i < 4; ++i) c += key[i] >= cand ? 1u : 0u;
            if (block_count(cnt, C.wave, lane, c) >= (unsigned)CAP) prefix = cand; }
        unsigned cg = 0, ce = 0;
#pragma unroll
        for (int i = 0; i < 4; ++i) { cg += key[i] > prefix ? 1u : 0u; ce += key[i] == prefix ? 1u : 0u; }
        const unsigned ngt = block_count(cnt, C.wave, lane, cg);
        const unsigned need = (unsigned)CAP - ngt;
        unsigned tb = block_excl_scan(cnt, C.wave, lane, ce);
        unsigned sel[4], cs = 0;
#pragma unroll
        for (int i = 0; i < 4; ++i) { const bool eq = key[i] == prefix; sel[i] = (key[i] > prefix || (eq && tb < need)) ? 1u : 0u; tb += eq ? 1u : 0u; cs += sel[i]; }
        unsigned p = block_excl_scan(cnt, C.wave, lane, cs);
#pragma unroll
        for (int i = 0; i < 4; ++i) { const int s = 4 * tid + i; int slot = -1;
            if (sel[i]) { slot = (int)p; C.IDX[be * CAP + p] = s; C.GATE[be * CAP + p] = __uint_as_float(key[i]); ++p; }
            C.SLOT[((size_t)b * 16 + e) * SEQ + s] = slot; }
        __syncthreads();
    }
}
typedef short s16x4_t __attribute__((ext_vector_type(4)));
struct ConvItem { const float* src; int ldw; float scale; unsigned char* dst; int ldt; };
__device__ __forceinline__ void conv_load(const ConvItem& d, f32x4 (&v)[16]) {
#pragma unroll
    for (int i = 0; i < 16; ++i) v[i] = *(const f32x4*)(d.src + (size_t)(4 * i) * d.ldw);
}
__device__ __forceinline__ void conv_finish(const ConvItem& d, f32x4 (&v)[16], LAS unsigned char* img, int lane) {
    const int kr = lane >> 4, c4 = lane & 15;
    asm volatile("" : "+v"(v[0]), "+v"(v[1]), "+v"(v[2]), "+v"(v[3]), "+v"(v[4]), "+v"(v[5]), "+v"(v[6]), "+v"(v[7]));
    asm volatile("" : "+v"(v[8]), "+v"(v[9]), "+v"(v[10]), "+v"(v[11]), "+v"(v[12]), "+v"(v[13]), "+v"(v[14]), "+v"(v[15]));
#pragma unroll
    for (int i = 0; i < 16; ++i) { u32x2 w; w.x = pk2(v[i][0] * d.scale, v[i][1] * d.scale); w.y = pk2(v[i][2] * d.scale, v[i][3] * d.scale); *(LAS u32x2*)(img + (4 * i + kr) * 192 + 8 * c4) = w; }
    LDS_WAIT(); asm volatile("" ::: "memory");
    const int g = lane >> 4, q = (lane >> 2) & 3, p = lane & 3, i16 = lane & 15;
    const int rdbase = (int)(unsigned)(size_t)img + (8 * (g >> 1) + q) * 192 + (16 * (g & 1) + 4 * p) * 2;
#pragma unroll
    for (int s = 0; s < 8; ++s) { const int jj = s >> 1, nn = s & 1;
        s16x4_t lo, hi;
        asm volatile("ds_read_b64_tr_b16 %0, %1 offset:%2" : "=&v"(lo) : "v"(rdbase), "i"((16 * jj) * 192 + 64 * nn) : "memory");
        asm volatile("ds_read_b64_tr_b16 %0, %1 offset:%2" : "=&v"(hi) : "v"(rdbase), "i"((16 * jj + 4) * 192 + 64 * nn) : "memory");
        asm volatile("s_waitcnt lgkmcnt(0)" : "+v"(lo), "+v"(hi) :: "memory");
        const int kc = 2 * jj + (g >> 1), n = 16 * (2 * nn + (g & 1)) + i16;
        const u32x2 l2 = __builtin_bit_cast(u32x2, lo), h2 = __builtin_bit_cast(u32x2, hi);
        u32x2 o; o.x = cvt4_fp8(bflo(l2.x), bfhi(l2.x), bflo(l2.y), bfhi(l2.y)); o.y = cvt4_fp8(bflo(h2.x), bfhi(h2.x), bflo(h2.y), bfhi(h2.y));
        *(GAS u32x2*)(d.dst + (size_t)n * d.ldt + 8 * kc) = o; }
    LDS_WAIT(); asm volatile("" ::: "memory");
}
__device__ __forceinline__ void wconv_all(const Ctx& C) {
    LAS unsigned char* img = C.lds + 8192 + C.wave * 12288;
    int tl_ = threadIdx.x; asm volatile("" : "+v"(tl_)); const int lane = tl_ & 63;
    const int gw = C.vcu * NWAVES + C.wave, NGW = C.G * NWAVES;
    constexpr int P_GU = 2 * 8 * 32, P_D = 16 * 16, P_E = P_GU + P_D, NPAIR = NE * P_E;
    const int kr = lane >> 4, c4 = lane & 15;
#define CONV_DECODE(pr, sub, d) do { const int e_ = (pr) / P_E; int r_ = (pr) % P_E; \
        if (r_ < P_GU) { const int up_ = r_ >> 8, kb_ = 2 * ((r_ >> 5) & 7) + (sub), nb_ = r_ & 31, n0_ = 64 * nb_; const float* W_ = (up_ ? C.w_up : C.w_gate) + (size_t)e_ * DM * FF; \
            d.src = W_ + (size_t)(64 * kb_ + kr) * FF + n0_ + 4 * c4; d.ldw = FF; d.scale = SC_WGU; d.ldt = DM; \
            d.dst = (unsigned char*)C.WGU + (size_t)e_ * 4096 * DM + (size_t)((n0_ >> 7) * 256 + (n0_ & 127) + up_ * 128) * DM + 64 * kb_; } \
        else { r_ -= P_GU; const int kb_ = 2 * (r_ >> 4) + (sub), nb_ = r_ & 15; \
            d.src = C.w_down + (size_t)e_ * FF * DM + (size_t)(64 * kb_ + kr) * DM + 64 * nb_ + 4 * c4; d.ldw = DM; d.scale = SC_WD; d.ldt = FF; \
            d.dst = (unsigned char*)C.WD + (size_t)e_ * DM * FF + (size_t)(64 * nb_) * FF + 64 * kb_; } } while (0)
    int pr = gw; if (pr >= NPAIR) return;
    f32x4 va[16], vb[16]; ConvItem dA, dB;
    CONV_DECODE(pr, 0, dA); conv_load(dA, va);
    for (;;) {
        CONV_DECODE(pr, 1, dB); conv_load(dB, vb);
        conv_finish(dA, va, img, lane);
        const int pn = pr + NGW; const bool hn = pn < NPAIR;
        if (hn) { CONV_DECODE(pn, 0, dA); conv_load(dA, va); }
        conv_finish(dB, vb, img, lane);
        if (!hn) break;
        pr = pn;
    }
#undef CONV_DECODE
}
__device__ __forceinline__ void phase_final(const Ctx& C) {
    PHASE_IDS;
    const int gw = C.vcu * NWAVES + C.wave, NGW = C.G * NWAVES;
    f32x4 nx[4]; int nslot = -1;
    if (gw < T) { const int b = gw >> 11, s = gw & 2047;
#pragma unroll
        for (int j = 0; j < 4; ++j) nx[j] = *(const f32x4*)(C.out + (size_t)gw * DM + 4 * lane + 256 * j);
        nslot = lane < 16 ? C.SLOT[((size_t)b * 16 + lane) * SEQ + s] : -1; }
    for (int t = gw; t < T; t += NGW) {
        const int b = t >> 11;
        f32x4 a[4], x1[4];
#pragma unroll
        for (int j = 0; j < 4; ++j) { a[j] = (f32x4){0.f, 0.f, 0.f, 0.f}; x1[j] = nx[j]; }
        const int myslot = nslot;
        if (t + NGW < T) { const int tn = t + NGW, bn = tn >> 11, sn = tn & 2047;
#pragma unroll
            for (int j = 0; j < 4; ++j) nx[j] = *(const f32x4*)(C.out + (size_t)tn * DM + 4 * lane + 256 * j);
            nslot = lane < 16 ? C.SLOT[((size_t)bn * 16 + lane) * SEQ + sn] : -1; }
        unsigned long long mask = __ballot(myslot >= 0);
        while (mask) {
            const int e0 = __builtin_ctzll(mask); mask &= mask - 1; const bool two = mask != 0ull; const int e1 = two ? __builtin_ctzll(mask) : e0; if (two) mask &= mask - 1;
            const int p0 = __shfl(myslot, e0), p1 = __shfl(myslot, e1);
            const bf16* y0 = C.YE + ((size_t)(b * 16 + e0) * CAP + p0) * DM + 4 * lane; const bf16* y1 = C.YE + ((size_t)(b * 16 + e1) * CAP + p1) * DM + 4 * lane;
            u32x2 w0[4], w1[4];
#pragma unroll
            for (int j = 0; j < 4; ++j) { w0[j] = *(const u32x2*)(y0 + 256 * j); w1[j] = *(const u32x2*)(y1 + 256 * j); }
            const float f1 = two ? 1.f : 0.f;
#pragma unroll
            for (int j = 0; j < 4; ++j) { a[j][0] += bflo(w0[j].x) + f1 * bflo(w1[j].x); a[j][1] += bfhi(w0[j].x) + f1 * bfhi(w1[j].x); a[j][2] += bflo(w0[j].y) + f1 * bflo(w1[j].y); a[j][3] += bfhi(w0[j].y) + f1 * bfhi(w1[j].y); }
        }
        const float* mod = C.MOD + b * 6144 + 5120;
        f32x4 v[4]; float sum = 0.f;
#pragma unroll
        for (int j = 0; j < 4; ++j) { const int col = 4 * lane + 256 * j; const f32x4 g = *(const f32x4*)(mod + col);
#pragma unroll
            for (int i = 0; i < 4; ++i) v[j][i] = ALPHA * x1[j][i] + g[i] * a[j][i];
            sum += (v[j][0] + v[j][1]) + (v[j][2] + v[j][3]); }
        const float mean = wave_sum(sum) * (1.f / DM); float s2 = 0.f;
#pragma unroll
        for (int j = 0; j < 4; ++j) { v[j] = v[j] - mean; s2 += (v[j][0] * v[j][0] + v[j][1] * v[j][1]) + (v[j][2] * v[j][2] + v[j][3] * v[j][3]); }
        const float rstd = 1.0f / sqrtf(wave_sum(s2) * (1.f / DM) + LN_EPS);
#pragma unroll
        for (int j = 0; j < 4; ++j) { const int col = 4 * lane + 256 * j; const f32x4 g = *(const f32x4*)(C.ln2g + col), be = *(const f32x4*)(C.ln2b + col); f32x4 o;
#pragma unroll
            for (int i = 0; i < 4; ++i) o[i] = v[j][i] * rstd * g[i] + be[i];
            *(f32x4*)(C.out + (size_t)t * DM + col) = o; }
    }
}

namespace pg8 {
#define PG8_LAS __attribute__((address_space(3)))
constexpr int BM = 256, BK = 64, HALF = 128, HTB = HALF * BK * 2, STAGE_BYTES = 8 * HTB;
__host__ __device__ __forceinline__ int lds_byte(int r, int c) { const int st = (r >> 4) * 2 + (c >> 5), rr = r & 15, cc = c & 31, ob = rr * 64 + cc * 2; return st * 1024 + (ob ^ (((ob >> 9) & 1) << 5)); }
__host__ __device__ __forceinline__ void stage_rc(int b, int& R, int& C) { const int st = b / 1024, sb = b % 1024, swz = sb ^ (((sb >> 9) & 1) << 5); R = (st >> 1) * 16 + swz / 64; C = (st & 1) * 32 + (swz % 64) / 2; }
__host__ __device__ __forceinline__ int perm32(int rho) { const int n = rho >> 4, i = rho & 15; return 8 * (i >> 2) + 4 * n + (i & 3); }
struct Unit { int pm, pn, kind; };

template <class F> struct EpiRow8 { static constexpr bool PERM = true; F f;
    __device__ __forceinline__ void operator()(const f32x4 (&acc)[2][2][4][2], const Unit& u, int wr, int wc, int fr, int fq) const {
        const int row0 = u.pm * BM + wr * 64 + fr, col0 = u.pn * BM + wc * 32 + 8 * fq;
#pragma unroll
        for (int ai = 0; ai < 2; ++ai)
#pragma unroll
            for (int m = 0; m < 4; ++m)
#pragma unroll
                for (int bj = 0; bj < 2; ++bj) { const f32x4 a = acc[ai][bj][m][0], b = acc[ai][bj][m][1]; const float v[8] = {a[0], a[1], a[2], a[3], b[0], b[1], b[2], b[3]};
                    f.row8(u.kind, row0 + ai * HALF + m * 16, col0 + bj * HALF, v); }
    } };
struct EpiProj { static constexpr bool PERM = true; bf16* PROJ; float* ssq_q; float* ssq_kv; bf16* KR; const float* cs; const float* sn;
    __device__ __forceinline__ void operator()(const f32x4 (&acc)[2][2][4][2], const Unit& u, int wr, int wc, int fr, int fq) const {
        const int row0 = u.pm * BM + wr * 64 + fr, col0 = u.pn * BM + wc * 32 + 8 * fq;
#pragma unroll
        for (int ai = 0; ai < 2; ++ai)
#pragma unroll
            for (int m = 0; m < 4; ++m) { const int row = row0 + ai * HALF + m * 16;
#pragma unroll
                for (int bj = 0; bj < 2; ++bj) { const f32x4 a = acc[ai][bj][m][0], b = acc[ai][bj][m][1]; const float v[8] = {a[0], a[1], a[2], a[3], b[0], b[1], b[2], b[3]};
                    store8_bf16(PROJ + (size_t)row * NPROJ + col0 + bj * HALF, v); }
                if (u.pn <= 1) {
                    float s = 0.f;
#pragma unroll
                    for (int bj = 0; bj < 2; ++bj) if (bj == 0 || u.pn == 0) {
#pragma unroll
                        for (int n = 0; n < 2; ++n) { const f32x4 x = acc[ai][bj][m][n]; s += (x[0] * x[0] + x[1] * x[1]) + (x[2] * x[2] + x[3] * x[3]); } }
                    s += __shfl_xor(s, 16); s += __shfl_xor(s, 32);
                    if (fq == 0) (u.pn == 0 ? ssq_q : ssq_kv)[(size_t)row * 4 + wc] = s;
                    if (u.pn == 1 && wc == 0) {
                        const f32x4 t1 = acc[ai][1][m][0], t2 = acc[ai][1][m][1], c4 = *(const f32x4*)(cs + (size_t)row * 16 + 4 * fq), s4 = *(const f32x4*)(sn + (size_t)row * 16 + 4 * fq);
                        float o[8];
#pragma unroll
                        for (int i = 0; i < 4; ++i) { o[i] = t1[i] * c4[i] - t2[i] * s4[i]; o[4 + i] = t1[i] * s4[i] + t2[i] * c4[i]; }
                        store8_bf16(KR + (size_t)row * 32 + 8 * fq, o); }
                } }
    } };
struct EpiQKV { static constexpr bool PERM = true; FRowScale fq, fkv;
    __device__ __forceinline__ void operator()(const f32x4 (&acc)[2][2][4][2], const Unit& u, int wr, int wc, int fr, int fq_) const {
        EpiRow8<FRowScale> e{u.kind ? fkv : fq}; e(acc, u, wr, wc, fr, fq_);
    } };
struct EpiY { static constexpr bool PERM = true; float* Y; const float* x; const float* mod;
    __device__ __forceinline__ void operator()(const f32x4 (&acc)[2][2][4][2], const Unit& u, int wr, int wc, int fr, int fq) const {
        const int row0 = u.pm * BM + wr * 64 + fr, col0 = u.pn * BM + wc * 32 + 8 * fq, b = (u.pm * BM) >> 11;
        f32x4 g[2][2];
#pragma unroll
        for (int bj = 0; bj < 2; ++bj) { const float* gp = mod + b * 6144 + 2048 + col0 + bj * HALF; g[bj][0] = *(const f32x4*)gp; g[bj][1] = *(const f32x4*)(gp + 4); }
#pragma unroll
        for (int ai = 0; ai < 2; ++ai) {
            f32x4 xv[4][2][2];
#pragma unroll
            for (int m = 0; m < 4; ++m)
#pragma unroll
                for (int bj = 0; bj < 2; ++bj) { const float* xp = x + (size_t)(row0 + ai * HALF + m * 16) * DM + col0 + bj * HALF; xv[m][bj][0] = *(const f32x4*)xp; xv[m][bj][1] = *(const f32x4*)(xp + 4); }
#pragma unroll
            for (int m = 0; m < 4; ++m)
#pragma unroll
                for (int bj = 0; bj < 2; ++bj) { float* yp = Y + (size_t)(row0 + ai * HALF + m * 16) * DM + col0 + bj * HALF;
                    *(f32x4*)yp = xv[m][bj][0] * ALPHA + g[bj][0] * acc[ai][bj][m][0]; *(f32x4*)(yp + 4) = xv[m][bj][1] * ALPHA + g[bj][1] * acc[ai][bj][m][1]; }
        }
    } };
template <class F> struct EpiPair8 { static constexpr bool PERM = true; F f;
    __device__ __forceinline__ void operator()(const f32x4 (&acc)[2][2][4][2], const Unit& u, int wr, int wc, int fr, int fq) const {
        const int row0 = u.pm * BM + wr * 64 + fr, col0 = u.pn * HALF + wc * 32 + 8 * fq;
#pragma unroll
        for (int ai = 0; ai < 2; ++ai)
#pragma unroll
            for (int m = 0; m < 4; ++m) { const f32x4 a = acc[ai][0][m][0], b = acc[ai][0][m][1], c = acc[ai][1][m][0], d = acc[ai][1][m][1];
                const float g[8] = {a[0], a[1], a[2], a[3], b[0], b[1], b[2], b[3]}, up[8] = {c[0], c[1], c[2], c[3], d[0], d[1], d[2], d[3]};
                f.pair8(row0 + ai * HALF + m * 16, col0, g, up); }
    } };

template <class Epi, class Sched, bool FP8 = false, bool ALIGN_EPI = true, bool SP2 = true>
__device__ __forceinline__ void gemm_phase(PG8_LAS unsigned char* lds, const int KB  , const Sched& S, const Epi& E) {
    const int tid = threadIdx.x, wid = __builtin_amdgcn_readfirstlane(tid >> 6), lane = tid & 63, wr = wid >> 2, wc = wid & 3, fr = lane & 15, fq = lane >> 4;
    const int nt = KB / (BK * 2);
    Unit cur, nxt; int ui = 0;
    if (!S.next(0, cur)) return;
    unsigned voffA[2][2], voffB[2];
#pragma unroll
    for (int i = 0; i < 2; ++i) { int R, C; stage_rc(tid * 16 + i * 8192, R, C); const int Rb = Epi::PERM ? ((R & ~31) + perm32(R & 31)) : R;
        voffB[i] = (unsigned)(Rb * S.ldb) + (unsigned)C * 2u;
#pragma unroll
        for (int h = 0; h < 2; ++h) voffA[h][i] = S.a_rowoff(cur, h * HALF + R) + (unsigned)C * 2u; }
    const size_t kstep = (size_t)(BK * 2);
    const size_t hstepB = (size_t)HALF * S.ldb;
    const unsigned ldsw = (unsigned)wid * 1024u;
    const int aoff = lds_byte(wr * 64 + fr, fq * 8), boff = lds_byte(wc * 32 + fr, fq * 8);
#define PG8_SA(b, h) (((b) * 2 + (h)) * HTB)
#define PG8_SB(b, h) ((4 + (b) * 2 + (h)) * HTB)
#define PG8_STAGE_A(bufoff, gbase, h) do { _Pragma("unroll") for (int _i = 0; _i < 2; ++_i) \
        __builtin_amdgcn_global_load_lds((const unsigned*)((const char*)(gbase) + voffA[h][_i]), (PG8_LAS unsigned*)(lds + (bufoff) + ldsw + _i * 8192), 16, 0, 0); } while (0)
#define PG8_STAGE_B(bufoff, gbase) do { _Pragma("unroll") for (int _i = 0; _i < 2; ++_i) \
        __builtin_amdgcn_global_load_lds((const unsigned*)((const char*)(gbase) + voffB[_i]), (PG8_LAS unsigned*)(lds + (bufoff) + ldsw + _i * 8192), 16, 0, 0); } while (0)
#define PG8_LDA(dst, b, h) do { _Pragma("unroll") for (int m = 0; m < 4; ++m) dst[m] = PG8_CAT(*(const PG8_LAS i32x4*)(lds + PG8_SA(b, h) + aoff + m * 2048), *(const PG8_LAS i32x4*)(lds + PG8_SA(b, h) + aoff + m * 2048 + 1024)); } while (0)
#define PG8_LDB(dst, b, h) do { _Pragma("unroll") for (int n = 0; n < 2; ++n) dst[n] = PG8_CAT(*(const PG8_LAS i32x4*)(lds + PG8_SB(b, h) + boff + n * 2048), *(const PG8_LAS i32x4*)(lds + PG8_SB(b, h) + boff + n * 2048 + 1024)); } while (0)
#define PG8_CAT(x, y) __builtin_shufflevector(x, y, 0, 1, 2, 3, 4, 5, 6, 7)
#define PG8_LO(x) __builtin_bit_cast(bf16x8, __builtin_shufflevector(x, x, 0, 1, 2, 3))
#define PG8_HI(x) __builtin_bit_cast(bf16x8, __builtin_shufflevector(x, x, 4, 5, 6, 7))
#define PG8_MMA(ai, bj, At, Bt) do { __builtin_amdgcn_s_setprio(1); _Pragma("unroll") for (int m = 0; m < 4; ++m) _Pragma("unroll") for (int n = 0; n < 2; ++n) { \
        if constexpr (FP8) asm volatile("v_mfma_f32_16x16x128_f8f6f4 %0, %1, %2, %0" : "+v"(acc[ai][bj][m][n]) : "v"(Bt[n]), "v"(At[m]));   \
        else { acc[ai][bj][m][n] = __builtin_amdgcn_mfma_f32_16x16x32_bf16(PG8_LO(Bt[n]), PG8_LO(At[m]), acc[ai][bj][m][n], 0, 0, 0); \
               acc[ai][bj][m][n] = __builtin_amdgcn_mfma_f32_16x16x32_bf16(PG8_HI(Bt[n]), PG8_HI(At[m]), acc[ai][bj][m][n], 0, 0, 0); } } \
        __builtin_amdgcn_s_setprio(0); } while (0)
#define PG8_WAIT_V(n) asm volatile("s_waitcnt vmcnt(" #n ")" ::: "memory")
#define PG8_WAIT_L(n) asm volatile("s_waitcnt lgkmcnt(" #n ")" ::: "memory")
#define PG8_BAR __builtin_amdgcn_s_barrier()
#define PG8_SCHED __builtin_amdgcn_sched_barrier(0)
    f32x4 acc[2][2][4][2];
#pragma unroll
    for (int a = 0; a < 2; ++a)
#pragma unroll
        for (int b = 0; b < 2; ++b)
#pragma unroll
            for (int m = 0; m < 4; ++m)
#pragma unroll
                for (int n = 0; n < 2; ++n) acc[a][b][m][n] = (f32x4){0.f, 0.f, 0.f, 0.f};
    i32x8 At[4], B0[2], B1[2];
    const char* cA = S.a_base(cur); const char* cB = S.b_base(cur);
    if constexpr (SP2) {
        PG8_STAGE_B(PG8_SB(0, 0), cB); PG8_STAGE_B(PG8_SB(0, 1), cB + hstepB); PG8_STAGE_A(PG8_SA(0, 0), cA, 0); PG8_STAGE_A(PG8_SA(0, 1), cA, 1);
        if (wr == 1) PG8_BAR;
        PG8_WAIT_V(2); PG8_BAR;
        PG8_STAGE_B(PG8_SB(1, 0), cB + kstep); PG8_STAGE_A(PG8_SA(1, 0), cA + kstep, 0); PG8_STAGE_B(PG8_SB(1, 1), cB + hstepB + kstep);
        PG8_WAIT_V(6); PG8_BAR;
    } else {
        PG8_STAGE_B(PG8_SB(0, 0), cB); PG8_STAGE_A(PG8_SA(0, 0), cA, 0); PG8_STAGE_B(PG8_SB(0, 1), cB + hstepB); PG8_STAGE_A(PG8_SA(0, 1), cA, 1);
        if (wr == 1) PG8_BAR;
        PG8_WAIT_V(4); PG8_BAR;
        PG8_STAGE_B(PG8_SB(1, 0), cB + kstep); PG8_STAGE_A(PG8_SA(1, 0), cA + kstep, 0); PG8_STAGE_B(PG8_SB(1, 1), cB + hstepB + kstep);
        PG8_WAIT_V(6); PG8_BAR;
    }
    for (;;) {
        const bool has_next = S.next(ui + 1, nxt);
        const char* nA = has_next ? S.a_base(nxt) : cA; const char* nB = has_next ? S.b_base(nxt) : cB;
#pragma unroll 1
        for (int t = 0; t < nt; t += 2) {
            const bool last = (t == nt - 2);
            const char* a1 = cA + (size_t)(t + 1) * kstep;
            const char* a2 = last ? nA : cA + (size_t)(t + 2) * kstep; const char* b2 = last ? nB : cB + (size_t)(t + 2) * kstep;
            const char* a3 = a2 + kstep; const char* b3 = b2 + kstep;
            if constexpr (SP2) {
            PG8_LDB(B0, 0, 0); PG8_LDB(B1, 0, 1); PG8_SCHED; PG8_LDA(At, 0, 0); PG8_STAGE_A(PG8_SA(1, 1), a1, 1);
            PG8_WAIT_V(8); PG8_WAIT_L(0); PG8_BAR; PG8_MMA(0, 0, At, B0); PG8_MMA(0, 1, At, B1); PG8_BAR; PG8_SCHED;
            PG8_LDA(At, 0, 1); PG8_STAGE_B(PG8_SB(0, 0), b2); PG8_STAGE_B(PG8_SB(0, 1), b2 + hstepB); PG8_STAGE_A(PG8_SA(0, 0), a2, 0);
            PG8_WAIT_V(8); PG8_WAIT_L(0); PG8_BAR; PG8_MMA(1, 0, At, B0); PG8_MMA(1, 1, At, B1); PG8_BAR; PG8_SCHED;
            PG8_LDB(B0, 1, 0); PG8_LDB(B1, 1, 1); PG8_SCHED; PG8_LDA(At, 1, 0); PG8_STAGE_A(PG8_SA(0, 1), a2, 1);
            PG8_WAIT_V(8); PG8_WAIT_L(0); PG8_BAR; PG8_MMA(0, 0, At, B0); PG8_MMA(0, 1, At, B1); PG8_BAR; PG8_SCHED;
            PG8_LDA(At, 1, 1); PG8_STAGE_B(PG8_SB(1, 0), b3); PG8_STAGE_B(PG8_SB(1, 1), b3 + hstepB); PG8_STAGE_A(PG8_SA(1, 0), a3, 0);
            PG8_WAIT_V(8); PG8_WAIT_L(0); PG8_BAR; PG8_MMA(1, 0, At, B0); PG8_MMA(1, 1, At, B1); PG8_BAR; PG8_SCHED;
            } else {
            PG8_LDB(B0, 0, 0); PG8_SCHED; PG8_LDA(At, 0, 0); PG8_STAGE_A(PG8_SA(1, 1), a1, 1);
            PG8_WAIT_L(8); PG8_BAR; PG8_WAIT_L(0); PG8_MMA(0, 0, At, B0); PG8_BAR; PG8_SCHED;
            PG8_LDB(B1, 0, 1); PG8_STAGE_B(PG8_SB(0, 0), b2);
            PG8_BAR; PG8_WAIT_L(0); PG8_MMA(0, 1, At, B1); PG8_BAR;
            PG8_LDA(At, 0, 1); PG8_STAGE_A(PG8_SA(0, 0), a2, 0);
            PG8_BAR; PG8_WAIT_L(0); PG8_MMA(1, 0, At, B0); PG8_BAR; PG8_SCHED;
            PG8_STAGE_B(PG8_SB(0, 1), b2 + hstepB);
            PG8_WAIT_V(6); PG8_BAR; PG8_MMA(1, 1, At, B1); PG8_BAR;
            PG8_LDB(B0, 1, 0); PG8_SCHED; PG8_LDA(At, 1, 0); PG8_STAGE_A(PG8_SA(0, 1), a2, 1);
            PG8_WAIT_L(8); PG8_BAR; PG8_WAIT_L(0); PG8_MMA(0, 0, At, B0); PG8_BAR; PG8_SCHED;
            PG8_LDB(B1, 1, 1); PG8_STAGE_B(PG8_SB(1, 0), b3);
            PG8_BAR; PG8_WAIT_L(0); PG8_MMA(0, 1, At, B1); PG8_BAR;
            PG8_LDA(At, 1, 1); PG8_STAGE_A(PG8_SA(1, 0), a3, 0);
            PG8_BAR; PG8_WAIT_L(0); PG8_MMA(1, 0, At, B0); PG8_BAR; PG8_SCHED;
            PG8_STAGE_B(PG8_SB(1, 1), b3 + hstepB);
            PG8_WAIT_V(6); PG8_BAR; PG8_MMA(1, 1, At, B1); PG8_BAR;
            }
        }
        if constexpr (ALIGN_EPI) { if (wr == 0) PG8_BAR; }
        if constexpr (FP8) asm volatile("s_nop 15\n\ts_nop 7" ::: "memory");
        E(acc, cur, wr, wc, fr, fq);
        if (!has_next) break;
#pragma unroll
        for (int a = 0; a < 2; ++a)
#pragma unroll
            for (int b = 0; b < 2; ++b)
#pragma unroll
                for (int m = 0; m < 4; ++m)
#pragma unroll
                    for (int n = 0; n < 2; ++n) acc[a][b][m][n] = (f32x4){0.f, 0.f, 0.f, 0.f};
        cur = nxt; cA = nA; cB = nB; ++ui;
        if constexpr (ALIGN_EPI) { if (wr == 1) PG8_BAR; }
    }
    PG8_WAIT_V(0);
    if constexpr (!ALIGN_EPI) { if (wr == 0) PG8_BAR; }
    PG8_BAR;
#undef PG8_SA
#undef PG8_SB
#undef PG8_STAGE_A
#undef PG8_STAGE_B
#undef PG8_LDA
#undef PG8_LDB
#undef PG8_MMA
#undef PG8_CAT
#undef PG8_LO
#undef PG8_HI
#undef PG8_WAIT_V
#undef PG8_WAIT_L
#undef PG8_BAR
#undef PG8_SCHED
}
struct SchedDense {
    const char* A; const char* Bt; int lda, ldb; int nM, nN, nwg, G, c;
    __device__ __forceinline__ void init(const void* A_, int lda_, const void* Bt_, int ldb_, int M, int N, int G_, int c_) { A = (const char*)A_; Bt = (const char*)Bt_; lda = lda_ * 2; ldb = ldb_ * 2; nM = M / BM; nN = N / BM; nwg = nM * nN; G = G_; c = c_; }
    __device__ __forceinline__ bool next(int i, Unit& u) const {
        const long L = (long)i * G + c; if (L >= nwg) return false;
        int wgid = (int)L; { const int q = nwg / 8, r = nwg % 8, xcd = wgid % 8, off = wgid / 8; wgid = (xcd < r ? xcd * (q + 1) : r * (q + 1) + (xcd - r) * q) + off; }
        const int nig = 8 * nN, gid = wgid / nig, fm = gid * 8, gsz = (nM - fm) < 8 ? (nM - fm) : 8;
        u.pm = fm + ((wgid % nig) % gsz); u.pn = (wgid % nig) / gsz; u.kind = 0; return true;
    }
    __device__ __forceinline__ const char* a_base(const Unit& u) const { return A + (size_t)u.pm * BM * lda; }
    __device__ __forceinline__ const char* b_base(const Unit& u) const { return Bt + (size_t)u.pn * BM * ldb; }
    __device__ __forceinline__ unsigned a_rowoff(const Unit&, int r) const { return (unsigned)(r * lda); }
};
struct SchedQKV {
    const char* proj; const char* wuq; const char* wukv; int lda, ldb; int G, vcu;
    __device__ __forceinline__ bool next(int i, Unit& u) const {
        const int L = i * G + vcu; if (L >= (T / BM) * 7) return false;
        u.pm = L / 7; const int j = L % 7; u.kind = j < 3 ? 0 : 1; u.pn = j < 3 ? j : j - 3; return true; }
    __device__ __forceinline__ const char* a_base(const Unit& u) const { return proj + ((size_t)u.pm * BM * NPROJ + (u.kind == 1 ? 256 : 0)) * 2; }
    __device__ __forceinline__ const char* b_base(const Unit& u) const { return (u.kind == 1 ? wukv : wuq) + (size_t)u.pn * BM * 256 * 2; }
    __device__ __forceinline__ unsigned a_rowoff(const Unit&, int r) const { return (unsigned)(r * lda); }
};
__device__ __forceinline__ int be_of_vcu(int vcu) { const int x = vcu >> 5, j = vcu & 31; return (j & 15) * 16 + 2 * x + (j >> 4); }
struct SchedUp {
    const char* u2; const int* idx; const char* wgu; int lda, ldb; int G, vcu;
    __device__ __forceinline__ bool next(int i, Unit& u) const { if (i >= 16 || vcu >= 256) return false; u.pm = be_of_vcu(vcu); u.pn = i; u.kind = 0; return true; }
    __device__ __forceinline__ const char* a_base(const Unit& u) const { return u2 + (size_t)(u.pm >> 4) * SEQ * DM; }
    __device__ __forceinline__ const char* b_base(const Unit& u) const { return wgu + ((size_t)(u.pm & 15) * 4096 + (size_t)u.pn * BM) * DM; }
    __device__ __forceinline__ unsigned a_rowoff(const Unit& u, int r) const { return (unsigned)idx[u.pm * CAP + r] * (unsigned)DM; }
};
struct SchedDown {
    const char* h; const char* wd; int lda, ldb; int G, vcu;
    __device__ __forceinline__ bool next(int i, Unit& u) const { if (i >= 4 || vcu >= 256) return false; const int x = vcu >> 5, j = vcu & 31; u.pm = (4 * (j & 3) + i) * 16 + 2 * x + (j >> 4); u.pn = (j >> 2) & 3; u.kind = 0; return true; }
    __device__ __forceinline__ const char* a_base(const Unit& u) const { return h + (size_t)u.pm * BM * FF; }
    __device__ __forceinline__ const char* b_base(const Unit& u) const { return wd + ((size_t)(u.pm & 15) * DM + (size_t)u.pn * BM) * FF; }
    __device__ __forceinline__ unsigned a_rowoff(const Unit&, int r) const { return (unsigned)(r * lda); }
};
}


constexpr int CV_ITEMS = 96, CV_SLOT_BYTES = 2048, CV_LDS_OFF = 109632;
struct ConvStream { int q; int pend0, pend1; };
struct ConvAddr { const float* W; int ldw, n0, kb, up; float scale; unsigned char* WT; };
__device__ __forceinline__ void conv_decode(const Ctx& C, int gw, int q, ConvAddr& a) {
    const int m = q >> 5, i = q & 31, hc = gw + m * 2048;
    if (hc < 4096) { const int e = hc >> 8, r = hc & 255; a.up = r >> 7; const int nseg = r & 127;
        a.W = (a.up ? C.w_up : C.w_gate) + (size_t)e * DM * FF; a.ldw = FF; a.n0 = 16 * nseg; a.kb = i; a.scale = SC_WGU; a.WT = (unsigned char*)C.WGU + (size_t)e * 4096 * DM; }
    else { const int d = hc - 4096, e = d >> 7, r = d & 127, khalf = r >> 6, nseg = r & 63; a.up = -1;
        a.W = C.w_down + (size_t)e * FF * DM; a.ldw = DM; a.n0 = 16 * nseg; a.kb = 32 * khalf + i; a.scale = SC_WD; a.WT = (unsigned char*)C.WD + (size_t)e * DM * FF; }
}
__device__ __forceinline__ void glds16_cv(const void* gsrc, unsigned lds_dst) { unsigned keep;
    asm volatile("s_mov_b32 %0, m0\n\ts_mov_b32 m0, %2\n\ts_nop 0\n\tglobal_load_lds_dwordx4 %1, off\n\ts_mov_b32 m0, %0" : "=&s"(keep) : "v"(gsrc), "s"(lds_dst) : "memory"); }
__device__ __forceinline__ void conv_issue(const Ctx& C, int gw, int q, int slot, int wid, int lane) {
    ConvAddr a; conv_decode(C, gw, q, a);
    const float* src = a.W + (size_t)(32 * a.kb + (lane >> 2)) * a.ldw + a.n0 + 4 * (lane & 3);
    const unsigned dst = (unsigned)__builtin_amdgcn_readfirstlane((int)(unsigned)(size_t)(C.lds + CV_LDS_OFF) + (wid * 2 + slot) * CV_SLOT_BYTES);
    glds16_cv(src, dst); glds16_cv(src + (size_t)16 * a.ldw, dst + 1024);
}
__device__ __forceinline__ void conv_process(const Ctx& C, int gw, int q, int slot, int wid, int lane) {
    ConvAddr a; conv_decode(C, gw, q, a);
    const int n = lane & 15, kg = lane >> 4;
    const LAS float* img = (const LAS float*)(C.lds + CV_LDS_OFF + (wid * 2 + slot) * CV_SLOT_BYTES) + (8 * kg) * 16 + n;
    float v[8];
#pragma unroll
    for (int i = 0; i < 8; ++i) v[i] = img[i * 16] * a.scale;
    u32x2 w; w.x = cvt4_fp8(v[0], v[1], v[2], v[3]); w.y = cvt4_fp8(v[4], v[5], v[6], v[7]);
    const int c = a.n0 + n;
    if (a.up >= 0) *(GAS u32x2*)(a.WT + (size_t)((c >> 7) * 256 + (c & 127) + a.up * 128) * DM + 32 * a.kb + 8 * kg) = w;
    else *(GAS u32x2*)(a.WT + (size_t)c * FF + 32 * a.kb + 8 * kg) = w;
}
__device__ __forceinline__ void conv_flush(const Ctx& C, ConvStream& cs, int gw, int wid, int lane) {
    asm volatile("s_waitcnt vmcnt(0)" ::: "memory");
    if (cs.pend0 >= 0) { conv_process(C, gw, cs.pend0, 0, wid, lane); cs.pend0 = -1; }
    if (cs.pend1 >= 0) { conv_process(C, gw, cs.pend1, 1, wid, lane); cs.pend1 = -1; }
    while (cs.q < CV_ITEMS) { conv_issue(C, gw, cs.q, 0, wid, lane); asm volatile("s_waitcnt vmcnt(0)" ::: "memory"); conv_process(C, gw, cs.q, 0, wid, lane); ++cs.q; }
}

namespace att {
using f32x16 = __attribute__((ext_vector_type(16))) float;
using s16x4  = __attribute__((ext_vector_type(4))) short;
constexpr int SHM_V = 16384, SHM_K = 16384;
constexpr int NSLOT = 3;
constexpr int L_V = 0, L_K = NSLOT * SHM_V, L_WS = L_K + NSLOT * SHM_K, L_KPOS = L_WS + 8 * 64 * 4, L_TAB = L_KPOS + SEQ * 4, L_Q = L_TAB + 272 * 4, L_END = L_Q + 8 * 4096;
#ifndef ATT_SDEPTH
#define ATT_SDEPTH 2
#endif
constexpr float THR2 = 11.5f;
#define ATT_KSWZ(row, colB) ((row) * 256 + ((colB) ^ (((row) & 15) << 4)))
#define ATT_SBAR() __builtin_amdgcn_sched_barrier(0)
__device__ __forceinline__ int crow(int r, int hi) { return (r & 3) + 8 * (r >> 2) + 4 * hi; }
__device__ __forceinline__ unsigned cvtpk(float lo, float hi) { unsigned r; asm volatile("v_cvt_pk_bf16_f32 %0, %1, %2" : "=v"(r) : "v"(lo), "v"(hi)); return r; }
__device__ __forceinline__ int v_st(int k, int c) { const int kk = (k & ~0xC) | ((k & 4) << 1) | ((k & 8) >> 1); return ((kk >> 3) * 4 + (c >> 5)) * 512 + ((kk & 7) * 32 + (c & 31)) * 2; }
__device__ __forceinline__ int v_rd_base(int lane) { return ((lane & 3) << 3) | (((lane >> 2) & 3) << 6) | (((lane >> 4) & 1) << 5) | (((lane >> 5) & 1) << 11); }
constexpr int v_rd_off(int d0, int ks, int half) { return d0 * 512 + ks * 4096 + half * 256; }
typedef short v4i16_t __attribute__((ext_vector_type(4)));
struct VFrag { s16x4 l0, h0, l1, h1, l2, h2, l3, h3; };
template <int OFF> __device__ __forceinline__ s16x4 tr_read(const LAS char* vp) { return __builtin_bit_cast(s16x4, __builtin_amdgcn_ds_read_tr16_b64_v4i16((LAS v4i16_t*)(vp + OFF))); }
template <int D0> __device__ __forceinline__ void v_rd(VFrag& f, const LAS char* vb) {
    f.l0 = tr_read<v_rd_off(D0, 0, 0)>(vb); f.h0 = tr_read<v_rd_off(D0, 0, 1)>(vb); f.l1 = tr_read<v_rd_off(D0, 1, 0)>(vb); f.h1 = tr_read<v_rd_off(D0, 1, 1)>(vb);
    f.l2 = tr_read<v_rd_off(D0, 2, 0)>(vb); f.h2 = tr_read<v_rd_off(D0, 2, 1)>(vb); f.l3 = tr_read<v_rd_off(D0, 3, 0)>(vb); f.h3 = tr_read<v_rd_off(D0, 3, 1)>(vb);
}
__device__ __forceinline__ void v_mm(f32x16& od, const VFrag& f, bf16x8 pa0, bf16x8 pa1, bf16x8 pa2, bf16x8 pa3) {
#define ATT_PK(L, H) (bf16x8){L[0], L[1], L[2], L[3], H[0], H[1], H[2], H[3]}
    od = __builtin_amdgcn_mfma_f32_32x32x16_bf16(pa0, ATT_PK(f.l0, f.h0), od, 0, 0, 0);
    od = __builtin_amdgcn_mfma_f32_32x32x16_bf16(pa1, ATT_PK(f.l1, f.h1), od, 0, 0, 0);
    od = __builtin_amdgcn_mfma_f32_32x32x16_bf16(pa2, ATT_PK(f.l2, f.h2), od, 0, 0, 0);
    od = __builtin_amdgcn_mfma_f32_32x32x16_bf16(pa3, ATT_PK(f.l3, f.h3), od, 0, 0, 0);
#undef ATT_PK
}
template <int NDV> __device__ __forceinline__ void pv_all(f32x16 (&o)[NDV], const LAS char* vb, bf16x8 pa0, bf16x8 pa1, bf16x8 pa2, bf16x8 pa3) {
    VFrag fa, fb;
    v_rd<0>(fa, vb); v_rd<1>(fb, vb); ATT_SBAR();
    v_mm(o[0], fa, pa0, pa1, pa2, pa3); ATT_SBAR();
    if constexpr (NDV == 4) {
        v_rd<2>(fa, vb); ATT_SBAR(); v_mm(o[1], fb, pa0, pa1, pa2, pa3); ATT_SBAR();
        v_rd<3>(fb, vb); ATT_SBAR(); v_mm(o[2], fa, pa0, pa1, pa2, pa3); ATT_SBAR();
        v_mm(o[3], fb, pa0, pa1, pa2, pa3);
    } else {
        v_mm(o[1], fb, pa0, pa1, pa2, pa3);
    }
}
__device__ __forceinline__ void glds16(const void* gsrc, unsigned lds_dst) { unsigned keep;
    asm volatile("s_mov_b32 %0, m0\n\ts_mov_b32 m0, %2\n\ts_nop 0\n\tglobal_load_lds_dwordx4 %1, off\n\ts_mov_b32 m0, %0" : "=&s"(keep) : "v"(gsrc), "s"(lds_dst) : "memory"); }
template <int NDQ, bool QLDS> __device__ __forceinline__ void qkt(f32x16& p0, f32x16& p1, const LAS char* Kl, const bf16x8 (&qr)[NDQ], const LAS char* ql, int r32, int hi, const f32x16& negm) {
#pragma unroll
    for (int d0 = 0; d0 < NDQ; ++d0) { const int cb = (d0 * 16 + hi * 8) * 2;
        const bf16x8 b0 = *(const LAS bf16x8*)(Kl + ATT_KSWZ(r32, cb)), b1 = *(const LAS bf16x8*)(Kl + ATT_KSWZ(32 + r32, cb));
        bf16x8 q; if constexpr (QLDS) q = *(const LAS bf16x8*)(ql + d0 * 1024); else q = qr[d0];
        if (d0 == 0) { p0 = __builtin_amdgcn_mfma_f32_32x32x16_bf16(b0, q, negm, 0, 0, 0); p1 = __builtin_amdgcn_mfma_f32_32x32x16_bf16(b1, q, negm, 0, 0, 0); }
        else { p0 = __builtin_amdgcn_mfma_f32_32x32x16_bf16(b0, q, p0, 0, 0, 0); p1 = __builtin_amdgcn_mfma_f32_32x32x16_bf16(b1, q, p1, 0, 0, 0); } }
}
#define ATT_MX3(a, b, c) __builtin_fmaxf(__builtin_fmaxf((a), (b)), (c))
template <bool BAND, bool FIRST> __device__ __forceinline__ void partialSM(f32x16& p0, f32x16& p1, float& mhat, f32x16& negm, float ccur, float& alpha, const LAS int* kposl, const LAS float* tabl, int qpos, int hi) {
    if constexpr (BAND) {
#pragma unroll
        for (int r = 0; r < 16; ++r) { const int kc = crow(r, hi); int r0 = kposl[kc] - qpos, r1 = kposl[32 + kc] - qpos;
            r0 = r0 < -128 ? -128 : (r0 > 128 ? 128 : r0); r1 = r1 < -128 ? -128 : (r1 > 128 ? 128 : r1);
            p0[r] += tabl[r0 + 128]; p1[r] += tabl[r1 + 128];
            if ((r & 3) == 3) asm volatile("" ::: "memory"); }
    }
    float a = ATT_MX3(p0[0], p0[1], p1[0]), b = ATT_MX3(p0[2], p0[3], p1[1]); a = ATT_MX3(a, p1[2], p1[3]);
#pragma unroll
    for (int r = 4; r < 16; r += 4) { a = ATT_MX3(a, p0[r], p0[r + 1]); b = ATT_MX3(b, p0[r + 2], p0[r + 3]); a = ATT_MX3(a, p1[r], p1[r + 1]); b = ATT_MX3(b, p1[r + 2], p1[r + 3]); }
    float rm = __builtin_fmaxf(a, b);
    { auto rr = __builtin_amdgcn_permlane32_swap(__float_as_uint(rm), __float_as_uint(rm), false, false); rm = __builtin_fmaxf(__uint_as_float(rr[0]), __uint_as_float(rr[1])); }
    alpha = 1.f;
    if (FIRST || __builtin_expect(__any(rm > THR2), 0)) {
        const float dl = FIRST ? rm : __builtin_fmaxf(rm, 0.f);
        mhat += dl;
#pragma unroll
        for (int r = 0; r < 16; ++r) { p0[r] -= dl; p1[r] -= dl; }
        const float nm = ccur - mhat;
#pragma unroll
        for (int r = 0; r < 16; ++r) negm[r] = nm;
        asm volatile("" : "+v"(negm));
        if (!FIRST) alpha = __builtin_amdgcn_exp2f(-dl);
    }
#pragma unroll
    for (int r = 0; r < 16; ++r) p0[r] = __builtin_amdgcn_exp2f(p0[r]);
}
__device__ __forceinline__ void finishSM(f32x16& p0, f32x16& p1, float alpha, float& l_reg, bf16x8& pa0, bf16x8& pa1, bf16x8& pa2, bf16x8& pa3) {
#pragma unroll
    for (int r = 0; r < 16; ++r) p1[r] = __builtin_amdgcn_exp2f(p1[r]);
    float ps = 0, ps2 = 0;
#pragma unroll
    for (int r = 0; r < 16; ++r) { ps += p0[r]; ps2 += p1[r]; }
    ps += ps2;
    { auto rr = __builtin_amdgcn_permlane32_swap(__float_as_uint(ps), __float_as_uint(ps), false, false); ps = __uint_as_float(rr[0]) + __uint_as_float(rr[1]); }
    l_reg = l_reg * alpha + ps;
#define ATT_PK8(P, BASE, OUT) do { u32x4 w = {cvtpk(P[BASE + 0], P[BASE + 1]), cvtpk(P[BASE + 2], P[BASE + 3]), cvtpk(P[BASE + 4], P[BASE + 5]), cvtpk(P[BASE + 6], P[BASE + 7])}; OUT = __builtin_bit_cast(bf16x8, w); } while (0)
    ATT_PK8(p0, 0, pa0); ATT_PK8(p0, 8, pa1); ATT_PK8(p1, 0, pa2); ATT_PK8(p1, 8, pa3);
#undef ATT_PK8
}

struct DmaSrc { const bf16* k0; const bf16* k1; const bf16* v0; const bf16* v1; int kp0, kp1, vp; };
template <int NDQ, int NDV, bool DIFF>
__device__ __forceinline__ void attn_pass_dma(const Ctx& C, ConvStream& cs, LAS char* lds, const int tid, const bf16x8 (&qr)[NDQ], const DmaSrc& S, f32x16 (&o)[NDV], float& l_out,
                                              int qpos, int qmn, int qmx, const int* pmm, float cL, float cR) {
    const int wid = __builtin_amdgcn_readfirstlane(tid >> 6), lane = tid & 63, r32 = lane & 31, hi = lane >> 5;
    LAS char* V_lds = lds + L_V; LAS char* K_lds = lds + L_K;
    LAS float* al_l = (LAS float*)(lds + L_WS) + wid * 64 + 32;
    LAS int* kposl = (LAS int*)(lds + L_KPOS); const LAS float* tabl = (const LAS float*)(lds + L_TAB);
    float mhat = 0.f, l_reg = 0.f, ccur = 0.f; f32x16 negm;
#pragma unroll
    for (int r = 0; r < 16; ++r) negm[r] = 0.f;
#pragma unroll
    for (int d = 0; d < NDV; ++d)
#pragma unroll
        for (int r = 0; r < 16; ++r) o[d][r] = 0.f;
    const LAS char* vb0 = V_lds + v_rd_base(lane);
    const int kdst_a = (int)(unsigned)(size_t)(K_lds + wid * 2048);
    const int vdst_a = (int)(unsigned)(size_t)(V_lds + wid * 2048);
#define DMA_K(t, so) do { glds16(S.k0 + (size_t)(t) * 64 * S.kp0, (unsigned)__builtin_amdgcn_readfirstlane(kdst_a + (so))); \
                          glds16(S.k1 + (size_t)(t) * 64 * S.kp1, (unsigned)__builtin_amdgcn_readfirstlane(kdst_a + (so) + 1024)); } while (0)
#define DMA_V(t, so) do { glds16(S.v0 + (size_t)(t) * 64 * S.vp, (unsigned)__builtin_amdgcn_readfirstlane(vdst_a + (so))); \
                          if constexpr (NDV == 4) glds16(S.v1 + (size_t)(t) * 64 * S.vp, (unsigned)__builtin_amdgcn_readfirstlane(vdst_a + (so) + 1024)); } while (0)
#define DMA_WAIT_BAR(n) asm volatile("s_waitcnt vmcnt(" #n ") lgkmcnt(0)\n\ts_barrier" ::: "memory")
#define ATT_RESC(a) do { if (__any((a) < 1.f)) { if (hi == 0) al_l[r32] = (a); asm volatile("s_waitcnt lgkmcnt(0)" ::: "memory"); \
    _Pragma("unroll") for (int d = 0; d < NDV; ++d) _Pragma("unroll") for (int r = 0; r < 16; ++r) o[d][r] *= al_l[crow(r, hi)]; } } while (0)
#define ATT_CLASS(j, band) do { band = false; if constexpr (DIFF) { float ci_ = 0.f; \
    if ((mask_r >> (j)) & 1u) ci_ = cR; else if ((mask_l >> (j)) & 1u) ci_ = cL; else band = true; \
    if (ci_ != ccur) { ccur = ci_; const float nm_ = ccur - mhat; _Pragma("unroll") for (int r = 0; r < 16; ++r) negm[r] = nm_; asm volatile("" : "+v"(negm)); } } } while (0)
#define ATT_PSM(P0, P1, AL, band, tile, FIRST) do { if (DIFF && (band)) partialSM<true, FIRST>(P0, P1, mhat, negm, ccur, AL, kposl + (tile) * 64, tabl, qpos, hi); else partialSM<false, FIRST>(P0, P1, mhat, negm, ccur, AL, kposl, tabl, qpos, hi); } while (0)
    f32x16 pA0, pA1, pB0, pB1; float alA, alB; bool band; bf16x8 pa0, pa1, pa2, pa3; constexpr int NT = SEQ / 64;
    unsigned mask_r = 0u, mask_l = 0u;
    if constexpr (DIFF) { const int kmn_ = __hip_atomic_load(pmm + 2 * (lane & 31), RLX_AGENT), kmx_ = __hip_atomic_load(pmm + 2 * (lane & 31) + 1, RLX_AGENT);
        mask_r = (unsigned)__ballot(kmn_ - qmx >= 128); mask_l = (unsigned)__ballot(qmn - kmx_ >= 128); }
    asm volatile("s_waitcnt vmcnt(0)" ::: "memory");
    int s0 = 0, s1 = SHM_K, s2 = 2 * SHM_K;
#define ATT_ROT() do { const int t_ = s0; s0 = s1; s1 = s2; s2 = t_; } while (0)
    DMA_K(0, 0); DMA_V(0, 0); DMA_K(1, SHM_K);
    DMA_WAIT_BAR(0);
    DMA_K(2, s2); DMA_V(1, s1);
    ATT_CLASS(0, band); qkt<NDQ, false>(pA0, pA1, K_lds + s0, qr, nullptr, r32, hi, negm); ATT_PSM(pA0, pA1, alA, band, 0, true);
    if constexpr (NDV == 4) DMA_WAIT_BAR(4); else DMA_WAIT_BAR(3);
    ATT_ROT();
    int sv = 0;
    const int cv_gw = C.vcu * NWAVES + wid;
#define CV_HOOK(j) do { cvact = false; if (cs.q < CV_ITEMS) { const int sl_ = (j) & 1; const int pq_ = sl_ ? cs.pend1 : cs.pend0; \
        if (pq_ >= 0) conv_process(C, cv_gw, pq_, sl_, wid, lane); \
        conv_issue(C, cv_gw, cs.q, sl_, wid, lane); if (sl_) cs.pend1 = cs.q; else cs.pend0 = cs.q; ++cs.q; cvact = true; } } while (0)
#define ATT_STEP(C0, C1, ALC, P0, P1, ALP, j, HASK, HASV, NW, NWC) do { \
        if (HASK) DMA_K((j) + 2, s2); \
        if (HASV) DMA_V((j) + 1, s1); \
        CV_HOOK(j); \
        ATT_SBAR(); ATT_CLASS(j, band); qkt<NDQ, false>(C0, C1, K_lds + s0, qr, nullptr, r32, hi, negm); \
        finishSM(P0, P1, ALP, l_reg, pa0, pa1, pa2, pa3); ATT_SBAR(); \
        pv_all<NDV>(o, vb0 + sv, pa0, pa1, pa2, pa3); ATT_PSM(C0, C1, ALC, band, j, false); \
        ATT_RESC(ALC); \
        if (cvact) DMA_WAIT_BAR(NWC); else DMA_WAIT_BAR(NW); sv = s0; ATT_ROT(); } while (0)
    bool cvact = false;
    constexpr int NW_ = (NDV == 4) ? 4 : 3;
#pragma unroll 1
    for (int j = 1; j + 3 < NT; j += 2) {
        if constexpr (NDV == 4) { ATT_STEP(pB0, pB1, alB, pA0, pA1, alA, j, true, true, 4, 6); ATT_STEP(pA0, pA1, alA, pB0, pB1, alB, j + 1, true, true, 4, 6); }
        else { ATT_STEP(pB0, pB1, alB, pA0, pA1, alA, j, true, true, 3, 5); ATT_STEP(pA0, pA1, alA, pB0, pB1, alB, j + 1, true, true, 3, 5); }
    }
    ATT_STEP(pB0, pB1, alB, pA0, pA1, alA, NT - 3, true, true, 0, 0);
    ATT_STEP(pA0, pA1, alA, pB0, pB1, alB, NT - 2, false, true, 0, 0);
    ATT_STEP(pB0, pB1, alB, pA0, pA1, alA, NT - 1, false, false, 0, 0);
    finishSM(pB0, pB1, alB, l_reg, pa0, pa1, pa2, pa3); ATT_SBAR();
    pv_all<NDV>(o, vb0 + sv, pa0, pa1, pa2, pa3);
    l_out = l_reg;
    (void)NW_;
    __syncthreads();
#undef DMA_K
#undef DMA_V
#undef DMA_WAIT_BAR
#undef ATT_RESC
#undef ATT_CLASS
#undef ATT_PSM
#undef ATT_STEP
#undef CV_HOOK
#undef ATT_ROT
}
__device__ __forceinline__ void row_recip(LAS float* li_l, float l_reg, int r32, int hi, float (&rli)[16]) {
    if (hi == 0) li_l[r32] = l_reg; asm volatile("s_waitcnt lgkmcnt(0)" ::: "memory");
#pragma unroll
    for (int r = 0; r < 16; ++r) rli[r] = __builtin_amdgcn_rcpf(li_l[crow(r, hi)]);
    asm volatile("s_waitcnt lgkmcnt(0)" ::: "memory");
}
__device__ __forceinline__ void mla_unit(const Ctx& C, ConvStream& cs, int b, int h, int qb) {
    LAS char* lds = (LAS char*)C.lds;
    int tid = threadIdx.x; asm volatile("" : "+v"(tid));
    const int wid = __builtin_amdgcn_readfirstlane(tid >> 6), lane = tid & 63, r32 = lane & 31, hi = lane >> 5;
    const int t0 = b * SEQ + qb * 256 + wid * 32;
    bf16x8 qr[6];
    const bf16* qrow = C.Q + (size_t)(t0 + r32) * 768;
#pragma unroll
    for (int d0 = 0; d0 < 4; ++d0) qr[d0] = *(const bf16x8*)(qrow + h * 64 + d0 * 16 + hi * 8);
#pragma unroll
    for (int d0 = 4; d0 < 6; ++d0) { const int fqi = 2 * (d0 - 4) + hi; const u32x4 w = *(const u32x4*)(qrow + 512 + h * 32 + (d0 - 4) * 16 + hi * 8);
        const f32x4 c4 = *(const f32x4*)(C.CS + (size_t)(t0 + r32) * 16 + 4 * fqi), s4 = *(const f32x4*)(C.SN + (size_t)(t0 + r32) * 16 + 4 * fqi);
        const float t1[4] = {bflo(w.x), bfhi(w.x), bflo(w.y), bfhi(w.y)}, t2[4] = {bflo(w.z), bfhi(w.z), bflo(w.w), bfhi(w.w)};
        float a[4], bb[4];
#pragma unroll
        for (int i = 0; i < 4; ++i) { a[i] = t1[i] * c4[i] - t2[i] * s4[i]; bb[i] = t1[i] * s4[i] + t2[i] * c4[i]; }
        u32x4 ww; ww.x = pk2(a[0], a[1]); ww.y = pk2(a[2], a[3]); ww.z = pk2(bb[0], bb[1]); ww.w = pk2(bb[2], bb[3]); qr[d0] = __builtin_bit_cast(bf16x8, ww); }
    DmaSrc S;
    {   const size_t kb = (size_t)b * SEQ;
#pragma unroll
        for (int i = 0; i < 2; ++i) { const int row = 8 * wid + 4 * i + (lane >> 4), c = (lane & 15) ^ (row & 15); const bf16* p; int pitch;
            if (c < 8) { p = C.KV + (kb + row) * 1024 + h * 64 + 8 * c; pitch = 1024; } else { p = C.KR + (kb + row) * 32 + 8 * (c & 3); pitch = 32; }
            if (i == 0) { S.k0 = p; S.kp0 = pitch; } else { S.k1 = p; S.kp1 = pitch; } }
        const int rin = (lane >> 2) & 7, key = 16 * (wid >> 1) + 8 * (rin >> 2) + 4 * (wid & 1) + (rin & 3);
        S.v0 = C.KV + (kb + key) * 1024 + 512 + h * 64 + 32 * (lane >> 5) + 8 * (lane & 3); S.v1 = S.v0; S.vp = 1024; }
    f32x16 o[2]; float l;
    attn_pass_dma<6, 2, false>(C, cs, lds, tid, qr, S, o, l, 0, 0, 0, nullptr, 0.f, 0.f);
    float rli[16]; row_recip((LAS float*)(lds + L_WS) + wid * 64, l, r32, hi, rli);
    bf16* ao = C.AO + (size_t)t0 * DM + h * 64; const int loff = hi * 4 * DM + r32;
#pragma unroll
    for (int r = 0; r < 16; ++r) {
#pragma unroll
        for (int d0 = 0; d0 < 2; ++d0) ao[crow(r, 0) * DM + d0 * 32 + loff] = (bf16)f2bf(o[d0][r] * rli[r]); }
}
__device__ __forceinline__ void diff_unit(const Ctx& C, ConvStream& cs, int b, int h, int qb) {
    LAS char* lds = (LAS char*)C.lds;
    int tid = threadIdx.x; asm volatile("" : "+v"(tid));
    const int wid = __builtin_amdgcn_readfirstlane(tid >> 6);
    const int t0 = b * SEQ + qb * 256 + wid * 32;
    LAS float* tabl = (LAS float*)(lds + L_TAB);
    if (tid < 257) tabl[tid] = __hip_atomic_load(C.MISC + 64 + h * 260 + tid, RLX_AGENT);
    { LAS int* kposl = (LAS int*)(lds + L_KPOS);
#pragma unroll
      for (int i = 0; i < SEQ / NTHREADS; ++i) kposl[tid + i * NTHREADS] = C.pos[b * SEQ + tid + i * NTHREADS]; }
    const float cL = __hip_atomic_load(C.MISC + 64 + h * 260 + 0, RLX_AGENT), cR = __hip_atomic_load(C.MISC + 64 + h * 260 + 256, RLX_AGENT);
    const float lam = __hip_atomic_load(C.MISC, RLX_AGENT);
    const int qpos = C.pos[t0 + (tid & 31)]; int qmn = qpos, qmx = qpos;
#pragma unroll
    for (int o_ = 1; o_ < 64; o_ <<= 1) { const int a = __shfl_xor(qmn, o_), c = __shfl_xor(qmx, o_); qmn = a < qmn ? a : qmn; qmx = c > qmx ? c : qmx; }
    qmn = __builtin_amdgcn_readfirstlane(qmn); qmx = __builtin_amdgcn_readfirstlane(qmx);
    __syncthreads();
    float* scr = C.out + (size_t)t0 * DM + h * 128;
    const int* pmm = C.PMM + b * 64;
#pragma unroll
    for (int m = 0; m < 2; ++m) {
        f32x16 o[4]; float l;
        {
            int tl = threadIdx.x; asm volatile("" : "+v"(tl));
            const int lane = tl & 63, r32 = lane & 31, hi = lane >> 5, sc = (tl & 15) * 8;
            bf16x8 qr[4];
            const bf16* qrow = C.PROJ + (size_t)(t0 + r32) * NPROJ + 512 + (h * 2 + m) * 64;
#pragma unroll
            for (int d0 = 0; d0 < 4; ++d0) qr[d0] = *(const bf16x8*)(qrow + d0 * 16 + hi * 8);
            DmaSrc S;
            {   const size_t kb = (size_t)b * SEQ;
#pragma unroll
                for (int i = 0; i < 2; ++i) { const int row = 8 * wid + 4 * i + (lane >> 4), c = (lane & 15) ^ (row & 15);
                    const bf16* p = C.PROJ + (kb + row) * NPROJ + 1024 + (h * 2 + m) * 64 + 8 * (c & 7);
                    if (i == 0) { S.k0 = p; S.kp0 = NPROJ; } else { S.k1 = p; S.kp1 = NPROJ; } }
                const int rin = (lane >> 2) & 7, key = 16 * (wid >> 1) + 8 * (rin >> 2) + 4 * (wid & 1) + (rin & 3);
                S.v0 = C.PROJ + (kb + key) * NPROJ + 1536 + h * 128 + 32 * (lane >> 5) + 8 * (lane & 3); S.v1 = S.v0 + 64; S.vp = NPROJ; }
            attn_pass_dma<4, 4, true>(C, cs, lds, tl, qr, S, o, l, qpos, qmn, qmx, pmm, cL, cR);
        }
        int te = threadIdx.x; asm volatile("" : "+v"(te));
        const int r32 = te & 31, hi = (te >> 5) & 1, loff = hi * 4 * DM + r32;
        float rli[16]; row_recip((LAS float*)(lds + L_WS) + wid * 64, l, r32, hi, rli);
        if (m == 0) {
#pragma unroll
            for (int r = 0; r < 16; ++r) {
#pragma unroll
                for (int d0 = 0; d0 < 4; ++d0) scr[crow(r, 0) * DM + d0 * 32 + loff] = o[d0][r] * rli[r]; }
        } else {
#pragma unroll
            for (int r = 0; r < 16; ++r) { float s = 0.f;
#pragma unroll
                for (int d0 = 0; d0 < 4; ++d0) { const float a = scr[crow(r, 0) * DM + d0 * 32 + loff] - lam * (o[d0][r] * rli[r]); o[d0][r] = a; s += a * a; }
                s += __shfl_xor(s, 1); s += __shfl_xor(s, 2); s += __shfl_xor(s, 4); s += __shfl_xor(s, 8); s += __shfl_xor(s, 16);
                const float f = (1.0f - LAMBDA_INIT) / sqrtf(s * (1.f / 128.f) + RMS_EPS);
#pragma unroll
                for (int d0 = 0; d0 < 4; ++d0) o[d0][r] *= f;
                asm volatile("" : "+v"(o[0][r]), "+v"(o[1][r]), "+v"(o[2][r]), "+v"(o[3][r]));
                if (r & 1) asm volatile("" ::: "memory"); }
            bf16* ao = C.AO + (size_t)t0 * DM + 512 + h * 128;
#pragma unroll
            for (int d0 = 0; d0 < 4; ++d0) { const float g = C.subln[d0 * 32 + r32];
#pragma unroll
                for (int r = 0; r < 16; ++r) ao[crow(r, 0) * DM + d0 * 32 + loff] = (bf16)f2bf(o[d0][r] * g); }
        }
    }
}
__device__ __forceinline__ void attn_phase(const Ctx& C) {
    ConvStream cs; cs.q = 0; cs.pend0 = -1; cs.pend1 = -1;
#ifndef ATT_SKIP_DIFF
#pragma unroll 1
    for (int U = C.vcu; U < BATCH * 4 * 8; U += C.G) diff_unit(C, cs, U >> 5, (U >> 3) & 3, U & 7);
#endif
#ifndef ATT_SKIP_MLA
#pragma unroll 1
    for (int U = C.vcu; U < BATCH * 8 * 8; U += C.G) mla_unit(C, cs, U >> 6, (U >> 3) & 7, U & 7);
#endif
    { int tl_ = threadIdx.x; asm volatile("" : "+v"(tl_)); conv_flush(C, cs, C.vcu * NWAVES + C.wave, C.wave, tl_ & 63); }
}
}

constexpr int NPHASE = 12;
__global__ void __launch_bounds__(NTHREADS, 2) mega(Args args) {
    extern __shared__ __attribute__((aligned(16))) unsigned char lds[];
    Ctx C; ctx_init(C, args);
    C.lds = (LAS unsigned char*)lds; C.lds_g = lds;
    C.wave = __builtin_amdgcn_readfirstlane((int)threadIdx.x >> 6);
    C.G = gridDim.x; { const int bx = blockIdx.x; C.vcu = (C.G % 8 == 0) ? (bx % 8) * (C.G / 8) + bx / 8 : bx; }
    volatile LAS unsigned* MISCL = (volatile LAS unsigned*)(C.lds + MISC_OFF);
    for (int u = threadIdx.x; u < (LDS_BYTES - LDSCTL_OFF) / 4; u += NTHREADS) ((LAS unsigned*)(C.lds + LDSCTL_OFF))[u] = 0u;
    __syncthreads();
    const int lo = args.ph_lo, hi = args.ph_hi;
    XcdBarrier bar; bar.bar = (unsigned*)(args.ws + WS_CTL) + CW_BAR + args.li * XCD_BAR_WORDS; bar.x = 0; bar.st = nullptr;
    if (hi - lo > 1) bar = xcd_barrier_post((unsigned*)(args.ws + WS_CTL) + CW_BAR + args.li * XCD_BAR_WORDS, MISCL + 8);
#define IN(k) (lo <= (k) && (k) < hi)
#define SEAM(k) do { if (IN(k) && IN((k) + 1)) xcd_barrier(bar); } while (0)
    if (IN(0)) { phase_prep(C); } SEAM(0);
    if (IN(1)) { phase_u(C); } SEAM(1);
    if (IN(2)) {
        pg8::SchedDense S; S.init(C.U, DM, C.WIN, DM, T, NPROJ, C.G, (int)blockIdx.x);
        pg8::EpiProj E{C.PROJ, C.RINVQ, C.RINVKV, C.KR, C.CS, C.SN};
        pg8::gemm_phase(C.lds, DM * 2, S, E);
    } SEAM(2);
    if (IN(4)) {
        pg8::SchedQKV S{(const char*)C.PROJ, (const char*)C.WUQ, (const char*)C.WUKV, NPROJ * 2, 256 * 2, C.G, C.vcu};
        pg8::EpiQKV E{FRowScale{C.Q, 768, C.RINVQ, 1.f / 256.f}, FRowScale{C.KV, 1024, C.RINVKV, 1.f / 128.f}};
        pg8::gemm_phase(C.lds, 256 * 2, S, E);
    } SEAM(4);
    if (IN(5)) { att::attn_phase(C); } SEAM(5);
    if (IN(6)) {
        pg8::SchedDense S; S.init(C.AO, DM, C.WOUT, DM, T, DM, C.G, (int)blockIdx.x);
        pg8::EpiY E{C.Y, C.x, C.MOD};
        pg8::gemm_phase(C.lds, DM * 2, S, E);
    } SEAM(6);
    if (IN(7)) { phase_ln1(C); } SEAM(7);
    if (IN(9)) {
        if (C.vcu < 256) phase_topk(C, ((C.vcu & 15) * 16 + 2 * (C.vcu >> 5) + ((C.vcu >> 4) & 1)), BATCH * NE);
        VM_WAIT(); __syncthreads();
        pg8::SchedUp S{(const char*)C.U2, C.IDX, (const char*)C.WGU, DM, DM, C.G, C.vcu};
        pg8::EpiPair8<FSwi> E{FSwi{(unsigned char*)C.HLO}};
        pg8::gemm_phase<pg8::EpiPair8<FSwi>, pg8::SchedUp, true>(C.lds, DM, S, E);
    } SEAM(9);
    if (IN(10)) {
        pg8::SchedDown S{(const char*)C.HLO, (const char*)C.WD, FF, FF, C.G, C.vcu};
        pg8::EpiRow8<FGate> E{FGate{C.YE, C.GATE}};
        pg8::gemm_phase<pg8::EpiRow8<FGate>, pg8::SchedDown, true>(C.lds, FF, S, E);
    } SEAM(10);
    if (IN(11)) { phase_final(C); }
#undef IN
#undef SEAM
}

extern "C" void kernel_launch(void* const* d_in, const int* in_sizes, int n_in, void* d_out, int out_size, void* d_ws, size_t ws_size, hipStream_t stream) {
    static int grid = 0;
    if (grid == 0) {
        if (n_in != 25 || out_size != T * DM || ws_size < WS_END) { fprintf(stderr, "kernel_launch: unexpected shapes (n_in %d out %d ws %zu, need %zu)\n", n_in, out_size, ws_size, (size_t)WS_END); grid = -1; return; }
        int dev = 0, cus = 0;
        if (hipGetDevice(&dev) != hipSuccess || hipDeviceGetAttribute(&cus, hipDeviceAttributeMultiprocessorCount, dev) != hipSuccess) { grid = -1; return; }
        if (hipFuncSetAttribute((const void*)mega, hipFuncAttributeMaxDynamicSharedMemorySize, LDS_BYTES) != hipSuccess) { fprintf(stderr, "kernel_launch: hipFuncSetAttribute failed\n"); grid = -1; return; }
        int per_cu = 0; (void)hipOccupancyMaxActiveBlocksPerMultiprocessor(&per_cu, (const void*)mega, NTHREADS, LDS_BYTES); (void)hipGetLastError();
        if (per_cu < 1) fprintf(stderr, "kernel_launch: occupancy query reports %d\n", per_cu);
        grid = cus;
        if (grid != 256) fprintf(stderr, "kernel_launch: %d CUs (the expert-GEMM unit maps are built for 256)\n", grid);
    }
    if (grid < 0) return;
    (void)hipMemsetAsync((char*)d_ws + WS_CTL, 0, CTL_BYTES, stream);
    Args a{};
    for (int i = 0; i < 25; ++i) a.in[i] = d_in[i];
    a.out = (float*)d_out; a.ws = (unsigned char*)d_ws; a.ph_lo = 0; a.ph_hi = NPHASE; a.li = 0; a.pad = 0;
    hipLaunchKernelGGL(mega, dim3(grid), dim3(NTHREADS), LDS_BYTES, stream, a);
}
```

```cpp
#include <hip/hip_runtime.h>
#include <cstdio>
#include <cstdint>

constexpr int BATCH = 16, SEQ = 2048, DM = 1024, T = BATCH * SEQ;
constexpr int NE = 16, FF = 2048, CAP = 256, NSEL = BATCH * NE * CAP;
constexpr int NPROJ = 2048;
constexpr float LOG2E = 1.4426950408889634f;
constexpr float MLA_SCALE = 0.10206207261596575f;
constexpr float DIFF_SCALE = 0.125f;
constexpr float ALPHA = 1.189207115002721f;
constexpr float LN_EPS = 1e-5f, RMS_EPS = 1e-6f;
constexpr float LAMBDA_INIT = 0.2f;

constexpr size_t MiB = 1u << 20;
constexpr size_t WS_CTL = 0, CTL_BYTES = 32768;
constexpr size_t WS_MOD = 1 * MiB;
constexpr size_t WS_MISC = 1 * MiB + 512 * 1024;
constexpr size_t WS_PMM = 1 * MiB + 768 * 1024;
constexpr size_t WS_CS = 2 * MiB, WS_SN = 4 * MiB;
constexpr size_t WS_AFF = 6 * MiB;
constexpr size_t WS_IDX = 8 * MiB, WS_GATE = 8 * MiB + 512 * 1024;
constexpr size_t WS_SLOT = 9 * MiB;
constexpr size_t WS_RINVQ = 11 * MiB, WS_RINVKV = 11 * MiB + 512 * 1024;
constexpr size_t WS_KR = 12 * MiB;
constexpr size_t WS_WIN = 14 * MiB, WS_WUQ = 18 * MiB, WS_WUKV = 18 * MiB + 512 * 1024, WS_WOUT = 19 * MiB;
constexpr size_t WS_WD = 22 * MiB;
constexpr size_t WS_WGU = 86 * MiB;
constexpr size_t WS_YE = WS_WGU;
constexpr size_t WS_PROJ = 214 * MiB;
constexpr size_t WS_Y = WS_PROJ, WS_HLO = WS_PROJ;
constexpr size_t WS_Q = 342 * MiB;
constexpr size_t WS_KV = 390 * MiB;
constexpr size_t WS_U2 = 342 * MiB;
constexpr size_t WS_U = 454 * MiB, WS_AO = 454 * MiB;
constexpr size_t WS_HHI = 406 * MiB;
constexpr size_t WS_END = 534 * MiB;
constexpr size_t WS_ODIFF = WS_WGU;

#define GAS __attribute__((address_space(1)))
#define LAS __attribute__((address_space(3)))
typedef unsigned short bf16;
typedef short bf16x8 __attribute__((ext_vector_type(8)));
typedef float f32x4 __attribute__((ext_vector_type(4)));
typedef float f32x2 __attribute__((ext_vector_type(2)));
typedef unsigned u32x4 __attribute__((ext_vector_type(4)));
typedef unsigned u32x2 __attribute__((ext_vector_type(2)));
typedef GAS unsigned gu32;
#define RLX_AGENT __ATOMIC_RELAXED, __HIP_MEMORY_SCOPE_AGENT
#define LDS_WAIT() asm volatile("s_waitcnt lgkmcnt(0)" ::: "memory")
#define VM_WAIT() asm volatile("s_waitcnt vmcnt(0)" ::: "memory")
__device__ __forceinline__ unsigned f2bf(float f) { unsigned u = __builtin_bit_cast(unsigned, f); return (u + 0x7fffu + ((u >> 16) & 1u)) >> 16; }
typedef __bf16 bf16x2_hw __attribute__((ext_vector_type(2)));
__device__ __forceinline__ unsigned pk2(float lo, float hi) { const f32x2 v = {lo, hi}; return __builtin_bit_cast(unsigned, __builtin_convertvector(v, bf16x2_hw)); }
__device__ __forceinline__ float bflo(unsigned w) { return __uint_as_float(w << 16); }
__device__ __forceinline__ float bfhi(unsigned w) { return __uint_as_float(w & 0xffff0000u); }
__device__ __forceinline__ float bf2f(bf16 h) { return __uint_as_float((unsigned)h << 16); }
__device__ __forceinline__ float wave_sum(float v) {
#pragma unroll
    for (int o = 1; o < 64; o <<= 1) v += __shfl_xor(v, o);
    return v;
}
__device__ __forceinline__ float wave_max(float v) {
#pragma unroll
    for (int o = 1; o < 64; o <<= 1) v = fmaxf(v, __shfl_xor(v, o));
    return v;
}
typedef int i32x4 __attribute__((ext_vector_type(4)));
typedef int i32x8 __attribute__((ext_vector_type(8)));
constexpr float FP8_MAX = 448.0f;
constexpr float SC_U2 = 16.0f, SC_WGU = 512.0f, SC_H = 4.0f, SC_WD = 1024.0f;
constexpr float SC_YE = 64.0f;
constexpr float DS_UP = 1.0f / (SC_U2 * SC_WGU), DS_DOWN = 1.0f / (SC_H * SC_WD);
__device__ __forceinline__ unsigned cvt4_fp8(float a, float b, float c, float d) {
    a = __builtin_amdgcn_fmed3f(a, -FP8_MAX, FP8_MAX); b = __builtin_amdgcn_fmed3f(b, -FP8_MAX, FP8_MAX); c = __builtin_amdgcn_fmed3f(c, -FP8_MAX, FP8_MAX); d = __builtin_amdgcn_fmed3f(d, -FP8_MAX, FP8_MAX);
    int w = 0; w = __builtin_amdgcn_cvt_pk_fp8_f32(a, b, w, false); w = __builtin_amdgcn_cvt_pk_fp8_f32(c, d, w, true); return (unsigned)w;
}
__device__ __forceinline__ float silu_f(float g) { return g * __builtin_amdgcn_rcpf(1.0f + __builtin_amdgcn_exp2f(-g * LOG2E)); }

#define XB_TMO      128
#define XB_XCNT(j)  (256  + 64 * (j))
#define XB_XSUB(j)  (1280 + 64 * (j))
#define XB_XGEN(j)  (2304 + 64 * (j))
#define XB_TOP      3328
#define XB_TOPGEN   3392
#define XCD_BAR_WORDS 3456
#define XB_SPIN_CAP (1u << 18)
__device__ __forceinline__ unsigned xb_ld(unsigned* p)              { return __hip_atomic_load(p, __ATOMIC_RELAXED, __HIP_MEMORY_SCOPE_AGENT); }
__device__ __forceinline__ unsigned xb_add(unsigned* p, unsigned v) { return __hip_atomic_fetch_add(p, v, __ATOMIC_RELAXED, __HIP_MEMORY_SCOPE_AGENT); }
__device__ __forceinline__ unsigned xb_xcc_id() { return (unsigned)__builtin_amdgcn_s_getreg((3 << 11) | 20) & 0xFu; }
#define XB_SPIN(cond, bar) do { unsigned _sp = 0; while (cond) { __builtin_amdgcn_s_sleep(1); \
    if ((++_sp & 255u) == 0u) { if (xb_ld(&(bar)[XB_TMO])) break; if (_sp > XB_SPIN_CAP) { atomicAdd(&(bar)[XB_TMO], 1u); break; } } } } while (0)
struct XcdBarrier { unsigned* bar; unsigned x; volatile LAS unsigned* st; };
__device__ __forceinline__ XcdBarrier xcd_barrier_post(unsigned* bar, volatile LAS unsigned* st) {
    XcdBarrier b; b.bar = bar; b.x = xb_xcc_id(); b.st = st;
    if (threadIdx.x == 0) (void)xb_add(&bar[XB_XCNT(b.x)], 1u);
    return b;
}
__device__ __forceinline__ void xcd_barrier_complete(unsigned* bar, unsigned x, unsigned& nloc, unsigned& nx) {
    const unsigned G = gridDim.x * gridDim.y * gridDim.z;
    unsigned sum, cnt, mine, sp = 0u;
    for (;;) {
        sum = 0u; cnt = 0u; mine = 0u;
#pragma unroll
        for (unsigned j = 0; j < 16; ++j) { const unsigned c = xb_ld(&bar[XB_XCNT(j)]); sum += c; cnt += (c > 0u) ? 1u : 0u; mine = (j == x) ? c : mine; }
        if (sum == G) break;
        __builtin_amdgcn_s_sleep(1);
        if ((++sp & 255u) == 0u) { if (xb_ld(&bar[XB_TMO])) break; if (sp > XB_SPIN_CAP) { atomicAdd(&bar[XB_TMO], 1u); break; } }
    }
    nloc = mine > 0u ? mine : 1u; nx = cnt > 0u ? cnt : 1u;
}
__device__ __forceinline__ void xcd_barrier(const XcdBarrier& b) {
    asm volatile("s_waitcnt vmcnt(0)" ::: "memory");
    __syncthreads();
    if (threadIdx.x == 0) {
        unsigned* bar = b.bar;
        __builtin_amdgcn_s_waitcnt(0);
        unsigned nloc = b.st[0], nx = b.st[1];
        if (nloc == 0u) { xcd_barrier_complete(bar, b.x, nloc, nx); b.st[0] = nloc; b.st[1] = nx; }
        const unsigned old = xb_add(&bar[XB_XSUB(b.x)], 1u);
        const unsigned gen = old / nloc;
        if (old + 1u == (gen + 1u) * nloc) {
            __builtin_amdgcn_fence(__ATOMIC_RELEASE, "agent");
            asm volatile("s_waitcnt vmcnt(0)" ::: "memory");
            const unsigned og = xb_add(&bar[XB_TOP], 1u);
            const unsigned tg = og / nx;
            if (og + 1u == (tg + 1u) * nx) xb_add(&bar[XB_TOPGEN], 1u);
            else XB_SPIN(xb_ld(&bar[XB_TOPGEN]) == tg, bar);
            __builtin_amdgcn_fence(__ATOMIC_ACQUIRE, "agent");
            xb_add(&bar[XB_XGEN(b.x)], 1u);
            asm volatile("s_waitcnt vmcnt(0)" ::: "memory");
        } else {
            XB_SPIN(xb_ld(&bar[XB_XGEN(b.x)]) == gen, bar);
            __builtin_amdgcn_fence(__ATOMIC_ACQUIRE, "agent");
            asm volatile("s_waitcnt vmcnt(0)" ::: "memory");
        }
    }
    __syncthreads();
}

constexpr int NWAVES = 8, NTHREADS = 512;
constexpr int RING_BYTES = 147456, LDSCTL_OFF = RING_BYTES, MISC_OFF = LDSCTL_OFF + 320, LDS_BYTES = 148480;
constexpr int CW_BAR = 4096;

struct Args { const void* in[25]; float* out; unsigned char* ws; int ph_lo, ph_hi, li, pad; };

struct Ctx {
    LAS unsigned char* lds; unsigned char* lds_g;
    int wave, vcu, G;
    const float *x, *c, *rel_bias, *w_ada, *b_ada, *w_in, *qnorm, *w_uq, *kvnorm, *w_ukv, *lq1, *lk1, *lq2, *lk2, *subln, *w_out, *ln1g, *ln1b, *w_router, *w_gate, *w_up, *w_down, *ln2g, *ln2b;
    const int* pos;
    float* out; unsigned char* ws;
    float *MOD, *MISC, *CS, *SN, *AFF, *GATE, *RINVQ, *RINVKV, *Y;
    int *PMM, *IDX, *SLOT;
    bf16 *KR, *WIN, *WUQ, *WUKV, *WOUT, *WD, *WGU, *YE, *PROJ, *Q, *KV, *U2, *U, *AO, *HLO, *HHI;
};
__device__ __forceinline__ void ctx_init(Ctx& C, const Args& a) {
    C.x = (const float*)a.in[0]; C.c = (const float*)a.in[1]; C.pos = (const int*)a.in[2]; C.rel_bias = (const float*)a.in[3];
    C.w_ada = (const float*)a.in[4]; C.b_ada = (const float*)a.in[5]; C.w_in = (const float*)a.in[6]; C.qnorm = (const float*)a.in[7];
    C.w_uq = (const float*)a.in[8]; C.kvnorm = (const float*)a.in[9]; C.w_ukv = (const float*)a.in[10];
    C.lq1 = (const float*)a.in[11]; C.lk1 = (const float*)a.in[12]; C.lq2 = (const float*)a.in[13]; C.lk2 = (const float*)a.in[14];
    C.subln = (const float*)a.in[15]; C.w_out = (const float*)a.in[16]; C.ln1g = (const float*)a.in[17]; C.ln1b = (const float*)a.in[18];
    C.w_router = (const float*)a.in[19]; C.w_gate = (const float*)a.in[20]; C.w_up = (const float*)a.in[21]; C.w_down = (const float*)a.in[22];
    C.ln2g = (const float*)a.in[23]; C.ln2b = (const float*)a.in[24];
    C.out = a.out; unsigned char* ws = a.ws; C.ws = ws;
    C.MOD = (float*)(ws + WS_MOD); C.MISC = (float*)(ws + WS_MISC); C.PMM = (int*)(ws + WS_PMM); C.CS = (float*)(ws + WS_CS); C.SN = (float*)(ws + WS_SN);
    C.AFF = (float*)(ws + WS_AFF); C.IDX = (int*)(ws + WS_IDX); C.GATE = (float*)(ws + WS_GATE); C.SLOT = (int*)(ws + WS_SLOT);
    C.RINVQ = (float*)(ws + WS_RINVQ); C.RINVKV = (float*)(ws + WS_RINVKV); C.KR = (bf16*)(ws + WS_KR);
    C.WIN = (bf16*)(ws + WS_WIN); C.WUQ = (bf16*)(ws + WS_WUQ); C.WUKV = (bf16*)(ws + WS_WUKV); C.WOUT = (bf16*)(ws + WS_WOUT);
    C.WD = (bf16*)(ws + WS_WD); C.WGU = (bf16*)(ws + WS_WGU); C.YE = (bf16*)(ws + WS_YE);
    C.PROJ = (bf16*)(ws + WS_PROJ); C.Y = (float*)(ws + WS_Y); C.HLO = (bf16*)(ws + WS_HLO); C.HHI = (bf16*)(ws + WS_HHI);
    C.Q = (bf16*)(ws + WS_Q); C.KV = (bf16*)(ws + WS_KV); C.U2 = (bf16*)(ws + WS_U2); C.U = (bf16*)(ws + WS_U); C.AO = (bf16*)(ws + WS_AO);
}

__device__ __forceinline__ void store8_bf16(bf16* p, const float (&v)[8]) {
    u32x4 w; w.x = pk2(v[0], v[1]); w.y = pk2(v[2], v[3]); w.z = pk2(v[4], v[5]); w.w = pk2(v[6], v[7]); *(u32x4*)p = w;
}
struct FRowScale { bf16* O; int ldc; const float* ssq; float inv_n;
    __device__ __forceinline__ void row8(int kind, int row, int col, const float (&v)[8]) const {
        const f32x4 p = *(const f32x4*)(ssq + (size_t)row * 4); const float s = __builtin_amdgcn_rsqf(((p[0] + p[1]) + (p[2] + p[3])) * inv_n + RMS_EPS); float o[8];
#pragma unroll
        for (int i = 0; i < 8; ++i) o[i] = v[i] * s;
        store8_bf16(O + (size_t)row * ldc + col, o);
    } };
struct FSwi { unsigned char* H;
    __device__ __forceinline__ void pair8(int row, int col, const float (&g)[8], const float (&u)[8]) const {
        float o[8];
#pragma unroll
        for (int i = 0; i < 8; ++i) o[i] = silu_f(g[i] * DS_UP) * (u[i] * (DS_UP * SC_H));
        u32x2 w; w.x = cvt4_fp8(o[0], o[1], o[2], o[3]); w.y = cvt4_fp8(o[4], o[5], o[6], o[7]);
        *(u32x2*)(H + (size_t)row * FF + col) = w;
    } };
struct FGate { bf16* YE; const float* gate;
    __device__ __forceinline__ void row8(int kind, int row, int col, const float (&v)[8]) const {
        const float s = gate[row] * DS_DOWN; float o[8];
#pragma unroll
        for (int i = 0; i < 8; ++i) o[i] = v[i] * s;
        store8_bf16(YE + (size_t)row * DM + col, o);
    } };

__device__ __forceinline__ void tr_item(const float* W, int ldw, int kb, int srccol0, bool perm, float scale, const float* kgain, int kvalid,
                                        bf16* WT, int ldt, int n0, LAS float* scr, int lane) {
    const int k0 = 64 * kb, cl = lane & 31;
    const int sc = perm ? (16 * ((cl >> 2) & 1) + 4 * (cl >> 3) + (cl & 3)) : cl;
#pragma unroll 8
    for (int i = 0; i < 32; ++i) { const int kk = 2 * i + (lane >> 5), k = k0 + kk; float v = 0.f;
        if (srccol0 >= 0 && k < kvalid) { v = W[(size_t)k * ldw + srccol0 + sc] * scale; if (kgain) v *= kgain[k]; }
        scr[kk * 33 + cl] = v; }
    LDS_WAIT(); asm volatile("" ::: "memory");
    const int c = lane & 7;
#pragma unroll
    for (int j = 0; j < 4; ++j) { const int n = (lane >> 3) + 8 * j; const LAS float* s = scr + (8 * c) * 33 + n;
        u32x4 o; o.x = pk2(s[0 * 33], s[1 * 33]); o.y = pk2(s[2 * 33], s[3 * 33]); o.z = pk2(s[4 * 33], s[5 * 33]); o.w = pk2(s[6 * 33], s[7 * 33]);
        *(GAS u32x4*)(WT + (size_t)(n0 + n) * ldt + k0 + 8 * c) = o; }
    LDS_WAIT(); asm volatile("" ::: "memory");
}
__device__ __forceinline__ int t5_bucket(int rel) {
    const int nb = 16, max_exact = 8; int ret = rel > 0 ? nb : 0; const int n = rel < 0 ? -rel : rel;
    const float nf = (float)(n > 1 ? n : 1);
    int large = max_exact + (int)(logf(nf / 8.0f) / 2.772588722239781f * 8.0f);
    large = large < nb - 1 ? large : nb - 1;
    return ret + (n < max_exact ? n : large);
}

#define PHASE_IDS int tid_l_ = threadIdx.x; asm volatile("" : "+v"(tid_l_)); const int tid = tid_l_, lane = tid & 63; (void)lane
__device__ __forceinline__ void phase_prep(const Ctx& C) {
    PHASE_IDS;
    LAS float* scr = (LAS float*)(C.lds + C.wave * 8448);
    const int gw = C.vcu * NWAVES + C.wave, NGW = C.G * NWAVES;
    constexpr int I_IN = 16 * 64, I_UQ = 4 * 24, I_UKV = 4 * 32, I_OUT = 16 * 32, NIT = I_IN + I_UQ + I_UKV + I_OUT;
    for (int it = gw; it < NIT; it += NGW) {
        int r = it;
        if (r < I_IN) { const int kb = r / 64, nb = r % 64, n0 = 32 * nb; int src; bool perm = false; float sc = 1.f;
            if (nb < 12) src = n0; else if (nb == 12) { src = 384; perm = true; } else if (nb < 16) src = -1; else { src = 416 + (n0 - 512); if (n0 < 1024) sc = DIFF_SCALE * LOG2E; }
            tr_item(C.w_in, 1952, kb, src, perm, sc, nullptr, 1024, C.WIN, 1024, n0, scr, lane); continue; }
        r -= I_IN;
        if (r < I_UQ) { const int kb = r / 24, nb = r % 24, n0 = 32 * nb; int src; bool perm = false;
            if (nb < 16) { src = 96 * (n0 >> 6) + (n0 & 63); } else { src = 96 * (nb - 16) + 64; perm = true; }
            tr_item(C.w_uq, 768, kb, src, perm, MLA_SCALE * LOG2E, C.qnorm, 256, C.WUQ, 256, n0, scr, lane); continue; }
        r -= I_UQ;
        if (r < I_UKV) { const int kb = r / 32, nb = r % 32, n0 = 32 * nb; int src;
            if (nb < 16) src = 128 * (n0 >> 6) + (n0 & 63); else { const int n1 = n0 - 512; src = 128 * (n1 >> 6) + 64 + (n1 & 63); }
            tr_item(C.w_ukv, 1024, kb, src, false, 1.f, C.kvnorm, 128, C.WUKV, 256, n0, scr, lane); continue; }
        r -= I_UKV;
        { const int kb = r / 32, nb = r % 32; tr_item(C.w_out, 1024, kb, 32 * nb, false, 1.f, nullptr, 1024, C.WOUT, 1024, 32 * nb, scr, lane); }
    }
    for (int i = (C.vcu * NTHREADS + tid); i < T * 16; i += C.G * NTHREADS) { const int t = i >> 4, j = i & 15;
        const float freq = (float)pow(10000.0, -(double)j / 16.0); const float ang = (float)C.pos[t] * freq; float s, c; sincosf(ang, &s, &c);
        C.CS[i] = c; C.SN[i] = s; }
    for (int i = (C.vcu * NTHREADS + tid); i < BATCH * 32; i += C.G * NTHREADS) { int mn = 0x7fffffff, mx = -0x7fffffff - 1;
        for (int k = 0; k < 64; ++k) { const int p = C.pos[i * 64 + k]; mn = p < mn ? p : mn; mx = p > mx ? p : mx; }
        C.PMM[2 * i] = mn; C.PMM[2 * i + 1] = mx; }
    if (C.vcu == 255 % C.G) {
        for (int i = tid; i < 4 * 257; i += NTHREADS) { const int h = i / 257, r = i % 257 - 128; C.MISC[64 + h * 260 + (r + 128)] = C.rel_bias[t5_bucket(r) * 4 + h] * LOG2E; }
        if (C.wave == 0) { const float a = wave_sum(C.lq1[lane] * C.lk1[lane]), b = wave_sum(C.lq2[lane] * C.lk2[lane]);
            if (lane == 0) C.MISC[0] = expf(a) - expf(b) + LAMBDA_INIT; }
    }
    __syncthreads();
    LAS float* cact = (LAS float*)C.lds;
    LAS float* red = (LAS float*)(C.lds + 65536);
    bool have = false;
    for (int u = C.vcu; u < 192; u += C.G) {
        if (!have) { for (int i = tid; i < 16 * 1024; i += NTHREADS) { const int b = i >> 10, d = i & 1023; const float v = C.c[i]; cact[d * 16 + b] = v / (1.0f + expf(-v)); } have = true; __syncthreads(); }
        const int nl = tid & 31, kc = tid >> 5, n = 32 * u + nl;
        float acc[16];
#pragma unroll
        for (int b = 0; b < 16; ++b) acc[b] = 0.f;
#pragma unroll 8
        for (int i = 0; i < 64; ++i) { const int d = kc * 64 + i; const float w = C.w_ada[(size_t)d * 6144 + n];
#pragma unroll
            for (int q = 0; q < 4; ++q) { const f32x4 ca = *(const LAS f32x4*)(cact + d * 16 + 4 * q); acc[4 * q] += w * ca[0]; acc[4 * q + 1] += w * ca[1]; acc[4 * q + 2] += w * ca[2]; acc[4 * q + 3] += w * ca[3]; } }
#pragma unroll
        for (int b = 0; b < 16; ++b) red[(kc * 16 + b) * 32 + nl] = acc[b];
        __syncthreads();
        { const int b = tid >> 5; float s = C.b_ada[n];
#pragma unroll
            for (int k = 0; k < 16; ++k) s += red[(k * 16 + b) * 32 + nl];
            C.MOD[b * 6144 + n] = s; }
        __syncthreads();
    }
}
__device__ __forceinline__ void phase_u(const Ctx& C) {
    PHASE_IDS;
    for (size_t i = (size_t)C.vcu * NTHREADS + tid; i < (size_t)T * DM / 8; i += (size_t)C.G * NTHREADS) {
        const size_t e = i * 8; const int row = (int)(e >> 10), col = (int)(e & 1023), b = row >> 11;
        const f32x4 x0 = *(const f32x4*)(C.x + e), x1 = *(const f32x4*)(C.x + e + 4);
        const float* sh = C.MOD + b * 6144 + col; const float* sc = sh + 1024;
        const f32x4 h0 = *(const f32x4*)sh, h1 = *(const f32x4*)(sh + 4), c0 = *(const f32x4*)sc, c1 = *(const f32x4*)(sc + 4);
        u32x4 w; w.x = pk2(x0[0] * (1.f + c0[0]) + h0[0], x0[1] * (1.f + c0[1]) + h0[1]); w.y = pk2(x0[2] * (1.f + c0[2]) + h0[2], x0[3] * (1.f + c0[3]) + h0[3]);
        w.z = pk2(x1[0] * (1.f + c1[0]) + h1[0], x1[1] * (1.f + c1[1]) + h1[1]); w.w = pk2(x1[2] * (1.f + c1[2]) + h1[2], x1[3] * (1.f + c1[3]) + h1[3]);
        *(u32x4*)(C.U + e) = w;
    }
}
__device__ __forceinline__ void phase_ln1(const Ctx& C) {
    PHASE_IDS;
    LAS float* wr = (LAS float*)C.lds;
    LAS float* urow = (LAS float*)(C.lds + 65536) + C.wave * 2048;
    for (int i = tid; i < 1024 * 4; i += NTHREADS) { const int d = i >> 2, ch = i & 3; const f32x4 v = *(const f32x4*)(C.w_router + d * 16 + 4 * ch);
        *(LAS f32x4*)(wr + d * 16 + 4 * (ch ^ ((d >> 2) & 3))) = v; }
    __syncthreads();
    const int gw = C.vcu * NWAVES + C.wave, NGW = C.G * NWAVES;
    for (int t0 = gw; t0 + NGW < T; t0 += 2 * NGW) {
        f32x4 v[2][4]; float sum[2] = {0.f, 0.f};
#pragma unroll
        for (int r = 0; r < 2; ++r) { const f32x4* yr = (const f32x4*)(C.Y + (size_t)(t0 + r * NGW) * DM) + lane;
#pragma unroll
            for (int j = 0; j < 4; ++j) v[r][j] = yr[64 * j]; }
#pragma unroll
        for (int r = 0; r < 2; ++r)
#pragma unroll
            for (int j = 0; j < 4; ++j) sum[r] += (v[r][j][0] + v[r][j][1]) + (v[r][j][2] + v[r][j][3]);
        float mean[2], rstd[2];
#pragma unroll
        for (int r = 0; r < 2; ++r) { mean[r] = wave_sum(sum[r]) * (1.f / DM); float s2 = 0.f;
#pragma unroll
            for (int j = 0; j < 4; ++j) { v[r][j] = v[r][j] - mean[r]; s2 += (v[r][j][0] * v[r][j][0] + v[r][j][1] * v[r][j][1]) + (v[r][j][2] * v[r][j][2] + v[r][j][3] * v[r][j][3]); }
            rstd[r] = 1.0f / sqrtf(wave_sum(s2) * (1.f / DM) + LN_EPS); }
#pragma unroll
        for (int r = 0; r < 2; ++r) { const int t = t0 + r * NGW, b = t >> 11; const float* mod = C.MOD + b * 6144;
#pragma unroll
            for (int j = 0; j < 4; ++j) { const int col = 4 * lane + 256 * j;
                const f32x4 g = *(const f32x4*)(C.ln1g + col), be = *(const f32x4*)(C.ln1b + col), sh = *(const f32x4*)(mod + 3072 + col), sc = *(const f32x4*)(mod + 4096 + col);
                f32x4 x1, u2;
#pragma unroll
                for (int i = 0; i < 4; ++i) { x1[i] = v[r][j][i] * rstd[r] * g[i] + be[i]; u2[i] = x1[i] * (1.f + sc[i]) + sh[i]; }
                *(f32x4*)(C.out + (size_t)t * DM + col) = x1;
                *(unsigned*)((unsigned char*)C.U2 + (size_t)t * DM + col) = cvt4_fp8(u2[0] * SC_U2, u2[1] * SC_U2, u2[2] * SC_U2, u2[3] * SC_U2);
                *(LAS f32x4*)(urow + r * 1024 + col) = u2; } }
        LDS_WAIT(); asm volatile("" ::: "memory");
        float lg[32];
#pragma unroll
        for (int e = 0; e < 32; ++e) lg[e] = 0.f;
#pragma unroll 4
        for (int k = 0; k < 16; ++k) { const int d = lane + 64 * k; const float u0 = urow[d], u1 = urow[1024 + d]; const int sw = (d >> 2) & 3;
#pragma unroll
            for (int ch = 0; ch < 4; ++ch) { const f32x4 w = *(const LAS f32x4*)(wr + d * 16 + 4 * (ch ^ sw));
#pragma unroll
                for (int i = 0; i < 4; ++i) { lg[4 * ch + i] += u0 * w[i]; lg[16 + 4 * ch + i] += u1 * w[i]; } } }
        float h16[16];
        { const bool up = (lane & 32) != 0;
#pragma unroll
          for (int i = 0; i < 16; ++i) { const float keep = up ? lg[16 + i] : lg[i], send = up ? lg[i] : lg[16 + i]; h16[i] = keep + __shfl_xor(send, 32); } }
        float h8[8];
        { const bool up = (lane & 16) != 0;
#pragma unroll
          for (int i = 0; i < 8; ++i) { const float keep = up ? h16[8 + i] : h16[i], send = up ? h16[i] : h16[8 + i]; h8[i] = keep + __shfl_xor(send, 16); } }
        float h4[4];
        { const bool up = (lane & 8) != 0;
#pragma unroll
          for (int i = 0; i < 4; ++i) { const float keep = up ? h8[4 + i] : h8[i], send = up ? h8[i] : h8[4 + i]; h4[i] = keep + __shfl_xor(send, 8); } }
        float h2[2];
        { const bool up = (lane & 4) != 0;
#pragma unroll
          for (int i = 0; i < 2; ++i) { const float keep = up ? h4[2 + i] : h4[i], send = up ? h4[i] : h4[2 + i]; h2[i] = keep + __shfl_xor(send, 4); } }
        float lgt;
        { const bool up = (lane & 2) != 0; const float keep = up ? h2[1] : h2[0], send = up ? h2[0] : h2[1]; lgt = keep + __shfl_xor(send, 2); }
        lgt += __shfl_xor(lgt, 1);
        float mx = lgt;
        mx = fmaxf(mx, __shfl_xor(mx, 2)); mx = fmaxf(mx, __shfl_xor(mx, 4)); mx = fmaxf(mx, __shfl_xor(mx, 8)); mx = fmaxf(mx, __shfl_xor(mx, 16));
        const float ex = __builtin_amdgcn_exp2f((lgt - mx) * LOG2E);
        float den = ex;
        den += __shfl_xor(den, 2); den += __shfl_xor(den, 4); den += __shfl_xor(den, 8); den += __shfl_xor(den, 16);
        if ((lane & 1) == 0) { const int r = lane >> 5, e = (((lane >> 4) & 1) << 3) | (((lane >> 3) & 1) << 2) | (((lane >> 2) & 1) << 1) | ((lane >> 1) & 1);
            const int t = t0 + r * NGW, b = t >> 11, s = t & 2047; C.AFF[((size_t)b * 16 + e) * SEQ + s] = ex / den; }
        LDS_WAIT(); asm volatile("" ::: "memory");
    }
}
__device__ __forceinline__ unsigned block_count(LAS unsigned* cnt, int wave, int lane, unsigned c) {
    c += __shfl_xor(c, 1); c += __shfl_xor(c, 2); c += __shfl_xor(c, 4); c += __shfl_xor(c, 8); c += __shfl_xor(c, 16); c += __shfl_xor(c, 32);
    __syncthreads();
    if (lane == 0) cnt[wave] = c;
    __syncthreads();
    unsigned s = 0;
#pragma unroll
    for (int w = 0; w < NWAVES; ++w) s += cnt[w];
    return s;
}
__device__ __forceinline__ unsigned block_excl_scan(LAS unsigned* cnt, int wave, int lane, unsigned c) {
    unsigned inc = c;
#pragma unroll
    for (int o = 1; o < 64; o <<= 1) { const unsigned n = __shfl_up(inc, o); if (lane >= o) inc += n; }
    __syncthreads();
    if (lane == 63) cnt[wave] = inc;
    __syncthreads();
    unsigned base = 0;
#pragma unroll
    for (int w = 0; w < NWAVES; ++w) base += (w < wave) ? cnt[w] : 0u;
    return base + inc - c;
}
__device__ __forceinline__ void phase_topk(const Ctx& C, int be_first, int be_step) {
    PHASE_IDS;
    LAS unsigned* cnt = (LAS unsigned*)(C.lds + 4096);
    for (int be = be_first; be < BATCH * NE; be += be_step) {
        const int b = be >> 4, e = be & 15;
        const float* aff = C.AFF + ((size_t)b * 16 + e) * SEQ;
        const u32x4 kv = *(const u32x4*)(aff + 4 * tid);
        const unsigned key[4] = {kv.x, kv.y, kv.z, kv.w};
        unsigned prefix = 0;
        for (int bit = 30; bit >= 0; --bit) { const unsigned cand = prefix | (1u << bit);
            unsigned c = 0;
#pragma unroll
            for (int i = 0; i < 4; ++i) c += key[i] >= cand ? 1u : 0u;
            if (block_count(cnt, C.wave, lane, c) >= (unsigned)CAP) prefix = cand; }
        unsigned cg = 0, ce = 0;
#pragma unroll
        for (int i = 0; i < 4; ++i) { cg += key[i] > prefix ? 1u : 0u; ce += key[i] == prefix ? 1u : 0u; }
        const unsigned ngt = block_count(cnt, C.wave, lane, cg);
        const unsigned need = (unsigned)CAP - ngt;
        unsigned tb = block_excl_scan(cnt, C.wave, lane, ce);
        unsigned sel[4], cs = 0;
#pragma unroll
        for (int i = 0; i < 4; ++i) { const bool eq = key[i] == prefix; sel[i] = (key[i] > prefix || (eq && tb < need)) ? 1u : 0u; tb += eq ? 1u : 0u; cs += sel[i]; }
        unsigned p = block_excl_scan(cnt, C.wave, lane, cs);
#pragma unroll
        for (int i = 0; i < 4; ++i) { const int s = 4 * tid + i; int slot = -1;
            if (sel[i]) { slot = (int)p; C.IDX[be * CAP + p] = s; C.GATE[be * CAP + p] = __uint_as_float(key[i]); ++p; }
            C.SLOT[((size_t)b * 16 + e) * SEQ + s] = slot; }
        __syncthreads();
    }
}
typedef short s16x4_t __attribute__((ext_vector_type(4)));
struct ConvItem { const float* src; int ldw; float scale; unsigned char* dst; int ldt; };
__device__ __forceinline__ void conv_load(const ConvItem& d, f32x4 (&v)[16]) {
#pragma unroll
    for (int i = 0; i < 16; ++i) v[i] = *(const f32x4*)(d.src + (size_t)(4 * i) * d.ldw);
}
__device__ __forceinline__ void conv_finish(const ConvItem& d, f32x4 (&v)[16], LAS unsigned char* img, int lane) {
    const int kr = lane >> 4, c4 = lane & 15;
    asm volatile("" : "+v"(v[0]), "+v"(v[1]), "+v"(v[2]), "+v"(v[3]), "+v"(v[4]), "+v"(v[5]), "+v"(v[6]), "+v"(v[7]));
    asm volatile("" : "+v"(v[8]), "+v"(v[9]), "+v"(v[10]), "+v"(v[11]), "+v"(v[12]), "+v"(v[13]), "+v"(v[14]), "+v"(v[15]));
#pragma unroll
    for (int i = 0; i < 16; ++i) { u32x2 w; w.x = pk2(v[i][0] * d.scale, v[i][1] * d.scale); w.y = pk2(v[i][2] * d.scale, v[i][3] * d.scale); *(LAS u32x2*)(img + (4 * i + kr) * 192 + 8 * c4) = w; }
    LDS_WAIT(); asm volatile("" ::: "memory");
    const int g = lane >> 4, q = (lane >> 2) & 3, p = lane & 3, i16 = lane & 15;
    const int rdbase = (int)(unsigned)(size_t)img + (8 * (g >> 1) + q) * 192 + (16 * (g & 1) + 4 * p) * 2;
#pragma unroll
    for (int s = 0; s < 8; ++s) { const int jj = s >> 1, nn = s & 1;
        s16x4_t lo, hi;
        asm volatile("ds_read_b64_tr_b16 %0, %1 offset:%2" : "=&v"(lo) : "v"(rdbase), "i"((16 * jj) * 192 + 64 * nn) : "memory");
        asm volatile("ds_read_b64_tr_b16 %0, %1 offset:%2" : "=&v"(hi) : "v"(rdbase), "i"((16 * jj + 4) * 192 + 64 * nn) : "memory");
        asm volatile("s_waitcnt lgkmcnt(0)" : "+v"(lo), "+v"(hi) :: "memory");
        const int kc = 2 * jj + (g >> 1), n = 16 * (2 * nn + (g & 1)) + i16;
        const u32x2 l2 = __builtin_bit_cast(u32x2, lo), h2 = __builtin_bit_cast(u32x2, hi);
        u32x2 o; o.x = cvt4_fp8(bflo(l2.x), bfhi(l2.x), bflo(l2.y), bfhi(l2.y)); o.y = cvt4_fp8(bflo(h2.x), bfhi(h2.x), bflo(h2.y), bfhi(h2.y));
        *(GAS u32x2*)(d.dst + (size_t)n * d.ldt + 8 * kc) = o; }
    LDS_WAIT(); asm volatile("" ::: "memory");
}
__device__ __forceinline__ void wconv_all(const Ctx& C) {
    LAS unsigned char* img = C.lds + 8192 + C.wave * 12288;
    int tl_ = threadIdx.x; asm volatile("" : "+v"(tl_)); const int lane = tl_ & 63;
    const int gw = C.vcu * NWAVES + C.wave, NGW = C.G * NWAVES;
    constexpr int P_GU = 2 * 8 * 32, P_D = 16 * 16, P_E = P_GU + P_D, NPAIR = NE * P_E;
    const int kr = lane >> 4, c4 = lane & 15;
#define CONV_DECODE(pr, sub, d) do { const int e_ = (pr) / P_E; int r_ = (pr) % P_E; \
        if (r_ < P_GU) { const int up_ = r_ >> 8, kb_ = 2 * ((r_ >> 5) & 7) + (sub), nb_ = r_ & 31, n0_ = 64 * nb_; const float* W_ = (up_ ? C.w_up : C.w_gate) + (size_t)e_ * DM * FF; \
            d.src = W_ + (size_t)(64 * kb_ + kr) * FF + n0_ + 4 * c4; d.ldw = FF; d.scale = SC_WGU; d.ldt = DM; \
            d.dst = (unsigned char*)C.WGU + (size_t)e_ * 4096 * DM + (size_t)((n0_ >> 7) * 256 + (n0_ & 127) + up_ * 128) * DM + 64 * kb_; } \
        else { r_ -= P_GU; const int kb_ = 2 * (r_ >> 4) + (sub), nb_ = r_ & 15; \
            d.src = C.w_down + (size_t)e_ * FF * DM + (size_t)(64 * kb_ + kr) * DM + 64 * nb_ + 4 * c4; d.ldw = DM; d.scale = SC_WD; d.ldt = FF; \
            d.dst = (unsigned char*)C.WD + (size_t)e_ * DM * FF + (size_t)(64 * nb_) * FF + 64 * kb_; } } while (0)
    int pr = gw; if (pr >= NPAIR) return;
    f32x4 va[16], vb[16]; ConvItem dA, dB;
    CONV_DECODE(pr, 0, dA); conv_load(dA, va);
    for (;;) {
        CONV_DECODE(pr, 1, dB); conv_load(dB, vb);
        conv_finish(dA, va, img, lane);
        const int pn = pr + NGW; const bool hn = pn < NPAIR;
        if (hn) { CONV_DECODE(pn, 0, dA); conv_load(dA, va); }
        conv_finish(dB, vb, img, lane);
        if (!hn) break;
        pr = pn;
    }
#undef CONV_DECODE
}
__device__ __forceinline__ void phase_final(const Ctx& C) {
    PHASE_IDS;
    const int gw = C.vcu * NWAVES + C.wave, NGW = C.G * NWAVES;
    f32x4 nx[4]; int nslot = -1;
    if (gw < T) { const int b = gw >> 11, s = gw & 2047;
#pragma unroll
        for (int j = 0; j < 4; ++j) nx[j] = *(const f32x4*)(C.out + (size_t)gw * DM + 4 * lane + 256 * j);
        nslot = lane < 16 ? C.SLOT[((size_t)b * 16 + lane) * SEQ + s] : -1; }
    for (int t = gw; t < T; t += NGW) {
        const int b = t >> 11;
        f32x4 a[4], x1[4];
#pragma unroll
        for (int j = 0; j < 4; ++j) { a[j] = (f32x4){0.f, 0.f, 0.f, 0.f}; x1[j] = nx[j]; }
        const int myslot = nslot;
        if (t + NGW < T) { const int tn = t + NGW, bn = tn >> 11, sn = tn & 2047;
#pragma unroll
            for (int j = 0; j < 4; ++j) nx[j] = *(const f32x4*)(C.out + (size_t)tn * DM + 4 * lane + 256 * j);
            nslot = lane < 16 ? C.SLOT[((size_t)bn * 16 + lane) * SEQ + sn] : -1; }
        unsigned long long mask = __ballot(myslot >= 0);
        while (mask) {
            const int e0 = __builtin_ctzll(mask); mask &= mask - 1; const bool two = mask != 0ull; const int e1 = two ? __builtin_ctzll(mask) : e0; if (two) mask &= mask - 1;
            const int p0 = __shfl(myslot, e0), p1 = __shfl(myslot, e1);
            const bf16* y0 = C.YE + ((size_t)(b * 16 + e0) * CAP + p0) * DM + 4 * lane; const bf16* y1 = C.YE + ((size_t)(b * 16 + e1) * CAP + p1) * DM + 4 * lane;
            u32x2 w0[4], w1[4];
#pragma unroll
            for (int j = 0; j < 4; ++j) { w0[j] = *(const u32x2*)(y0 + 256 * j); w1[j] = *(const u32x2*)(y1 + 256 * j); }
            const float f1 = two ? 1.f : 0.f;
#pragma unroll
            for (int j = 0; j < 4; ++j) { a[j][0] += bflo(w0[j].x) + f1 * bflo(w1[j].x); a[j][1] += bfhi(w0[j].x) + f1 * bfhi(w1[j].x); a[j][2] += bflo(w0[j].y) + f1 * bflo(w1[j].y); a[j][3] += bfhi(w0[j].y) + f1 * bfhi(w1[j].y); }
        }
        const float* mod = C.MOD + b * 6144 + 5120;
        f32x4 v[4]; float sum = 0.f;
#pragma unroll
        for (int j = 0; j < 4; ++j) { const int col = 4 * lane + 256 * j; const f32x4 g = *(const f32x4*)(mod + col);
#pragma unroll
            for (int i = 0; i < 4; ++i) v[j][i] = ALPHA * x1[j][i] + g[i] * a[j][i];
            sum += (v[j][0] + v[j][1]) + (v[j][2] + v[j][3]); }
        const float mean = wave_sum(sum) * (1.f / DM); float s2 = 0.f;
#pragma unroll
        for (int j = 0; j < 4; ++j) { v[j] = v[j] - mean; s2 += (v[j][0] * v[j][0] + v[j][1] * v[j][1]) + (v[j][2] * v[j][2] + v[j][3] * v[j][3]); }
        const float rstd = 1.0f / sqrtf(wave_sum(s2) * (1.f / DM) + LN_EPS);
#pragma unroll
        for (int j = 0; j < 4; ++j) { const int col = 4 * lane + 256 * j; const f32x4 g = *(const f32x4*)(C.ln2g + col), be = *(const f32x4*)(C.ln2b + col); f32x4 o;
#pragma unroll
            for (int i = 0; i < 4; ++i) o[i] = v[j][i] * rstd * g[i] + be[i];
            *(f32x4*)(C.out + (size_t)t * DM + col) = o; }
    }
}

namespace pg8 {
#define PG8_LAS __attribute__((address_space(3)))
constexpr int BM = 256, BK = 64, HALF = 128, HTB = HALF * BK * 2, STAGE_BYTES = 8 * HTB;
__host__ __device__ __forceinline__ int lds_byte(int r, int c) { const int st = (r >> 4) * 2 + (c >> 5), rr = r & 15, cc = c & 31, ob = rr * 64 + cc * 2; return st * 1024 + (ob ^ (((ob >> 9) & 1) << 5)); }
__host__ __device__ __forceinline__ void stage_rc(int b, int& R, int& C) { const int st = b / 1024, sb = b % 1024, swz = sb ^ (((sb >> 9) & 1) << 5); R = (st >> 1) * 16 + swz / 64; C = (st & 1) * 32 + (swz % 64) / 2; }
__host__ __device__ __forceinline__ int perm32(int rho) { const int n = rho >> 4, i = rho & 15; return 8 * (i >> 2) + 4 * n + (i & 3); }
struct Unit { int pm, pn, kind; };

template <class F> struct EpiRow8 { static constexpr bool PERM = true; F f;
    __device__ __forceinline__ void operator()(const f32x4 (&acc)[2][2][4][2], const Unit& u, int wr, int wc, int fr, int fq) const {
        const int row0 = u.pm * BM + wr * 64 + fr, col0 = u.pn * BM + wc * 32 + 8 * fq;
#pragma unroll
        for (int ai = 0; ai < 2; ++ai)
#pragma unroll
            for (int m = 0; m < 4; ++m)
#pragma unroll
                for (int bj = 0; bj < 2; ++bj) { const f32x4 a = acc[ai][bj][m][0], b = acc[ai][bj][m][1]; const float v[8] = {a[0], a[1], a[2], a[3], b[0], b[1], b[2], b[3]};
                    f.row8(u.kind, row0 + ai * HALF + m * 16, col0 + bj * HALF, v); }
    } };
struct EpiProj { static constexpr bool PERM = true; bf16* PROJ; float* ssq_q; float* ssq_kv; bf16* KR; const float* cs; const float* sn;
    __device__ __forceinline__ void operator()(const f32x4 (&acc)[2][2][4][2], const Unit& u, int wr, int wc, int fr, int fq) const {
        const int row0 = u.pm * BM + wr * 64 + fr, col0 = u.pn * BM + wc * 32 + 8 * fq;
#pragma unroll
        for (int ai = 0; ai < 2; ++ai)
#pragma unroll
            for (int m = 0; m < 4; ++m) { const int row = row0 + ai * HALF + m * 16;
#pragma unroll
                for (int bj = 0; bj < 2; ++bj) { const f32x4 a = acc[ai][bj][m][0], b = acc[ai][bj][m][1]; const float v[8] = {a[0], a[1], a[2], a[3], b[0], b[1], b[2], b[3]};
                    store8_bf16(PROJ + (size_t)row * NPROJ + col0 + bj * HALF, v); }
                if (u.pn <= 1) {
                    float s = 0.f;
#pragma unroll
                    for (int bj = 0; bj < 2; ++bj) if (bj == 0 || u.pn == 0) {
#pragma unroll
                        for (int n = 0; n < 2; ++n) { const f32x4 x = acc[ai][bj][m][n]; s += (x[0] * x[0] + x[1] * x[1]) + (x[2] * x[2] + x[3] * x[3]); } }
                    s += __shfl_xor(s, 16); s += __shfl_xor(s, 32);
                    if (fq == 0) (u.pn == 0 ? ssq_q : ssq_kv)[(size_t)row * 4 + wc] = s;
                    if (u.pn == 1 && wc == 0) {
                        const f32x4 t1 = acc[ai][1][m][0], t2 = acc[ai][1][m][1], c4 = *(const f32x4*)(cs + (size_t)row * 16 + 4 * fq), s4 = *(const f32x4*)(sn + (size_t)row * 16 + 4 * fq);
                        float o[8];
#pragma unroll
                        for (int i = 0; i < 4; ++i) { o[i] = t1[i] * c4[i] - t2[i] * s4[i]; o[4 + i] = t1[i] * s4[i] + t2[i] * c4[i]; }
                        store8_bf16(KR + (size_t)row * 32 + 8 * fq, o); }
                } }
    } };
struct EpiQKV { static constexpr bool PERM = true; FRowScale fq, fkv;
    __device__ __forceinline__ void operator()(const f32x4 (&acc)[2][2][4][2], const Unit& u, int wr, int wc, int fr, int fq_) const {
        EpiRow8<FRowScale> e{u.kind ? fkv : fq}; e(acc, u, wr, wc, fr, fq_);
    } };
struct EpiY { static constexpr bool PERM = true; float* Y; const float* x; const float* mod;
    __device__ __forceinline__ void operator()(const f32x4 (&acc)[2][2][4][2], const Unit& u, int wr, int wc, int fr, int fq) const {
        const int row0 = u.pm * BM + wr * 64 + fr, col0 = u.pn * BM + wc * 32 + 8 * fq, b = (u.pm * BM) >> 11;
        f32x4 g[2][2];
#pragma unroll
        for (int bj = 0; bj < 2; ++bj) { const float* gp = mod + b * 6144 + 2048 + col0 + bj * HALF; g[bj][0] = *(const f32x4*)gp; g[bj][1] = *(const f32x4*)(gp + 4); }
#pragma unroll
        for (int ai = 0; ai < 2; ++ai) {
            f32x4 xv[4][2][2];
#pragma unroll
            for (int m = 0; m < 4; ++m)
#pragma unroll
                for (int bj = 0; bj < 2; ++bj) { const float* xp = x + (size_t)(row0 + ai * HALF + m * 16) * DM + col0 + bj * HALF; xv[m][bj][0] = *(const f32x4*)xp; xv[m][bj][1] = *(const f32x4*)(xp + 4); }
#pragma unroll
            for (int m = 0; m < 4; ++m)
#pragma unroll
                for (int bj = 0; bj < 2; ++bj) { float* yp = Y + (size_t)(row0 + ai * HALF + m * 16) * DM + col0 + bj * HALF;
                    *(f32x4*)yp = xv[m][bj][0] * ALPHA + g[bj][0] * acc[ai][bj][m][0]; *(f32x4*)(yp + 4) = xv[m][bj][1] * ALPHA + g[bj][1] * acc[ai][bj][m][1]; }
        }
    } };
template <class F> struct EpiPair8 { static constexpr bool PERM = true; F f;
    __device__ __forceinline__ void operator()(const f32x4 (&acc)[2][2][4][2], const Unit& u, int wr, int wc, int fr, int fq) const {
        const int row0 = u.pm * BM + wr * 64 + fr, col0 = u.pn * HALF + wc * 32 + 8 * fq;
#pragma unroll
        for (int ai = 0; ai < 2; ++ai)
#pragma unroll
            for (int m = 0; m < 4; ++m) { const f32x4 a = acc[ai][0][m][0], b = acc[ai][0][m][1], c = acc[ai][1][m][0], d = acc[ai][1][m][1];
                const float g[8] = {a[0], a[1], a[2], a[3], b[0], b[1], b[2], b[3]}, up[8] = {c[0], c[1], c[2], c[3], d[0], d[1], d[2], d[3]};
                f.pair8(row0 + ai * HALF + m * 16, col0, g, up); }
    } };

template <class Epi, class Sched, bool FP8 = false, bool ALIGN_EPI = true, bool SP2 = true>
__device__ __forceinline__ void gemm_phase(PG8_LAS unsigned char* lds, const int KB  , const Sched& S, const Epi& E) {
    const int tid = threadIdx.x, wid = __builtin_amdgcn_readfirstlane(tid >> 6), lane = tid & 63, wr = wid >> 2, wc = wid & 3, fr = lane & 15, fq = lane >> 4;
    const int nt = KB / (BK * 2);
    Unit cur, nxt; int ui = 0;
    if (!S.next(0, cur)) return;
    unsigned voffA[2][2], voffB[2];
#pragma unroll
    for (int i = 0; i < 2; ++i) { int R, C; stage_rc(tid * 16 + i * 8192, R, C); const int Rb = Epi::PERM ? ((R & ~31) + perm32(R & 31)) : R;
        voffB[i] = (unsigned)(Rb * S.ldb) + (unsigned)C * 2u;
#pragma unroll
        for (int h = 0; h < 2; ++h) voffA[h][i] = S.a_rowoff(cur, h * HALF + R) + (unsigned)C * 2u; }
    const size_t kstep = (size_t)(BK * 2);
    const size_t hstepB = (size_t)HALF * S.ldb;
    const unsigned ldsw = (unsigned)wid * 1024u;
    const int aoff = lds_byte(wr * 64 + fr, fq * 8), boff = lds_byte(wc * 32 + fr, fq * 8);
#define PG8_SA(b, h) (((b) * 2 + (h)) * HTB)
#define PG8_SB(b, h) ((4 + (b) * 2 + (h)) * HTB)
#define PG8_STAGE_A(bufoff, gbase, h) do { _Pragma("unroll") for (int _i = 0; _i < 2; ++_i) \
        __builtin_amdgcn_global_load_lds((const unsigned*)((const char*)(gbase) + voffA[h][_i]), (PG8_LAS unsigned*)(lds + (bufoff) + ldsw + _i * 8192), 16, 0, 0); } while (0)
#define PG8_STAGE_B(bufoff, gbase) do { _Pragma("unroll") for (int _i = 0; _i < 2; ++_i) \
        __builtin_amdgcn_global_load_lds((const unsigned*)((const char*)(gbase) + voffB[_i]), (PG8_LAS unsigned*)(lds + (bufoff) + ldsw + _i * 8192), 16, 0, 0); } while (0)
#define PG8_LDA(dst, b, h) do { _Pragma("unroll") for (int m = 0; m < 4; ++m) dst[m] = PG8_CAT(*(const PG8_LAS i32x4*)(lds + PG8_SA(b, h) + aoff + m * 2048), *(const PG8_LAS i32x4*)(lds + PG8_SA(b, h) + aoff + m * 2048 + 1024)); } while (0)
#define PG8_LDB(dst, b, h) do { _Pragma("unroll") for (int n = 0; n < 2; ++n) dst[n] = PG8_CAT(*(const PG8_LAS i32x4*)(lds + PG8_SB(b, h) + boff + n * 2048), *(const PG8_LAS i32x4*)(lds + PG8_SB(b, h) + boff + n * 2048 + 1024)); } while (0)
#define PG8_CAT(x, y) __builtin_shufflevector(x, y, 0, 1, 2, 3, 4, 5, 6, 7)
#define PG8_LO(x) __builtin_bit_cast(bf16x8, __builtin_shufflevector(x, x, 0, 1, 2, 3))
#define PG8_HI(x) __builtin_bit_cast(bf16x8, __builtin_shufflevector(x, x, 4, 5, 6, 7))
#define PG8_MMA(ai, bj, At, Bt) do { __builtin_amdgcn_s_setprio(1); _Pragma("unroll") for (int m = 0; m < 4; ++m) _Pragma("unroll") for (int n = 0; n < 2; ++n) { \
        if constexpr (FP8) asm volatile("v_mfma_f32_16x16x128_f8f6f4 %0, %1, %2, %0" : "+v"(acc[ai][bj][m][n]) : "v"(Bt[n]), "v"(At[m]));   \
        else { acc[ai][bj][m][n] = __builtin_amdgcn_mfma_f32_16x16x32_bf16(PG8_LO(Bt[n]), PG8_LO(At[m]), acc[ai][bj][m][n], 0, 0, 0); \
               acc[ai][bj][m][n] = __builtin_amdgcn_mfma_f32_16x16x32_bf16(PG8_HI(Bt[n]), PG8_HI(At[m]), acc[ai][bj][m][n], 0, 0, 0); } } \
        __builtin_amdgcn_s_setprio(0); } while (0)
#define PG8_WAIT_V(n) asm volatile("s_waitcnt vmcnt(" #n ")" ::: "memory")
#define PG8_WAIT_L(n) asm volatile("s_waitcnt lgkmcnt(" #n ")" ::: "memory")
#define PG8_BAR __builtin_amdgcn_s_barrier()
#define PG8_SCHED __builtin_amdgcn_sched_barrier(0)
    f32x4 acc[2][2][4][2];
#pragma unroll
    for (int a = 0; a < 2; ++a)
#pragma unroll
        for (int b = 0; b < 2; ++b)
#pragma unroll
            for (int m = 0; m < 4; ++m)
#pragma unroll
                for (int n = 0; n < 2; ++n) acc[a][b][m][n] = (f32x4){0.f, 0.f, 0.f, 0.f};
    i32x8 At[4], B0[2], B1[2];
    const char* cA = S.a_base(cur); const char* cB = S.b_base(cur);
    if constexpr (SP2) {
        PG8_STAGE_B(PG8_SB(0, 0), cB); PG8_STAGE_B(PG8_SB(0, 1), cB + hstepB); PG8_STAGE_A(PG8_SA(0, 0), cA, 0); PG8_STAGE_A(PG8_SA(0, 1), cA, 1);
        if (wr == 1) PG8_BAR;
        PG8_WAIT_V(2); PG8_BAR;
        PG8_STAGE_B(PG8_SB(1, 0), cB + kstep); PG8_STAGE_A(PG8_SA(1, 0), cA + kstep, 0); PG8_STAGE_B(PG8_SB(1, 1), cB + hstepB + kstep);
        PG8_WAIT_V(6); PG8_BAR;
    } else {
        PG8_STAGE_B(PG8_SB(0, 0), cB); PG8_STAGE_A(PG8_SA(0, 0), cA, 0); PG8_STAGE_B(PG8_SB(0, 1), cB + hstepB); PG8_STAGE_A(PG8_SA(0, 1), cA, 1);
        if (wr == 1) PG8_BAR;
        PG8_WAIT_V(4); PG8_BAR;
        PG8_STAGE_B(PG8_SB(1, 0), cB + kstep); PG8_STAGE_A(PG8_SA(1, 0), cA + kstep, 0); PG8_STAGE_B(PG8_SB(1, 1), cB + hstepB + kstep);
        PG8_WAIT_V(6); PG8_BAR;
    }
    for (;;) {
        const bool has_next = S.next(ui + 1, nxt);
        const char* nA = has_next ? S.a_base(nxt) : cA; const char* nB = has_next ? S.b_base(nxt) : cB;
#pragma unroll 1
        for (int t = 0; t < nt; t += 2) {
            const bool last = (t == nt - 2);
            const char* a1 = cA + (size_t)(t + 1) * kstep;
            const char* a2 = last ? nA : cA + (size_t)(t + 2) * kstep; const char* b2 = last ? nB : cB + (size_t)(t + 2) * kstep;
            const char* a3 = a2 + kstep; const char* b3 = b2 + kstep;
            if constexpr (SP2) {
            PG8_LDB(B0, 0, 0); PG8_LDB(B1, 0, 1); PG8_SCHED; PG8_LDA(At, 0, 0); PG8_STAGE_A(PG8_SA(1, 1), a1, 1);
            PG8_WAIT_V(8); PG8_WAIT_L(0); PG8_BAR; PG8_MMA(0, 0, At, B0); PG8_MMA(0, 1, At, B1); PG8_BAR; PG8_SCHED;
            PG8_LDA(At, 0, 1); PG8_STAGE_B(PG8_SB(0, 0), b2); PG8_STAGE_B(PG8_SB(0, 1), b2 + hstepB); PG8_STAGE_A(PG8_SA(0, 0), a2, 0);
            PG8_WAIT_V(8); PG8_WAIT_L(0); PG8_BAR; PG8_MMA(1, 0, At, B0); PG8_MMA(1, 1, At, B1); PG8_BAR; PG8_SCHED;
            PG8_LDB(B0, 1, 0); PG8_LDB(B1, 1, 1); PG8_SCHED; PG8_LDA(At, 1, 0); PG8_STAGE_A(PG8_SA(0, 1), a2, 1);
            PG8_WAIT_V(8); PG8_WAIT_L(0); PG8_BAR; PG8_MMA(0, 0, At, B0); PG8_MMA(0, 1, At, B1); PG8_BAR; PG8_SCHED;
            PG8_LDA(At, 1, 1); PG8_STAGE_B(PG8_SB(1, 0), b3); PG8_STAGE_B(PG8_SB(1, 1), b3 + hstepB); PG8_STAGE_A(PG8_SA(1, 0), a3, 0);
            PG8_WAIT_V(8); PG8_WAIT_L(0); PG8_BAR; PG8_MMA(1, 0, At, B0); PG8_MMA(1, 1, At, B1); PG8_BAR; PG8_SCHED;
            } else {
            PG8_LDB(B0, 0, 0); PG8_SCHED; PG8_LDA(At, 0, 0); PG8_STAGE_A(PG8_SA(1, 1), a1, 1);
            PG8_WAIT_L(8); PG8_BAR; PG8_WAIT_L(0); PG8_MMA(0, 0, At, B0); PG8_BAR; PG8_SCHED;
            PG8_LDB(B1, 0, 1); PG8_STAGE_B(PG8_SB(0, 0), b2);
            PG8_BAR; PG8_WAIT_L(0); PG8_MMA(0, 1, At, B1); PG8_BAR;
            PG8_LDA(At, 0, 1); PG8_STAGE_A(PG8_SA(0, 0), a2, 0);
            PG8_BAR; PG8_WAIT_L(0); PG8_MMA(1, 0, At, B0); PG8_BAR; PG8_SCHED;
            PG8_STAGE_B(PG8_SB(0, 1), b2 + hstepB);
            PG8_WAIT_V(6); PG8_BAR; PG8_MMA(1, 1, At, B1); PG8_BAR;
            PG8_LDB(B0, 1, 0); PG8_SCHED; PG8_LDA(At, 1, 0); PG8_STAGE_A(PG8_SA(0, 1), a2, 1);
            PG8_WAIT_L(8); PG8_BAR; PG8_WAIT_L(0); PG8_MMA(0, 0, At, B0); PG8_BAR; PG8_SCHED;
            PG8_LDB(B1, 1, 1); PG8_STAGE_B(PG8_SB(1, 0), b3);
            PG8_BAR; PG8_WAIT_L(0); PG8_MMA(0, 1, At, B1); PG8_BAR;
            PG8_LDA(At, 1, 1); PG8_STAGE_A(PG8_SA(1, 0), a3, 0);
            PG8_BAR; PG8_WAIT_L(0); PG8_MMA(1, 0, At, B0); PG8_BAR; PG8_SCHED;
            PG8_STAGE_B(PG8_SB(1, 1), b3 + hstepB);
            PG8_WAIT_V(6); PG8_BAR; PG8_MMA(1, 1, At, B1); PG8_BAR;
            }
        }
        if constexpr (ALIGN_EPI) { if (wr == 0) PG8_BAR; }
        if constexpr (FP8) asm volatile("s_nop 15\n\ts_nop 7" ::: "memory");
        E(acc, cur, wr, wc, fr, fq);
        if (!has_next) break;
#pragma unroll
        for (int a = 0; a < 2; ++a)
#pragma unroll
            for (int b = 0; b < 2; ++b)
#pragma unroll
                for (int m = 0; m < 4; ++m)
#pragma unroll
                    for (int n = 0; n < 2; ++n) acc[a][b][m][n] = (f32x4){0.f, 0.f, 0.f, 0.f};
        cur = nxt; cA = nA; cB = nB; ++ui;
        if constexpr (ALIGN_EPI) { if (wr == 1) PG8_BAR; }
    }
    PG8_WAIT_V(0);
    if constexpr (!ALIGN_EPI) { if (wr == 0) PG8_BAR; }
    PG8_BAR;
#undef PG8_SA
#undef PG8_SB
#undef PG8_STAGE_A
#undef PG8_STAGE_B
#undef PG8_LDA
#undef PG8_LDB
#undef PG8_MMA
#undef PG8_CAT
#undef PG8_LO
#undef PG8_HI
#undef PG8_WAIT_V
#undef PG8_WAIT_L
#undef PG8_BAR
#undef PG8_SCHED
}
struct SchedDense {
    const char* A; const char* Bt; int lda, ldb; int nM, nN, nwg, G, c;
    __device__ __forceinline__ void init(const void* A_, int lda_, const void* Bt_, int ldb_, int M, int N, int G_, int c_) { A = (const char*)A_; Bt = (const char*)Bt_; lda = lda_ * 2; ldb = ldb_ * 2; nM = M / BM; nN = N / BM; nwg = nM * nN; G = G_; c = c_; }
    __device__ __forceinline__ bool next(int i, Unit& u) const {
        const long L = (long)i * G + c; if (L >= nwg) return false;
        int wgid = (int)L; { const int q = nwg / 8, r = nwg % 8, xcd = wgid % 8, off = wgid / 8; wgid = (xcd < r ? xcd * (q + 1) : r * (q + 1) + (xcd - r) * q) + off; }
        const int nig = 8 * nN, gid = wgid / nig, fm = gid * 8, gsz = (nM - fm) < 8 ? (nM - fm) : 8;
        u.pm = fm + ((wgid % nig) % gsz); u.pn = (wgid % nig) / gsz; u.kind = 0; return true;
    }
    __device__ __forceinline__ const char* a_base(const Unit& u) const { return A + (size_t)u.pm * BM * lda; }
    __device__ __forceinline__ const char* b_base(const Unit& u) const { return Bt + (size_t)u.pn * BM * ldb; }
    __device__ __forceinline__ unsigned a_rowoff(const Unit&, int r) const { return (unsigned)(r * lda); }
};
struct SchedQKV {
    const char* proj; const char* wuq; const char* wukv; int lda, ldb; int G, vcu;
    __device__ __forceinline__ bool next(int i, Unit& u) const {
        const int L = i * G + vcu; if (L >= (T / BM) * 7) return false;
        u.pm = L / 7; const int j = L % 7; u.kind = j < 3 ? 0 : 1; u.pn = j < 3 ? j : j - 3; return true; }
    __device__ __forceinline__ const char* a_base(const Unit& u) const { return proj + ((size_t)u.pm * BM * NPROJ + (u.kind == 1 ? 256 : 0)) * 2; }
    __device__ __forceinline__ const char* b_base(const Unit& u) const { return (u.kind == 1 ? wukv : wuq) + (size_t)u.pn * BM * 256 * 2; }
    __device__ __forceinline__ unsigned a_rowoff(const Unit&, int r) const { return (unsigned)(r * lda); }
};
__device__ __forceinline__ int be_of_vcu(int vcu) { const int x = vcu >> 5, j = vcu & 31; return (j & 15) * 16 + 2 * x + (j >> 4); }
struct SchedUp {
    const char* u2; const int* idx; const char* wgu; int lda, ldb; int G, vcu;
    __device__ __forceinline__ bool next(int i, Unit& u) const { if (i >= 16 || vcu >= 256) return false; u.pm = be_of_vcu(vcu); u.pn = i; u.kind = 0; return true; }
    __device__ __forceinline__ const char* a_base(const Unit& u) const { return u2 + (size_t)(u.pm >> 4) * SEQ * DM; }
    __device__ __forceinline__ const char* b_base(const Unit& u) const { return wgu + ((size_t)(u.pm & 15) * 4096 + (size_t)u.pn * BM) * DM; }
    __device__ __forceinline__ unsigned a_rowoff(const Unit& u, int r) const { return (unsigned)idx[u.pm * CAP + r] * (unsigned)DM; }
};
struct SchedDown {
    const char* h; const char* wd; int lda, ldb; int G, vcu;
    __device__ __forceinline__ bool next(int i, Unit& u) const { if (i >= 4 || vcu >= 256) return false; const int x = vcu >> 5, j = vcu & 31; u.pm = (4 * (j & 3) + i) * 16 + 2 * x + (j >> 4); u.pn = (j >> 2) & 3; u.kind = 0; return true; }
    __device__ __forceinline__ const char* a_base(const Unit& u) const { return h + (size_t)u.pm * BM * FF; }
    __device__ __forceinline__ const char* b_base(const Unit& u) const { return wd + ((size_t)(u.pm & 15) * DM + (size_t)u.pn * BM) * FF; }
    __device__ __forceinline__ unsigned a_rowoff(const Unit&, int r) const { return (unsigned)(r * lda); }
};
}


constexpr int CV_ITEMS = 96, CV_SLOT_BYTES = 2048, CV_LDS_OFF = 109632;
struct ConvStream { int q; int pend0, pend1; };
struct ConvAddr { const float* W; int ldw, n0, kb, up; float scale; unsigned char* WT; };
__device__ __forceinline__ void conv_decode(const Ctx& C, int gw, int q, ConvAddr& a) {
    const int m = q >> 5, i = q & 31, hc = gw + m * 2048;
    if (hc < 4096) { const int e = hc >> 8, r = hc & 255; a.up = r >> 7; const int nseg = r & 127;
        a.W = (a.up ? C.w_up : C.w_gate) + (size_t)e * DM * FF; a.ldw = FF; a.n0 = 16 * nseg; a.kb = i; a.scale = SC_WGU; a.WT = (unsigned char*)C.WGU + (size_t)e * 4096 * DM; }
    else { const int d = hc - 4096, e = d >> 7, r = d & 127, khalf = r >> 6, nseg = r & 63; a.up = -1;
        a.W = C.w_down + (size_t)e * FF * DM; a.ldw = DM; a.n0 = 16 * nseg; a.kb = 32 * khalf + i; a.scale = SC_WD; a.WT = (unsigned char*)C.WD + (size_t)e * DM * FF; }
}
__device__ __forceinline__ void glds16_cv(const void* gsrc, unsigned lds_dst) { unsigned keep;
    asm volatile("s_mov_b32 %0, m0\n\ts_mov_b32 m0, %2\n\ts_nop 0\n\tglobal_load_lds_dwordx4 %1, off\n\ts_mov_b32 m0, %0" : "=&s"(keep) : "v"(gsrc), "s"(lds_dst) : "memory"); }
__device__ __forceinline__ void conv_issue(const Ctx& C, int gw, int q, int slot, int wid, int lane) {
    ConvAddr a; conv_decode(C, gw, q, a);
    const float* src = a.W + (size_t)(32 * a.kb + (lane >> 2)) * a.ldw + a.n0 + 4 * (lane & 3);
    const unsigned dst = (unsigned)__builtin_amdgcn_readfirstlane((int)(unsigned)(size_t)(C.lds + CV_LDS_OFF) + (wid * 2 + slot) * CV_SLOT_BYTES);
    glds16_cv(src, dst); glds16_cv(src + (size_t)16 * a.ldw, dst + 1024);
}
__device__ __forceinline__ void conv_process(const Ctx& C, int gw, int q, int slot, int wid, int lane) {
    ConvAddr a; conv_decode(C, gw, q, a);
    const int n = lane & 15, kg = lane >> 4;
    const LAS float* img = (const LAS float*)(C.lds + CV_LDS_OFF + (wid * 2 + slot) * CV_SLOT_BYTES) + (8 * kg) * 16 + n;
    float v[8];
#pragma unroll
    for (int i = 0; i < 8; ++i) v[i] = img[i * 16] * a.scale;
    u32x2 w; w.x = cvt4_fp8(v[0], v[1], v[2], v[3]); w.y = cvt4_fp8(v[4], v[5], v[6], v[7]);
    const int c = a.n0 + n;
    if (a.up >= 0) *(GAS u32x2*)(a.WT + (size_t)((c >> 7) * 256 + (c & 127) + a.up * 128) * DM + 32 * a.kb + 8 * kg) = w;
    else *(GAS u32x2*)(a.WT + (size_t)c * FF + 32 * a.kb + 8 * kg) = w;
}
__device__ __forceinline__ void conv_flush(const Ctx& C, ConvStream& cs, int gw, int wid, int lane) {
    asm volatile("s_waitcnt vmcnt(0)" ::: "memory");
    if (cs.pend0 >= 0) { conv_process(C, gw, cs.pend0, 0, wid, lane); cs.pend0 = -1; }
    if (cs.pend1 >= 0) { conv_process(C, gw, cs.pend1, 1, wid, lane); cs.pend1 = -1; }
    while (cs.q < CV_ITEMS) { conv_issue(C, gw, cs.q, 0, wid, lane); asm volatile("s_waitcnt vmcnt(0)" ::: "memory"); conv_process(C, gw, cs.q, 0, wid, lane); ++cs.q; }
}

namespace att {
using f32x16 = __attribute__((ext_vector_type(16))) float;
using s16x4  = __attribute__((ext_vector_type(4))) short;
constexpr int SHM_V = 16384, SHM_K = 16384;
constexpr int NSLOT = 3;
constexpr int L_V = 0, L_K = NSLOT * SHM_V, L_WS = L_K + NSLOT * SHM_K, L_KPOS = L_WS + 8 * 64 * 4, L_TAB = L_KPOS + SEQ * 4, L_Q = L_TAB + 272 * 4, L_END = L_Q + 8 * 4096;
#ifndef ATT_SDEPTH
#define ATT_SDEPTH 2
#endif
constexpr float THR2 = 11.5f;
#define ATT_KSWZ(row, colB) ((row) * 256 + ((colB) ^ (((row) & 15) << 4)))
#define ATT_SBAR() __builtin_amdgcn_sched_barrier(0)
__device__ __forceinline__ int crow(int r, int hi) { return (r & 3) + 8 * (r >> 2) + 4 * hi; }
__device__ __forceinline__ unsigned cvtpk(float lo, float hi) { unsigned r; asm volatile("v_cvt_pk_bf16_f32 %0, %1, %2" : "=v"(r) : "v"(lo), "v"(hi)); return r; }
__device__ __forceinline__ int v_st(int k, int c) { const int kk = (k & ~0xC) | ((k & 4) << 1) | ((k & 8) >> 1); return ((kk >> 3) * 4 + (c >> 5)) * 512 + ((kk & 7) * 32 + (c & 31)) * 2; }
__device__ __forceinline__ int v_rd_base(int lane) { return ((lane & 3) << 3) | (((lane >> 2) & 3) << 6) | (((lane >> 4) & 1) << 5) | (((lane >> 5) & 1) << 11); }
constexpr int v_rd_off(int d0, int ks, int half) { return d0 * 512 + ks * 4096 + half * 256; }
typedef short v4i16_t __attribute__((ext_vector_type(4)));
struct VFrag { s16x4 l0, h0, l1, h1, l2, h2, l3, h3; };
template <int OFF> __device__ __forceinline__ s16x4 tr_read(const LAS char* vp) { return __builtin_bit_cast(s16x4, __builtin_amdgcn_ds_read_tr16_b64_v4i16((LAS v4i16_t*)(vp + OFF))); }
template <int D0> __device__ __forceinline__ void v_rd(VFrag& f, const LAS char* vb) {
    f.l0 = tr_read<v_rd_off(D0, 0, 0)>(vb); f.h0 = tr_read<v_rd_off(D0, 0, 1)>(vb); f.l1 = tr_read<v_rd_off(D0, 1, 0)>(vb); f.h1 = tr_read<v_rd_off(D0, 1, 1)>(vb);
    f.l2 = tr_read<v_rd_off(D0, 2, 0)>(vb); f.h2 = tr_read<v_rd_off(D0, 2, 1)>(vb); f.l3 = tr_read<v_rd_off(D0, 3, 0)>(vb); f.h3 = tr_read<v_rd_off(D0, 3, 1)>(vb);
}
__device__ __forceinline__ void v_mm(f32x16& od, const VFrag& f, bf16x8 pa0, bf16x8 pa1, bf16x8 pa2, bf16x8 pa3) {
#define ATT_PK(L, H) (bf16x8){L[0], L[1], L[2], L[3], H[0], H[1], H[2], H[3]}
    od = __builtin_amdgcn_mfma_f32_32x32x16_bf16(pa0, ATT_PK(f.l0, f.h0), od, 0, 0, 0);
    od = __builtin_amdgcn_mfma_f32_32x32x16_bf16(pa1, ATT_PK(f.l1, f.h1), od, 0, 0, 0);
    od = __builtin_amdgcn_mfma_f32_32x32x16_bf16(pa2, ATT_PK(f.l2, f.h2), od, 0, 0, 0);
    od = __builtin_amdgcn_mfma_f32_32x32x16_bf16(pa3, ATT_PK(f.l3, f.h3), od, 0, 0, 0);
#undef ATT_PK
}
template <int NDV> __device__ __forceinline__ void pv_all(f32x16 (&o)[NDV], const LAS char* vb, bf16x8 pa0, bf16x8 pa1, bf16x8 pa2, bf16x8 pa3) {
    VFrag fa, fb;
    v_rd<0>(fa, vb); v_rd<1>(fb, vb); ATT_SBAR();
    v_mm(o[0], fa, pa0, pa1, pa2, pa3); ATT_SBAR();
    if constexpr (NDV == 4) {
        v_rd<2>(fa, vb); ATT_SBAR(); v_mm(o[1], fb, pa0, pa1, pa2, pa3); ATT_SBAR();
        v_rd<3>(fb, vb); ATT_SBAR(); v_mm(o[2], fa, pa0, pa1, pa2, pa3); ATT_SBAR();
        v_mm(o[3], fb, pa0, pa1, pa2, pa3);
    } else {
        v_mm(o[1], fb, pa0, pa1, pa2, pa3);
    }
}
__device__ __forceinline__ void glds16(const void* gsrc, unsigned lds_dst) { unsigned keep;
    asm volatile("s_mov_b32 %0, m0\n\ts_mov_b32 m0, %2\n\ts_nop 0\n\tglobal_load_lds_dwordx4 %1, off\n\ts_mov_b32 m0, %0" : "=&s"(keep) : "v"(gsrc), "s"(lds_dst) : "memory"); }
template <int NDQ, bool QLDS> __device__ __forceinline__ void qkt(f32x16& p0, f32x16& p1, const LAS char* Kl, const bf16x8 (&qr)[NDQ], const LAS char* ql, int r32, int hi, const f32x16& negm) {
#pragma unroll
    for (int d0 = 0; d0 < NDQ; ++d0) { const int cb = (d0 * 16 + hi * 8) * 2;
        const bf16x8 b0 = *(const LAS bf16x8*)(Kl + ATT_KSWZ(r32, cb)), b1 = *(const LAS bf16x8*)(Kl + ATT_KSWZ(32 + r32, cb));
        bf16x8 q; if constexpr (QLDS) q = *(const LAS bf16x8*)(ql + d0 * 1024); else q = qr[d0];
        if (d0 == 0) { p0 = __builtin_amdgcn_mfma_f32_32x32x16_bf16(b0, q, negm, 0, 0, 0); p1 = __builtin_amdgcn_mfma_f32_32x32x16_bf16(b1, q, negm, 0, 0, 0); }
        else { p0 = __builtin_amdgcn_mfma_f32_32x32x16_bf16(b0, q, p0, 0, 0, 0); p1 = __builtin_amdgcn_mfma_f32_32x32x16_bf16(b1, q, p1, 0, 0, 0); } }
}
#define ATT_MX3(a, b, c) __builtin_fmaxf(__builtin_fmaxf((a), (b)), (c))
template <bool BAND, bool FIRST> __device__ __forceinline__ void partialSM(f32x16& p0, f32x16& p1, float& mhat, f32x16& negm, float ccur, float& alpha, const LAS int* kposl, const LAS float* tabl, int qpos, int hi) {
    if constexpr (BAND) {
#pragma unroll
        for (int r = 0; r < 16; ++r) { const int kc = crow(r, hi); int r0 = kposl[kc] - qpos, r1 = kposl[32 + kc] - qpos;
            r0 = r0 < -128 ? -128 : (r0 > 128 ? 128 : r0); r1 = r1 < -128 ? -128 : (r1 > 128 ? 128 : r1);
            p0[r] += tabl[r0 + 128]; p1[r] += tabl[r1 + 128];
            if ((r & 3) == 3) asm volatile("" ::: "memory"); }
    }
    float a = ATT_MX3(p0[0], p0[1], p1[0]), b = ATT_MX3(p0[2], p0[3], p1[1]); a = ATT_MX3(a, p1[2], p1[3]);
#pragma unroll
    for (int r = 4; r < 16; r += 4) { a = ATT_MX3(a, p0[r], p0[r + 1]); b = ATT_MX3(b, p0[r + 2], p0[r + 3]); a = ATT_MX3(a, p1[r], p1[r + 1]); b = ATT_MX3(b, p1[r + 2], p1[r + 3]); }
    float rm = __builtin_fmaxf(a, b);
    { auto rr = __builtin_amdgcn_permlane32_swap(__float_as_uint(rm), __float_as_uint(rm), false, false); rm = __builtin_fmaxf(__uint_as_float(rr[0]), __uint_as_float(rr[1])); }
    alpha = 1.f;
    if (FIRST || __builtin_expect(__any(rm > THR2), 0)) {
        const float dl = FIRST ? rm : __builtin_fmaxf(rm, 0.f);
        mhat += dl;
#pragma unroll
        for (int r = 0; r < 16; ++r) { p0[r] -= dl; p1[r] -= dl; }
        const float nm = ccur - mhat;
#pragma unroll
        for (int r = 0; r < 16; ++r) negm[r] = nm;
        asm volatile("" : "+v"(negm));
        if (!FIRST) alpha = __builtin_amdgcn_exp2f(-dl);
    }
#pragma unroll
    for (int r = 0; r < 16; ++r) p0[r] = __builtin_amdgcn_exp2f(p0[r]);
}
__device__ __forceinline__ void finishSM(f32x16& p0, f32x16& p1, float alpha, float& l_reg, bf16x8& pa0, bf16x8& pa1, bf16x8& pa2, bf16x8& pa3) {
#pragma unroll
    for (int r = 0; r < 16; ++r) p1[r] = __builtin_amdgcn_exp2f(p1[r]);
    float ps = 0, ps2 = 0;
#pragma unroll
    for (int r = 0; r < 16; ++r) { ps += p0[r]; ps2 += p1[r]; }
    ps += ps2;
    { auto rr = __builtin_amdgcn_permlane32_swap(__float_as_uint(ps), __float_as_uint(ps), false, false); ps = __uint_as_float(rr[0]) + __uint_as_float(rr[1]); }
    l_reg = l_reg * alpha + ps;
#define ATT_PK8(P, BASE, OUT) do { u32x4 w = {cvtpk(P[BASE + 0], P[BASE + 1]), cvtpk(P[BASE + 2], P[BASE + 3]), cvtpk(P[BASE + 4], P[BASE + 5]), cvtpk(P[BASE + 6], P[BASE + 7])}; OUT = __builtin_bit_cast(bf16x8, w); } while (0)
    ATT_PK8(p0, 0, pa0); ATT_PK8(p0, 8, pa1); ATT_PK8(p1, 0, pa2); ATT_PK8(p1, 8, pa3);
#undef ATT_PK8
}

struct DmaSrc { const bf16* k0; const bf16* k1; const bf16* v0; const bf16* v1; int kp0, kp1, vp; };
template <int NDQ, int NDV, bool DIFF>
__device__ __forceinline__ void attn_pass_dma(const Ctx& C, ConvStream& cs, LAS char* lds, const int tid, const bf16x8 (&qr)[NDQ], const DmaSrc& S, f32x16 (&o)[NDV], float& l_out,
                                              int qpos, int qmn, int qmx, const int* pmm, float cL, float cR) {
    const int wid = __builtin_amdgcn_readfirstlane(tid >> 6), lane = tid & 63, r32 = lane & 31, hi = lane >> 5;
    LAS char* V_lds = lds + L_V; LAS char* K_lds = lds + L_K;
    LAS float* al_l = (LAS float*)(lds + L_WS) + wid * 64 + 32;
    LAS int* kposl = (LAS int*)(lds + L_KPOS); const LAS float* tabl = (const LAS float*)(lds + L_TAB);
    float mhat = 0.f, l_reg = 0.f, ccur = 0.f; f32x16 negm;
#pragma unroll
    for (int r = 0; r < 16; ++r) negm[r] = 0.f;
#pragma unroll
    for (int d = 0; d < NDV; ++d)
#pragma unroll
        for (int r = 0; r < 16; ++r) o[d][r] = 0.f;
    const LAS char* vb0 = V_lds + v_rd_base(lane);
    const int kdst_a = (int)(unsigned)(size_t)(K_lds + wid * 2048);
    const int vdst_a = (int)(unsigned)(size_t)(V_lds + wid * 2048);
#define DMA_K(t, so) do { glds16(S.k0 + (size_t)(t) * 64 * S.kp0, (unsigned)__builtin_amdgcn_readfirstlane(kdst_a + (so))); \
                          glds16(S.k1 + (size_t)(t) * 64 * S.kp1, (unsigned)__builtin_amdgcn_readfirstlane(kdst_a + (so) + 1024)); } while (0)
#define DMA_V(t, so) do { glds16(S.v0 + (size_t)(t) * 64 * S.vp, (unsigned)__builtin_amdgcn_readfirstlane(vdst_a + (so))); \
                          if constexpr (NDV == 4) glds16(S.v1 + (size_t)(t) * 64 * S.vp, (unsigned)__builtin_amdgcn_readfirstlane(vdst_a + (so) + 1024)); } while (0)
#define DMA_WAIT_BAR(n) asm volatile("s_waitcnt vmcnt(" #n ") lgkmcnt(0)\n\ts_barrier" ::: "memory")
#define ATT_RESC(a) do { if (__any((a) < 1.f)) { if (hi == 0) al_l[r32] = (a); asm volatile("s_waitcnt lgkmcnt(0)" ::: "memory"); \
    _Pragma("unroll") for (int d = 0; d < NDV; ++d) _Pragma("unroll") for (int r = 0; r < 16; ++r) o[d][r] *= al_l[crow(r, hi)]; } } while (0)
#define ATT_CLASS(j, band) do { band = false; if constexpr (DIFF) { float ci_ = 0.f; \
    if ((mask_r >> (j)) & 1u) ci_ = cR; else if ((mask_l >> (j)) & 1u) ci_ = cL; else band = true; \
    if (ci_ != ccur) { ccur = ci_; const float nm_ = ccur - mhat; _Pragma("unroll") for (int r = 0; r < 16; ++r) negm[r] = nm_; asm volatile("" : "+v"(negm)); } } } while (0)
#define ATT_PSM(P0, P1, AL, band, tile, FIRST) do { if (DIFF && (band)) partialSM<true, FIRST>(P0, P1, mhat, negm, ccur, AL, kposl + (tile) * 64, tabl, qpos, hi); else partialSM<false, FIRST>(P0, P1, mhat, negm, ccur, AL, kposl, tabl, qpos, hi); } while (0)
    f32x16 pA0, pA1, pB0, pB1; float alA, alB; bool band; bf16x8 pa0, pa1, pa2, pa3; constexpr int NT = SEQ / 64;
    unsigned mask_r = 0u, mask_l = 0u;
    if constexpr (DIFF) { const int kmn_ = __hip_atomic_load(pmm + 2 * (lane & 31), RLX_AGENT), kmx_ = __hip_atomic_load(pmm + 2 * (lane & 31) + 1, RLX_AGENT);
        mask_r = (unsigned)__ballot(kmn_ - qmx >= 128); mask_l = (unsigned)__ballot(qmn - kmx_ >= 128); }
    asm volatile("s_waitcnt vmcnt(0)" ::: "memory");
    int s0 = 0, s1 = SHM_K, s2 = 2 * SHM_K;
#define ATT_ROT() do { const int t_ = s0; s0 = s1; s1 = s2; s2 = t_; } while (0)
    DMA_K(0, 0); DMA_V(0, 0); DMA_K(1, SHM_K);
    DMA_WAIT_BAR(0);
    DMA_K(2, s2); DMA_V(1, s1);
    ATT_CLASS(0, band); qkt<NDQ, false>(pA0, pA1, K_lds + s0, qr, nullptr, r32, hi, negm); ATT_PSM(pA0, pA1, alA, band, 0, true);
    if constexpr (NDV == 4) DMA_WAIT_BAR(4); else DMA_WAIT_BAR(3);
    ATT_ROT();
    int sv = 0;
    const int cv_gw = C.vcu * NWAVES + wid;
#define CV_HOOK(j) do { cvact = false; if (cs.q < CV_ITEMS) { const int sl_ = (j) & 1; const int pq_ = sl_ ? cs.pend1 : cs.pend0; \
        if (pq_ >= 0) conv_process(C, cv_gw, pq_, sl_, wid, lane); \
        conv_issue(C, cv_gw, cs.q, sl_, wid, lane); if (sl_) cs.pend1 = cs.q; else cs.pend0 = cs.q; ++cs.q; cvact = true; } } while (0)
#define ATT_STEP(C0, C1, ALC, P0, P1, ALP, j, HASK, HASV, NW, NWC) do { \
        if (HASK) DMA_K((j) + 2, s2); \
        if (HASV) DMA_V((j) + 1, s1); \
        CV_HOOK(j); \
        ATT_SBAR(); ATT_CLASS(j, band); qkt<NDQ, false>(C0, C1, K_lds + s0, qr, nullptr, r32, hi, negm); \
        finishSM(P0, P1, ALP, l_reg, pa0, pa1, pa2, pa3); ATT_SBAR(); \
        pv_all<NDV>(o, vb0 + sv, pa0, pa1, pa2, pa3); ATT_PSM(C0, C1, ALC, band, j, false); \
        ATT_RESC(ALC); \
        if (cvact) DMA_WAIT_BAR(NWC); else DMA_WAIT_BAR(NW); sv = s0; ATT_ROT(); } while (0)
    bool cvact = false;
    constexpr int NW_ = (NDV == 4) ? 4 : 3;
#pragma unroll 1
    for (int j = 1; j + 3 < NT; j += 2) {
        if constexpr (NDV == 4) { ATT_STEP(pB0, pB1, alB, pA0, pA1, alA, j, true, true, 4, 6); ATT_STEP(pA0, pA1, alA, pB0, pB1, alB, j + 1, true, true, 4, 6); }
        else { ATT_STEP(pB0, pB1, alB, pA0, pA1, alA, j, true, true, 3, 5); ATT_STEP(pA0, pA1, alA, pB0, pB1, alB, j + 1, true, true, 3, 5); }
    }
    ATT_STEP(pB0, pB1, alB, pA0, pA1, alA, NT - 3, true, true, 0, 0);
    ATT_STEP(pA0, pA1, alA, pB0, pB1, alB, NT - 2, false, true, 0, 0);
    ATT_STEP(pB0, pB1, alB, pA0, pA1, alA, NT - 1, false, false, 0, 0);
    finishSM(pB0, pB1, alB, l_reg, pa0, pa1, pa2, pa3); ATT_SBAR();
    pv_all<NDV>(o, vb0 + sv, pa0, pa1, pa2, pa3);
    l_out = l_reg;
    (void)NW_;
    __syncthreads();
#undef DMA_K
#undef DMA_V
#undef DMA_WAIT_BAR
#undef ATT_RESC
#undef ATT_CLASS
#undef ATT_PSM
#undef ATT_STEP
#undef CV_HOOK
#undef ATT_ROT
}
__device__ __forceinline__ void row_recip(LAS float* li_l, float l_reg, int r32, int hi, float (&rli)[16]) {
    if (hi == 0) li_l[r32] = l_reg; asm volatile("s_waitcnt lgkmcnt(0)" ::: "memory");
#pragma unroll
    for (int r = 0; r < 16; ++r) rli[r] = __builtin_amdgcn_rcpf(li_l[crow(r, hi)]);
    asm volatile("s_waitcnt lgkmcnt(0)" ::: "memory");
}
__device__ __forceinline__ void mla_unit(const Ctx& C, ConvStream& cs, int b, int h, int qb) {
    LAS char* lds = (LAS char*)C.lds;
    int tid = threadIdx.x; asm volatile("" : "+v"(tid));
    const int wid = __builtin_amdgcn_readfirstlane(tid >> 6), lane = tid & 63, r32 = lane & 31, hi = lane >> 5;
    const int t0 = b * SEQ + qb * 256 + wid * 32;
    bf16x8 qr[6];
    const bf16* qrow = C.Q + (size_t)(t0 + r32) * 768;
#pragma unroll
    for (int d0 = 0; d0 < 4; ++d0) qr[d0] = *(const bf16x8*)(qrow + h * 64 + d0 * 16 + hi * 8);
#pragma unroll
    for (int d0 = 4; d0 < 6; ++d0) { const int fqi = 2 * (d0 - 4) + hi; const u32x4 w = *(const u32x4*)(qrow + 512 + h * 32 + (d0 - 4) * 16 + hi * 8);
        const f32x4 c4 = *(const f32x4*)(C.CS + (size_t)(t0 + r32) * 16 + 4 * fqi), s4 = *(const f32x4*)(C.SN + (size_t)(t0 + r32) * 16 + 4 * fqi);
        const float t1[4] = {bflo(w.x), bfhi(w.x), bflo(w.y), bfhi(w.y)}, t2[4] = {bflo(w.z), bfhi(w.z), bflo(w.w), bfhi(w.w)};
        float a[4], bb[4];
#pragma unroll
        for (int i = 0; i < 4; ++i) { a[i] = t1[i] * c4[i] - t2[i] * s4[i]; bb[i] = t1[i] * s4[i] + t2[i] * c4[i]; }
        u32x4 ww; ww.x = pk2(a[0], a[1]); ww.y = pk2(a[2], a[3]); ww.z = pk2(bb[0], bb[1]); ww.w = pk2(bb[2], bb[3]); qr[d0] = __builtin_bit_cast(bf16x8, ww); }
    DmaSrc S;
    {   const size_t kb = (size_t)b * SEQ;
#pragma unroll
        for (int i = 0; i < 2; ++i) { const int row = 8 * wid + 4 * i + (lane >> 4), c = (lane & 15) ^ (row & 15); const bf16* p; int pitch;
            if (c < 8) { p = C.KV + (kb + row) * 1024 + h * 64 + 8 * c; pitch = 1024; } else { p = C.KR + (kb + row) * 32 + 8 * (c & 3); pitch = 32; }
            if (i == 0) { S.k0 = p; S.kp0 = pitch; } else { S.k1 = p; S.kp1 = pitch; } }
        const int rin = (lane >> 2) & 7, key = 16 * (wid >> 1) + 8 * (rin >> 2) + 4 * (wid & 1) + (rin & 3);
        S.v0 = C.KV + (kb + key) * 1024 + 512 + h * 64 + 32 * (lane >> 5) + 8 * (lane & 3); S.v1 = S.v0; S.vp = 1024; }
    f32x16 o[2]; float l;
    attn_pass_dma<6, 2, false>(C, cs, lds, tid, qr, S, o, l, 0, 0, 0, nullptr, 0.f, 0.f);
    float rli[16]; row_recip((LAS float*)(lds + L_WS) + wid * 64, l, r32, hi, rli);
    bf16* ao = C.AO + (size_t)t0 * DM + h * 64; const int loff = hi * 4 * DM + r32;
#pragma unroll
    for (int r = 0; r < 16; ++r) {
#pragma unroll
        for (int d0 = 0; d0 < 2; ++d0) ao[crow(r, 0) * DM + d0 * 32 + loff] = (bf16)f2bf(o[d0][r] * rli[r]); }
}
__device__ __forceinline__ void diff_unit(const Ctx& C, ConvStream& cs, int b, int h, int qb) {
    LAS char* lds = (LAS char*)C.lds;
    int tid = threadIdx.x; asm volatile("" : "+v"(tid));
    const int wid = __builtin_amdgcn_readfirstlane(tid >> 6);
    const int t0 = b * SEQ + qb * 256 + wid * 32;
    LAS float* tabl = (LAS float*)(lds + L_TAB);
    if (tid < 257) tabl[tid] = __hip_atomic_load(C.MISC + 64 + h * 260 + tid, RLX_AGENT);
    { LAS int* kposl = (LAS int*)(lds + L_KPOS);
#pragma unroll
      for (int i = 0; i < SEQ / NTHREADS; ++i) kposl[tid + i * NTHREADS] = C.pos[b * SEQ + tid + i * NTHREADS]; }
    const float cL = __hip_atomic_load(C.MISC + 64 + h * 260 + 0, RLX_AGENT), cR = __hip_atomic_load(C.MISC + 64 + h * 260 + 256, RLX_AGENT);
    const float lam = __hip_atomic_load(C.MISC, RLX_AGENT);
    const int qpos = C.pos[t0 + (tid & 31)]; int qmn = qpos, qmx = qpos;
#pragma unroll
    for (int o_ = 1; o_ < 64; o_ <<= 1) { const int a = __shfl_xor(qmn, o_), c = __shfl_xor(qmx, o_); qmn = a < qmn ? a : qmn; qmx = c > qmx ? c : qmx; }
    qmn = __builtin_amdgcn_readfirstlane(qmn); qmx = __builtin_amdgcn_readfirstlane(qmx);
    __syncthreads();
    float* scr = C.out + (size_t)t0 * DM + h * 128;
    const int* pmm = C.PMM + b * 64;
#pragma unroll
    for (int m = 0; m < 2; ++m) {
        f32x16 o[4]; float l;
        {
            int tl = threadIdx.x; asm volatile("" : "+v"(tl));
            const int lane = tl & 63, r32 = lane & 31, hi = lane >> 5, sc = (tl & 15) * 8;
            bf16x8 qr[4];
            const bf16* qrow = C.PROJ + (size_t)(t0 + r32) * NPROJ + 512 + (h * 2 + m) * 64;
#pragma unroll
            for (int d0 = 0; d0 < 4; ++d0) qr[d0] = *(const bf16x8*)(qrow + d0 * 16 + hi * 8);
            DmaSrc S;
            {   const size_t kb = (size_t)b * SEQ;
#pragma unroll
                for (int i = 0; i < 2; ++i) { const int row = 8 * wid + 4 * i + (lane >> 4), c = (lane & 15) ^ (row & 15);
                    const bf16* p = C.PROJ + (kb + row) * NPROJ + 1024 + (h * 2 + m) * 64 + 8 * (c & 7);
                    if (i == 0) { S.k0 = p; S.kp0 = NPROJ; } else { S.k1 = p; S.kp1 = NPROJ; } }
                const int rin = (lane >> 2) & 7, key = 16 * (wid >> 1) + 8 * (rin >> 2) + 4 * (wid & 1) + (rin & 3);
                S.v0 = C.PROJ + (kb + key) * NPROJ + 1536 + h * 128 + 32 * (lane >> 5) + 8 * (lane & 3); S.v1 = S.v0 + 64; S.vp = NPROJ; }
            attn_pass_dma<4, 4, true>(C, cs, lds, tl, qr, S, o, l, qpos, qmn, qmx, pmm, cL, cR);
        }
        int te = threadIdx.x; asm volatile("" : "+v"(te));
        const int r32 = te & 31, hi = (te >> 5) & 1, loff = hi * 4 * DM + r32;
        float rli[16]; row_recip((LAS float*)(lds + L_WS) + wid * 64, l, r32, hi, rli);
        if (m == 0) {
#pragma unroll
            for (int r = 0; r < 16; ++r) {
#pragma unroll
                for (int d0 = 0; d0 < 4; ++d0) scr[crow(r, 0) * DM + d0 * 32 + loff] = o[d0][r] * rli[r]; }
        } else {
#pragma unroll
            for (int r = 0; r < 16; ++r) { float s = 0.f;
#pragma unroll
                for (int d0 = 0; d0 < 4; ++d0) { const float a = scr[crow(r, 0) * DM + d0 * 32 + loff] - lam * (o[d0][r] * rli[r]); o[d0][r] = a; s += a * a; }
                s += __shfl_xor(s, 1); s += __shfl_xor(s, 2); s += __shfl_xor(s, 4); s += __shfl_xor(s, 8); s += __shfl_xor(s, 16);
                const float f = (1.0f - LAMBDA_INIT) * __builtin_amdgcn_rsqf(s * (1.f / 128.f) + RMS_EPS);
#pragma unroll
                for (int d0 = 0; d0 < 4; ++d0) o[d0][r] *= f;
                asm volatile("" : "+v"(o[0][r]), "+v"(o[1][r]), "+v"(o[2][r]), "+v"(o[3][r]));
                if (r & 1) asm volatile("" ::: "memory"); }
            bf16* ao = C.AO + (size_t)t0 * DM + 512 + h * 128;
#pragma unroll
            for (int d0 = 0; d0 < 4; ++d0) { const float g = C.subln[d0 * 32 + r32];
#pragma unroll
                for (int r = 0; r < 16; ++r) ao[crow(r, 0) * DM + d0 * 32 + loff] = (bf16)f2bf(o[d0][r] * g); }
        }
    }
}
__device__ __forceinline__ void attn_phase(const Ctx& C) {
    ConvStream cs; cs.q = 0; cs.pend0 = -1; cs.pend1 = -1;
#ifndef ATT_SKIP_DIFF
#pragma unroll 1
    for (int U = C.vcu; U < BATCH * 4 * 8; U += C.G) diff_unit(C, cs, U >> 5, (U >> 3) & 3, U & 7);
#endif
#ifndef ATT_SKIP_MLA
#pragma unroll 1
    for (int U = C.vcu; U < BATCH * 8 * 8; U += C.G) mla_unit(C, cs, U >> 6, (U >> 3) & 7, U & 7);
#endif
    { int tl_ = threadIdx.x; asm volatile("" : "+v"(tl_)); conv_flush(C, cs, C.vcu * NWAVES + C.wave, C.wave, tl_ & 63); }
}
}

constexpr int NPHASE = 12;
__global__ void __launch_bounds__(NTHREADS, 2) mega(Args args) {
    extern __shared__ __attribute__((aligned(16))) unsigned char lds[];
    Ctx C; ctx_init(C, args);
    C.lds = (LAS unsigned char*)lds; C.lds_g = lds;
    C.wave = __builtin_amdgcn_readfirstlane((int)threadIdx.x >> 6);
    C.G = gridDim.x; { const int bx = blockIdx.x; C.vcu = (C.G % 8 == 0) ? (bx % 8) * (C.G / 8) + bx / 8 : bx; }
    volatile LAS unsigned* MISCL = (volatile LAS unsigned*)(C.lds + MISC_OFF);
    for (int u = threadIdx.x; u < (LDS_BYTES - LDSCTL_OFF) / 4; u += NTHREADS) ((LAS unsigned*)(C.lds + LDSCTL_OFF))[u] = 0u;
    __syncthreads();
    const int lo = args.ph_lo, hi = args.ph_hi;
    XcdBarrier bar; bar.bar = (unsigned*)(args.ws + WS_CTL) + CW_BAR + args.li * XCD_BAR_WORDS; bar.x = 0; bar.st = nullptr;
    if (hi - lo > 1) bar = xcd_barrier_post((unsigned*)(args.ws + WS_CTL) + CW_BAR + args.li * XCD_BAR_WORDS, MISCL + 8);
#define IN(k) (lo <= (k) && (k) < hi)
#define SEAM(k) do { if (IN(k) && IN((k) + 1)) xcd_barrier(bar); } while (0)
    if (IN(0)) { phase_prep(C); } SEAM(0);
    if (IN(1)) { phase_u(C); } SEAM(1);
    if (IN(2)) {
        pg8::SchedDense S; S.init(C.U, DM, C.WIN, DM, T, NPROJ, C.G, (int)blockIdx.x);
        pg8::EpiProj E{C.PROJ, C.RINVQ, C.RINVKV, C.KR, C.CS, C.SN};
        pg8::gemm_phase(C.lds, DM * 2, S, E);
    } SEAM(2);
    if (IN(4)) {
        pg8::SchedQKV S{(const char*)C.PROJ, (const char*)C.WUQ, (const char*)C.WUKV, NPROJ * 2, 256 * 2, C.G, C.vcu};
        pg8::EpiQKV E{FRowScale{C.Q, 768, C.RINVQ, 1.f / 256.f}, FRowScale{C.KV, 1024, C.RINVKV, 1.f / 128.f}};
        pg8::gemm_phase(C.lds, 256 * 2, S, E);
    } SEAM(4);
    if (IN(5)) { att::attn_phase(C); } SEAM(5);
    if (IN(6)) {
        pg8::SchedDense S; S.init(C.AO, DM, C.WOUT, DM, T, DM, C.G, (int)blockIdx.x);
        pg8::EpiY E{C.Y, C.x, C.MOD};
        pg8::gemm_phase(C.lds, DM * 2, S, E);
    } SEAM(6);
    if (IN(7)) { phase_ln1(C); } SEAM(7);
    if (IN(9)) {
        if (C.vcu < 256) phase_topk(C, ((C.vcu & 15) * 16 + 2 * (C.vcu >> 5) + ((C.vcu >> 4) & 1)), BATCH * NE);
        VM_WAIT(); __syncthreads();
        pg8::SchedUp S{(const char*)C.U2, C.IDX, (const char*)C.WGU, DM, DM, C.G, C.vcu};
        pg8::EpiPair8<FSwi> E{FSwi{(unsigned char*)C.HLO}};
        pg8::gemm_phase<pg8::EpiPair8<FSwi>, pg8::SchedUp, true>(C.lds, DM, S, E);
    } SEAM(9);
    if (IN(10)) {
        pg8::SchedDown S{(const char*)C.HLO, (const char*)C.WD, FF, FF, C.G, C.vcu};
        pg8::EpiRow8<FGate> E{FGate{C.YE, C.GATE}};
        pg8::gemm_phase<pg8::EpiRow8<FGate>, pg8::SchedDown, true>(C.lds, FF, S, E);
    } SEAM(10);
    if (IN(11)) { phase_final(C); }
#undef IN
#undef SEAM
}

extern "C" void kernel_launch(void* const* d_in, const int* in_sizes, int n_in, void* d_out, int out_size, void* d_ws, size_t ws_size, hipStream_t stream) {
    static int grid = 0;
    if (grid == 0) {
        if (n_in != 25 || out_size != T * DM || ws_size < WS_END) { fprintf(stderr, "kernel_launch: unexpected shapes (n_in %d out %d ws %zu, need %zu)\n", n_in, out_size, ws_size, (size_t)WS_END); grid = -1; return; }
        int dev = 0, cus = 0;
        if (hipGetDevice(&dev) != hipSuccess || hipDeviceGetAttribute(&cus, hipDeviceAttributeMultiprocessorCount, dev) != hipSuccess) { grid = -1; return; }
        if (hipFuncSetAttribute((const void*)mega, hipFuncAttributeMaxDynamicSharedMemorySize, LDS_BYTES) != hipSuccess) { fprintf(stderr, "kernel_launch: hipFuncSetAttribute failed\n"); grid = -1; return; }
        int per_cu = 0; (void)hipOccupancyMaxActiveBlocksPerMultiprocessor(&per_cu, (const void*)mega, NTHREADS, LDS_BYTES); (void)hipGetLastError();
        if (per_cu < 1) fprintf(stderr, "kernel_launch: occupancy query reports %d\n", per_cu);
        grid = cus;
        if (grid != 256) fprintf(stderr, "kernel_launch: %d CUs (the expert-GEMM unit maps are built for 256)\n", grid);
    }
    if (grid < 0) return;
    (void)hipMemsetAsync((char*)d_ws + WS_CTL, 0, CTL_BYTES, stream);
    Args a{};
    for (int i = 0; i < 25; ++i) a.in[i] = d_in[i];
    a.out = (float*)d_out; a.ws = (unsigned char*)d_ws; a.ph_lo = 0; a.ph_hi = NPHASE; a.li = 0; a.pad = 0;
    hipLaunchKernelGGL(mega, dim3(grid), dim3(NTHREADS), LDS_BYTES, stream, a);
}
```
